# Optimizing an MI355X kernel written in HIP

```python
import math
import jax, jax.numpy as jnp
from jax import lax
import numpy as np

D_MODEL = 2048
BATCH = 1
SEQ = 8192
DEPTH = 1

D_MIX = D_MODEL
CONV_CH = D_MIX // 2
HEAD_DIM = 64
N_Q_HEADS = (D_MIX - CONV_CH) // HEAD_DIM
N_KV_HEADS = 2
GQA_GROUP = N_Q_HEADS // N_KV_HEADS
ATTN_CH = N_Q_HEADS * HEAD_DIM
KV_CH = N_KV_HEADS * HEAD_DIM
IN_COLS = 2 * CONV_CH + ATTN_CH + 2 * KV_CH
CONV_K = 31
WINDOW = 128
BLOCK = 128
ROT_DIM = HEAD_DIM // 4
ROPE_THETA = 500000.0
EPS = 1e-6
N_KEYS = 128
N_EXPERTS = N_KEYS * N_KEYS
PEER_HEADS = 8
PEER_KEY_DIM = 256
PEER_HALF = PEER_KEY_DIM // 2
PEER_TOPK = 16
PEER_CHUNK = 128

kernel_name = "hymba_conv_swa_peer_layer"


def rms_norm(x, g):
    xf = x.astype(jnp.float32)
    y = xf * lax.rsqrt(jnp.mean(xf * xf, axis=-1, keepdims=True) + EPS)
    return (y * g.astype(jnp.float32)).astype(x.dtype)


def layer_norm(x, g, b):
    xf = x.astype(jnp.float32)
    mu = jnp.mean(xf, axis=-1, keepdims=True)
    var = jnp.mean(jnp.square(xf - mu), axis=-1, keepdims=True)
    y = (xf - mu) * lax.rsqrt(var + EPS)
    return (y * g.astype(jnp.float32) + b.astype(jnp.float32)).astype(x.dtype)


def partial_rotary(t, cos, sin):
    half = ROT_DIM // 2
    r1 = t[..., :half]
    r2 = t[..., half:ROT_DIM]
    return jnp.concatenate([r1 * cos - r2 * sin, r2 * cos + r1 * sin, t[..., ROT_DIM:]], axis=-1)


def conv_group(u, conv_dw_w, conv_dw_b, conv_ln_g, conv_ln_b):
    a, gate = jnp.split(u, 2, axis=-1)
    h = a * jax.nn.sigmoid(gate)
    h = lax.conv_general_dilated(
        h, conv_dw_w[:, None, :].astype(h.dtype), window_strides=(1,),
        padding=[(CONV_K - 1, 0)], dimension_numbers=("NWC", "WIO", "NWC"),
        feature_group_count=CONV_CH) + conv_dw_b
    h = layer_norm(h, conv_ln_g, conv_ln_b)
    return jax.nn.silu(h)


def swa_group(q, k, v, positions, q_norm_g, k_norm_g, attn_sinks):
    B, S, _ = q.shape
    nb = S // BLOCK
    q = rms_norm(q.reshape(B, S, N_Q_HEADS, HEAD_DIM), q_norm_g)
    k = rms_norm(k.reshape(B, S, N_KV_HEADS, HEAD_DIM), k_norm_g)
    v = v.reshape(B, S, N_KV_HEADS, HEAD_DIM)
    inv_freq = ROPE_THETA ** (-jnp.arange(0, ROT_DIM, 2, dtype=jnp.float32) / ROT_DIM)
    ang = positions.astype(jnp.float32)[..., None] * inv_freq
    cos = jnp.cos(ang)[:, :, None, :].astype(q.dtype)
    sin = jnp.sin(ang)[:, :, None, :].astype(q.dtype)
    q = partial_rotary(q, cos, sin)
    k = partial_rotary(k, cos, sin)

    qb = q.reshape(B, nb, BLOCK, N_KV_HEADS, GQA_GROUP, HEAD_DIM)
    pad = ((0, 0), (BLOCK, 0), (0, 0), (0, 0))
    kb = jnp.pad(k, pad).reshape(B, nb + 1, BLOCK, N_KV_HEADS, HEAD_DIM)
    vb = jnp.pad(v, pad).reshape(B, nb + 1, BLOCK, N_KV_HEADS, HEAD_DIM)
    k_band = jnp.concatenate([kb[:, :-1], kb[:, 1:]], axis=2)
    v_band = jnp.concatenate([vb[:, :-1], vb[:, 1:]], axis=2)

    scores = jnp.einsum("bnqhgd,bnshd->bnhgqs", qb, k_band).astype(jnp.float32)
    scores = scores * (1.0 / math.sqrt(HEAD_DIM))
    blk = jnp.arange(nb)[:, None, None]
    qpos = blk * BLOCK + jnp.arange(BLOCK)[None, :, None]
    kpos = (blk - 1) * BLOCK + jnp.arange(2 * BLOCK)[None, None, :]
    mask = (kpos <= qpos) & (qpos - kpos < WINDOW) & (kpos >= 0)
    scores = jnp.where(mask[None, :, None, None], scores, -1e30)

    sink = attn_sinks.astype(jnp.float32).reshape(1, 1, N_KV_HEADS, GQA_GROUP, 1, 1)
    m = jnp.maximum(jnp.max(scores, axis=-1, keepdims=True), sink)
    p = jnp.exp(scores - m)
    denom = jnp.sum(p, axis=-1, keepdims=True) + jnp.exp(sink - m)
    probs = (p / denom).astype(v.dtype)
    out = jnp.einsum("bnhgqs,bnshd->bnqhgd", probs, v_band)
    return out.reshape(B, S, ATTN_CH)


def peer(xn, peer_w_q, peer_sub_keys, peer_u, peer_v):
    B, S, D = xn.shape
    T = B * S
    xt = xn.reshape(T, D)
    qh = (xt @ peer_w_q).reshape(T, PEER_HEADS, 2, PEER_HALF)
    sub = jnp.einsum("thpc,hpnc->thpn", qh, peer_sub_keys).astype(jnp.float32)
    v1, i1 = lax.top_k(sub[:, :, 0], PEER_TOPK)
    v2, i2 = lax.top_k(sub[:, :, 1], PEER_TOPK)
    cand = (v1[..., :, None] + v2[..., None, :]).reshape(T, PEER_HEADS, PEER_TOPK * PEER_TOPK)
    vals, cidx = lax.top_k(cand, PEER_TOPK)
    e1 = jnp.take_along_axis(i1, cidx // PEER_TOPK, axis=-1)
    e2 = jnp.take_along_axis(i2, cidx % PEER_TOPK, axis=-1)
    experts = e1 * N_KEYS + e2
    gates = jax.nn.softmax(vals, axis=-1).astype(xn.dtype)

    nc = T // PEER_CHUNK

    def chunk_fn(args):
        xc, ec, gc = args
        u_sel = jnp.take(peer_u, ec, axis=0)
        h = jnp.einsum("cd,chkd->chk", xc, u_sel)
        a = jax.nn.gelu(h, approximate=False) * gc
        v_sel = jnp.take(peer_v, ec, axis=0)
        return jnp.einsum("chk,chkd->cd", a, v_sel)

    y = lax.map(chunk_fn, (xt.reshape(nc, PEER_CHUNK, D),
                           experts.reshape(nc, PEER_CHUNK, PEER_HEADS, PEER_TOPK),
                           gates.reshape(nc, PEER_CHUNK, PEER_HEADS, PEER_TOPK)))
    return y.reshape(B, S, D)


def setup_inputs(seed: int = 0) -> dict:
    key = jax.random.key(seed)
    ks = jax.random.split(key, 20)
    f32 = jnp.float32
    nrm = lambda k, shape, s: jax.random.normal(k, shape, f32) * s
    positions = jnp.broadcast_to(jnp.arange(SEQ, dtype=jnp.int32)[None, :], (BATCH, SEQ))
    return {
        "x": nrm(ks[0], (BATCH, SEQ, D_MODEL), 1.0),
        "positions": positions,
        "norm1_g": 1.0 + nrm(ks[1], (D_MODEL,), 0.02),
        "w_in": nrm(ks[2], (D_MODEL, IN_COLS), D_MODEL ** -0.5),
        "b_in": nrm(ks[3], (IN_COLS,), 0.02),
        "conv_dw_w": nrm(ks[4], (CONV_K, CONV_CH), CONV_K ** -0.5),
        "conv_dw_b": nrm(ks[5], (CONV_CH,), 0.02),
        "conv_ln_g": 1.0 + nrm(ks[6], (CONV_CH,), 0.02),
        "conv_ln_b": nrm(ks[7], (CONV_CH,), 0.02),
        "q_norm_g": 1.0 + nrm(ks[8], (HEAD_DIM,), 0.02),
        "k_norm_g": 1.0 + nrm(ks[9], (HEAD_DIM,), 0.02),
        "attn_sinks": nrm(ks[10], (N_Q_HEADS,), 0.5),
        "w_out": nrm(ks[11], (D_MIX, D_MODEL), D_MIX ** -0.5),
        "norm2_g": 1.0 + nrm(ks[12], (D_MODEL,), 0.02),
        "peer_w_q": nrm(ks[13], (D_MODEL, PEER_HEADS * PEER_KEY_DIM), D_MODEL ** -0.5),
        "peer_sub_keys": nrm(ks[14], (PEER_HEADS, 2, N_KEYS, PEER_HALF), PEER_HALF ** -0.5),
        "peer_u": nrm(ks[15], (N_EXPERTS, D_MODEL), D_MODEL ** -0.5),
        "peer_v": nrm(ks[16], (N_EXPERTS, D_MODEL), PEER_HEADS ** -0.5),
    }


def reference(x, positions, norm1_g, w_in, b_in, conv_dw_w, conv_dw_b, conv_ln_g, conv_ln_b,
              q_norm_g, k_norm_g, attn_sinks, w_out, norm2_g, peer_w_q, peer_sub_keys,
              peer_u, peer_v):
    for _ in range(DEPTH):
        xn = rms_norm(x, norm1_g)
        proj = xn @ w_in + b_in
        c0 = 2 * CONV_CH
        conv_in = proj[..., :c0]
        q = proj[..., c0:c0 + ATTN_CH]
        k = proj[..., c0 + ATTN_CH:c0 + ATTN_CH + KV_CH]
        v = proj[..., c0 + ATTN_CH + KV_CH:]
        conv_out = conv_group(conv_in, conv_dw_w, conv_dw_b, conv_ln_g, conv_ln_b)
        attn_out = swa_group(q, k, v, positions, q_norm_g, k_norm_g, attn_sinks)
        mixed = jnp.concatenate([conv_out, attn_out], axis=-1)
        x = x + mixed @ w_out
        x = x + peer(rms_norm(x, norm2_g), peer_w_q, peer_sub_keys, peer_u, peer_v)
    return x
```

```cpp
#include <hip/hip_runtime.h>
#include <cstdio>
#include <cstdint>

typedef unsigned short bf16;
typedef unsigned v4u __attribute__((ext_vector_type(4)));
typedef unsigned v2u __attribute__((ext_vector_type(2)));
typedef float f32x4 __attribute__((ext_vector_type(4)));

constexpr int T = 8192, D = 2048, CONVC = 1024, HD = 64, NQH = 16, NKVH = 2, ATT = 1024, KVC = 128;
constexpr int INC = 2 * CONVC + ATT + 2 * KVC;
constexpr int QOFF = 2 * CONVC, KOFF = QOFF + ATT, VOFF = KOFF + KVC;
constexpr int CK = 31, WIN = 128;
constexpr int NKEYS = 128, NEXP = NKEYS * NKEYS, PH = 8, PTOPK = 16;
constexpr float EPS = 1e-6f;

constexpr size_t MiB = 1u << 20;
constexpr size_t WS_CTL = 0, CTL_ZERO_BYTES = 1 * MiB;
constexpr size_t WS_SSQ = 64 * 1024;
constexpr size_t WS_RSTD1 = 1 * MiB;
constexpr size_t WS_SKB = 2 * MiB;
constexpr size_t WS_W1T = 4 * MiB;
constexpr size_t WS_W2T = 20 * MiB;
constexpr size_t WS_W3T = 28 * MiB;
constexpr size_t WS_XB = 64 * MiB;
constexpr size_t WS_PROJ = 96 * MiB;
constexpr size_t WS_MIXED = 160 * MiB;
constexpr size_t WS_X1B = 192 * MiB;
constexpr size_t WS_QP = 224 * MiB;
constexpr size_t WS_UB = 256 * MiB;
constexpr size_t WS_VB = 320 * MiB;
constexpr size_t WS_END = 384 * MiB;

__device__ __forceinline__ unsigned f2bf(float f) { unsigned u = __float_as_uint(f); return (u + 0x7fffu + ((u >> 16) & 1u)) >> 16; }
__device__ __forceinline__ unsigned pk2(float lo, float hi) { return f2bf(lo) | (f2bf(hi) << 16); }
__device__ __forceinline__ float bf2f(unsigned b) { return __uint_as_float(b << 16); }
__device__ __forceinline__ float bflo(unsigned w) { return __uint_as_float(w << 16); }
__device__ __forceinline__ float bfhi(unsigned w) { return __uint_as_float(w & 0xffff0000u); }
__device__ __forceinline__ float wave_sum(float v) {
#pragma unroll
    for (int o = 1; o < 64; o <<= 1) v += __shfl_xor(v, o);
    return v;
}
__device__ __forceinline__ float wave_max(float v) {
#pragma unroll
    for (int o = 1; o < 64; o <<= 1) v = fmaxf(v, __shfl_xor(v, o));
    return v;
}
__device__ __forceinline__ int wave_min_i(int v) {
#pragma unroll
    for (int o = 1; o < 64; o <<= 1) { int t = __shfl_xor(v, o); v = t < v ? t : v; }
    return v;
}

__global__ void k_prep_x(const float* __restrict__ x, bf16* __restrict__ xb, float* __restrict__ rstd1) {
    const int lane = threadIdx.x & 63, gw = (blockIdx.x * blockDim.x + threadIdx.x) >> 6, ngw = (gridDim.x * blockDim.x) >> 6;
    for (int row = gw; row < T; row += ngw) {
        const f32x4* xr = (const f32x4*)(x + (size_t)row * D) + lane;
        f32x4 v[8]; float ss = 0.f;
#pragma unroll
        for (int j = 0; j < 8; ++j) { v[j] = xr[64 * j]; ss += v[j].x * v[j].x + v[j].y * v[j].y + v[j].z * v[j].z + v[j].w * v[j].w; }
        ss = wave_sum(ss);
        if (lane == 0) rstd1[row] = rsqrtf(ss * (1.f / D) + EPS);
        v2u* o = (v2u*)(xb + (size_t)row * D) + lane;
#pragma unroll
        for (int j = 0; j < 8; ++j) { v2u w; w.x = pk2(v[j].x, v[j].y); w.y = pk2(v[j].z, v[j].w); o[64 * j] = w; }
    }
}
__global__ void k_transpose_w(const float* __restrict__ W, const float* __restrict__ g, bf16* __restrict__ Wt, int K, int N) {
    __shared__ float tile[32][33];
    const int k0 = blockIdx.y * 32, n0 = blockIdx.x * 32, tx = threadIdx.x & 31, ty = threadIdx.x >> 5;
    for (int i = ty; i < 32; i += 8) { const float gv = g ? g[k0 + i] : 1.f; tile[i][tx] = W[(size_t)(k0 + i) * N + n0 + tx] * gv; }
    __syncthreads();
    for (int i = ty; i < 32; i += 8) Wt[(size_t)(n0 + i) * K + k0 + tx] = (bf16)f2bf(tile[tx][i]);
}
__global__ void k_convert(const float* __restrict__ src, const float* __restrict__ g, bf16* __restrict__ dst, size_t n8, int ncol) {
    for (size_t i = (size_t)blockIdx.x * blockDim.x + threadIdx.x; i < n8; i += (size_t)gridDim.x * blockDim.x) {
        f32x4 a = ((const f32x4*)src)[2 * i], b = ((const f32x4*)src)[2 * i + 1];
        if (g) { const int c = (int)((i * 8) % ncol); const f32x4 ga = *(const f32x4*)(g + c), gb = *(const f32x4*)(g + c + 4); a = a * ga; b = b * gb; }
        v4u w; w.x = pk2(a.x, a.y); w.y = pk2(a.z, a.w); w.z = pk2(b.x, b.y); w.w = pk2(b.z, b.w);
        ((v4u*)dst)[i] = w;
    }
}

struct EpiProj { bf16* proj; const float* rstd1; const float* bias;
    __device__ void operator()(int r, int c, float v) const { proj[(size_t)r * INC + c] = (bf16)f2bf(rstd1[r] * v + bias[c]); } };
struct EpiX1 { const float* x; float* out; bf16* x1b;
    __device__ void operator()(int r, int c, float v) const { const float x1 = x[(size_t)r * D + c] + v; out[(size_t)r * D + c] = x1; x1b[(size_t)r * D + c] = (bf16)f2bf(x1); } };
struct EpiQp { bf16* qp; const float* ssq;
    __device__ void operator()(int r, int c, float v) const { qp[(size_t)r * D + c] = (bf16)f2bf(rsqrtf(ssq[r] * (1.f / D) + EPS) * v); } };
template <class Epi>
__global__ void __launch_bounds__(256) k_gemm_naive(const bf16* __restrict__ A, const bf16* __restrict__ Bt, int M, int N, int K, Epi E) {
    __shared__ float As[32][65], Bs[32][65];
    const int tx = threadIdx.x & 15, ty = threadIdx.x >> 4, m0 = blockIdx.y * 64, n0 = blockIdx.x * 64;
    float acc[4][4] = {};
    for (int k0 = 0; k0 < K; k0 += 32) {
        for (int i = threadIdx.x; i < 64 * 32; i += 256) { const int r = i >> 5, k = i & 31;
            As[k][r] = bf2f(A[(size_t)(m0 + r) * K + k0 + k]); Bs[k][r] = bf2f(Bt[(size_t)(n0 + r) * K + k0 + k]); }
        __syncthreads();
#pragma unroll 8
        for (int k = 0; k < 32; ++k) {
            float a[4], b[4];
#pragma unroll
            for (int i = 0; i < 4; ++i) { a[i] = As[k][ty * 4 + i]; b[i] = Bs[k][tx * 4 + i]; }
#pragma unroll
            for (int i = 0; i < 4; ++i)
#pragma unroll
                for (int j = 0; j < 4; ++j) acc[i][j] += a[i] * b[j];
        }
        __syncthreads();
    }
#pragma unroll
    for (int i = 0; i < 4; ++i)
#pragma unroll
        for (int j = 0; j < 4; ++j) E(m0 + ty * 4 + i, n0 + tx * 4 + j, acc[i][j]);
}

__global__ void __launch_bounds__(256) k_conv_naive(const bf16* __restrict__ proj, const float* __restrict__ cw, const float* __restrict__ cb,
                                                     const float* __restrict__ lg, const float* __restrict__ lb, bf16* __restrict__ mixed) {
    __shared__ float red[2][4];
    const int t = blockIdx.x, c0 = threadIdx.x * 4, lane = threadIdx.x & 63, wv = threadIdx.x >> 6;
    float acc[4];
#pragma unroll
    for (int i = 0; i < 4; ++i) acc[i] = cb[c0 + i];
    for (int j = 0; j < CK; ++j) {
        const int tt = t + j - (CK - 1);
        if (tt < 0) continue;
        const v2u a = *(const v2u*)(proj + (size_t)tt * INC + c0), gt = *(const v2u*)(proj + (size_t)tt * INC + CONVC + c0);
        const float av[4] = {bflo(a.x), bfhi(a.x), bflo(a.y), bfhi(a.y)}, gv[4] = {bflo(gt.x), bfhi(gt.x), bflo(gt.y), bfhi(gt.y)};
#pragma unroll
        for (int i = 0; i < 4; ++i) { const float h = av[i] / (1.f + __expf(-gv[i])); acc[i] += h * cw[j * CONVC + c0 + i]; }
    }
    float s = acc[0] + acc[1] + acc[2] + acc[3];
    s = wave_sum(s); if (lane == 0) red[0][wv] = s; __syncthreads();
    const float mu = (red[0][0] + red[0][1] + red[0][2] + red[0][3]) * (1.f / CONVC);
    float q = 0.f;
#pragma unroll
    for (int i = 0; i < 4; ++i) { const float d = acc[i] - mu; q += d * d; }
    q = wave_sum(q); if (lane == 0) red[1][wv] = q; __syncthreads();
    const float rstd = rsqrtf((red[1][0] + red[1][1] + red[1][2] + red[1][3]) * (1.f / CONVC) + EPS);
    float o[4];
#pragma unroll
    for (int i = 0; i < 4; ++i) { const float y = (acc[i] - mu) * rstd * lg[c0 + i] + lb[c0 + i]; o[i] = y / (1.f + __expf(-y)); }
    v2u w; w.x = pk2(o[0], o[1]); w.y = pk2(o[2], o[3]);
    *(v2u*)(mixed + (size_t)t * D + c0) = w;
}

__global__ void __launch_bounds__(256) k_attn_naive(const bf16* __restrict__ proj, const int* __restrict__ pos, const float* __restrict__ qg, const float* __restrict__ kg,
                                                     const float* __restrict__ sinks, bf16* __restrict__ mixed) {
    __shared__ float qs[4][64];
    const int lane = threadIdx.x & 63, wv = threadIdx.x >> 6, gw = blockIdx.x * 4 + wv;
    const int t = gw >> 4, hq = gw & 15, kvh = hq >> 3;
    {
        float q = bf2f(proj[(size_t)t * INC + QOFF + hq * HD + lane]);
        const float ss = wave_sum(q * q);
        q = q * rsqrtf(ss * (1.f / HD) + EPS) * qg[lane];
        const float pv = __shfl(q, lane < 8 ? lane + 8 : (lane < 16 ? lane - 8 : lane));
        if (lane < 16) { const int i = lane & 7; const float ang = (float)pos[t] * powf(500000.f, -(float)(2 * i) / 16.f); float sn, cs; sincosf(ang, &sn, &cs);
            q = lane < 8 ? q * cs - pv * sn : q * cs + pv * sn; }
        qs[wv][lane] = q;
    }
    __syncthreads();
    float sc[2];
#pragma unroll
    for (int h = 0; h < 2; ++h) {
        const int kp = t - lane - 64 * h;
        float s = -1e30f;
        if (kp >= 0) {
            const bf16* kr = proj + (size_t)kp * INC + KOFF + kvh * HD;
            float kv[64]; float ss = 0.f;
#pragma unroll
            for (int d = 0; d < 64; ++d) { kv[d] = bf2f(kr[d]); ss += kv[d] * kv[d]; }
            const float r = rsqrtf(ss * (1.f / HD) + EPS);
#pragma unroll
            for (int d = 0; d < 64; ++d) kv[d] = kv[d] * r * kg[d];
            const float p = (float)pos[kp];
#pragma unroll
            for (int i = 0; i < 8; ++i) { const float ang = p * powf(500000.f, -(float)(2 * i) / 16.f); float sn, cs; sincosf(ang, &sn, &cs);
                const float r1 = kv[i], r2 = kv[i + 8]; kv[i] = r1 * cs - r2 * sn; kv[i + 8] = r2 * cs + r1 * sn; }
            float dot = 0.f;
#pragma unroll
            for (int d = 0; d < 64; ++d) dot += kv[d] * qs[wv][d];
            s = dot * 0.125f;
        }
        sc[h] = s;
    }
    const float sink = sinks[hq];
    const float m = fmaxf(wave_max(fmaxf(sc[0], sc[1])), sink);
    const float p0 = (t - lane >= 0) ? __expf(sc[0] - m) : 0.f, p1 = (t - lane - 64 >= 0) ? __expf(sc[1] - m) : 0.f;
    const float denom = wave_sum(p0 + p1) + __expf(sink - m);
    float acc = 0.f;
    for (int j = 0; j < WIN; ++j) {
        const float pj = __shfl(j < 64 ? p0 : p1, j & 63);
        const int kp = t - j;
        if (kp >= 0) acc += pj * bf2f(proj[(size_t)kp * INC + VOFF + kvh * HD + lane]);
    }
    mixed[(size_t)t * D + CONVC + hq * HD + lane] = (bf16)f2bf(acc / denom);
}

__global__ void k_ssq(const float* __restrict__ x1, float* __restrict__ ssq) {
    const int lane = threadIdx.x & 63, gw = (blockIdx.x * blockDim.x + threadIdx.x) >> 6, ngw = (gridDim.x * blockDim.x) >> 6;
    for (int row = gw; row < T; row += ngw) {
        const f32x4* xr = (const f32x4*)(x1 + (size_t)row * D) + lane; float ss = 0.f;
#pragma unroll
        for (int j = 0; j < 8; ++j) { const f32x4 v = xr[64 * j]; ss += v.x * v.x + v.y * v.y + v.z * v.z + v.w * v.w; }
        ss = wave_sum(ss); if (lane == 0) ssq[row] = ss;
    }
}

__global__ void __launch_bounds__(256) k_peer_naive(const bf16* __restrict__ qp, const bf16* __restrict__ skb, const bf16* __restrict__ x1b, const float* __restrict__ ssq,
                                                     const bf16* __restrict__ Ub, const bf16* __restrict__ Vb, float* __restrict__ out) {
    __shared__ float q_s[4][256];
    __shared__ float tkv[4][2][16];
    __shared__ int tki[4][2][16];
    __shared__ int sel_e[4][128];
    __shared__ float sel_g[4][128];
    __shared__ float act[4][128];
    const int lane = threadIdx.x & 63, wv = threadIdx.x >> 6, t = blockIdx.x * 4 + wv;
    const float rstd2 = rsqrtf(ssq[t] * (1.f / D) + EPS);
    for (int h = 0; h < PH; ++h) {
        for (int i = lane; i < 256; i += 64) q_s[wv][i] = bf2f(qp[(size_t)t * D + h * 256 + i]);
        __builtin_amdgcn_s_waitcnt(0); __builtin_amdgcn_wave_barrier();
        for (int p = 0; p < 2; ++p) {
            float v0 = 0.f, v1 = 0.f;
            const bf16* k0 = skb + ((size_t)(h * 2 + p) * NKEYS + lane) * 128, * k1 = k0 + 64 * 128;
            for (int c8 = 0; c8 < 16; ++c8) {
                const v4u a = ((const v4u*)k0)[c8], b = ((const v4u*)k1)[c8]; const float* qv = &q_s[wv][p * 128 + c8 * 8];
                v0 += qv[0] * bflo(a.x) + qv[1] * bfhi(a.x) + qv[2] * bflo(a.y) + qv[3] * bfhi(a.y) + qv[4] * bflo(a.z) + qv[5] * bfhi(a.z) + qv[6] * bflo(a.w) + qv[7] * bfhi(a.w);
                v1 += qv[0] * bflo(b.x) + qv[1] * bfhi(b.x) + qv[2] * bflo(b.y) + qv[3] * bfhi(b.y) + qv[4] * bflo(b.z) + qv[5] * bfhi(b.z) + qv[6] * bflo(b.w) + qv[7] * bfhi(b.w);
            }
            float tv = 0.f; int ti = 0;
            for (int r = 0; r < PTOPK; ++r) {
                const float M = wave_max(fmaxf(v0, v1));
                const int cn = (v0 == M) ? lane : ((v1 == M) ? lane + 64 : 9999);
                const int nm = wave_min_i(cn);
                if (lane == r) { tv = M; ti = nm; }
                if (nm == lane) v0 = -3.0e38f;
                if (nm == lane + 64) v1 = -3.0e38f;
            }
            if (lane < 16) { tkv[wv][p][lane] = tv; tki[wv][p][lane] = ti; }
        }
        __builtin_amdgcn_s_waitcnt(0); __builtin_amdgcn_wave_barrier();
        float cs[4];
#pragma unroll
        for (int i = 0; i < 4; ++i) cs[i] = tkv[wv][0][lane >> 2] + tkv[wv][1][(lane & 3) * 4 + i];
        float sv = 0.f; int sf = 0;
        for (int r = 0; r < PTOPK; ++r) {
            const float M = wave_max(fmaxf(fmaxf(cs[0], cs[1]), fmaxf(cs[2], cs[3])));
            int cn = 9999;
#pragma unroll
            for (int i = 3; i >= 0; --i) if (cs[i] == M) cn = (lane >> 2) * 16 + (lane & 3) * 4 + i;
            const int nm = wave_min_i(cn);
            if (lane == r) { sv = M; sf = nm; }
#pragma unroll
            for (int i = 0; i < 4; ++i) if (nm == (lane >> 2) * 16 + (lane & 3) * 4 + i) cs[i] = -3.0e38f;
        }
        const float smax = __shfl(sv, 0);
        const float ge = lane < 16 ? __expf(sv - smax) : 0.f;
        const float gs = wave_sum(ge);
        if (lane < 16) { sel_e[wv][h * 16 + lane] = tki[wv][0][sf >> 4] * NKEYS + tki[wv][1][sf & 15]; sel_g[wv][h * 16 + lane] = ge / gs; }
        __builtin_amdgcn_s_waitcnt(0); __builtin_amdgcn_wave_barrier();
    }
    {
        const v4u* xr = (const v4u*)(x1b + (size_t)t * D) + lane;
        float xv[32];
#pragma unroll
        for (int j = 0; j < 4; ++j) { const v4u w = xr[64 * j]; xv[8 * j + 0] = bflo(w.x); xv[8 * j + 1] = bfhi(w.x); xv[8 * j + 2] = bflo(w.y); xv[8 * j + 3] = bfhi(w.y);
            xv[8 * j + 4] = bflo(w.z); xv[8 * j + 5] = bfhi(w.z); xv[8 * j + 6] = bflo(w.w); xv[8 * j + 7] = bfhi(w.w); }
        for (int k = 0; k < 128; ++k) {
            const v4u* ur = (const v4u*)(Ub + (size_t)sel_e[wv][k] * D) + lane; float dot = 0.f;
#pragma unroll
            for (int j = 0; j < 4; ++j) { const v4u w = ur[64 * j];
                dot += xv[8 * j + 0] * bflo(w.x) + xv[8 * j + 1] * bfhi(w.x) + xv[8 * j + 2] * bflo(w.y) + xv[8 * j + 3] * bfhi(w.y)
                     + xv[8 * j + 4] * bflo(w.z) + xv[8 * j + 5] * bfhi(w.z) + xv[8 * j + 6] * bflo(w.w) + xv[8 * j + 7] * bfhi(w.w); }
            dot = wave_sum(dot);
            const float hh = rstd2 * dot;
            if (lane == 0) act[wv][k] = 0.5f * hh * (1.f + erff(hh * 0.70710678118654752f)) * sel_g[wv][k];
        }
    }
    __builtin_amdgcn_s_waitcnt(0); __builtin_amdgcn_wave_barrier();
    {
        float acc[32];
#pragma unroll
        for (int i = 0; i < 32; ++i) acc[i] = 0.f;
        for (int k = 0; k < 128; ++k) {
            const v4u* vr = (const v4u*)(Vb + (size_t)sel_e[wv][k] * D) + lane; const float a = act[wv][k];
#pragma unroll
            for (int j = 0; j < 4; ++j) { const v4u w = vr[64 * j];
                acc[8 * j + 0] += a * bflo(w.x); acc[8 * j + 1] += a * bfhi(w.x); acc[8 * j + 2] += a * bflo(w.y); acc[8 * j + 3] += a * bfhi(w.y);
                acc[8 * j + 4] += a * bflo(w.z); acc[8 * j + 5] += a * bfhi(w.z); acc[8 * j + 6] += a * bflo(w.w); acc[8 * j + 7] += a * bfhi(w.w); }
        }
        f32x4* orow = (f32x4*)(out + (size_t)t * D);
#pragma unroll
        for (int j = 0; j < 4; ++j) {
            f32x4 a = orow[128 * j + 2 * lane], b = orow[128 * j + 2 * lane + 1];
            a.x += acc[8 * j + 0]; a.y += acc[8 * j + 1]; a.z += acc[8 * j + 2]; a.w += acc[8 * j + 3];
            b.x += acc[8 * j + 4]; b.y += acc[8 * j + 5]; b.z += acc[8 * j + 6]; b.w += acc[8 * j + 7];
            orow[128 * j + 2 * lane] = a; orow[128 * j + 2 * lane + 1] = b;
        }
    }
}

extern "C" void kernel_launch(void* const* d_in, const int* in_sizes, int n_in, void* d_out, int out_size, void* d_ws, size_t ws_size, hipStream_t stream) {
    if (n_in != 18 || in_sizes[0] != T * D || out_size != T * D || ws_size < WS_END) {
        fprintf(stderr, "kernel_launch: unexpected shapes: n_in %d in0 %d out %d ws %zu (need %zu)\n", n_in, n_in > 0 ? in_sizes[0] : -1, out_size, ws_size, (size_t)WS_END); return; }
    const float* x = (const float*)d_in[0]; const int* pos = (const int*)d_in[1]; const float* g1 = (const float*)d_in[2];
    const float* w_in = (const float*)d_in[3]; const float* b_in = (const float*)d_in[4]; const float* cw = (const float*)d_in[5];
    const float* cb = (const float*)d_in[6]; const float* lg = (const float*)d_in[7]; const float* lb = (const float*)d_in[8];
    const float* qg = (const float*)d_in[9]; const float* kg = (const float*)d_in[10]; const float* sinks = (const float*)d_in[11];
    const float* w_out = (const float*)d_in[12]; const float* g2 = (const float*)d_in[13]; const float* wq = (const float*)d_in[14];
    const float* skeys = (const float*)d_in[15]; const float* pu = (const float*)d_in[16]; const float* pv = (const float*)d_in[17];
    float* out = (float*)d_out; unsigned char* ws = (unsigned char*)d_ws;
    float* ssq = (float*)(ws + WS_SSQ); float* rstd1 = (float*)(ws + WS_RSTD1);
    bf16 *skb = (bf16*)(ws + WS_SKB), *w1t = (bf16*)(ws + WS_W1T), *w2t = (bf16*)(ws + WS_W2T), *w3t = (bf16*)(ws + WS_W3T);
    bf16 *xb = (bf16*)(ws + WS_XB), *proj = (bf16*)(ws + WS_PROJ), *mixed = (bf16*)(ws + WS_MIXED), *x1b = (bf16*)(ws + WS_X1B), *qp = (bf16*)(ws + WS_QP);
    bf16 *ub = (bf16*)(ws + WS_UB), *vb = (bf16*)(ws + WS_VB);

    k_prep_x<<<1024, 256, 0, stream>>>(x, xb, rstd1);
    k_transpose_w<<<dim3(INC / 32, D / 32), 256, 0, stream>>>(w_in, g1, w1t, D, INC);
    k_transpose_w<<<dim3(D / 32, D / 32), 256, 0, stream>>>(w_out, nullptr, w2t, D, D);
    k_transpose_w<<<dim3(D / 32, D / 32), 256, 0, stream>>>(wq, g2, w3t, D, D);
    k_convert<<<256, 256, 0, stream>>>(skeys, nullptr, skb, (size_t)16 * 128 * 128 / 8, 128);
    k_convert<<<2048, 256, 0, stream>>>(pu, g2, ub, (size_t)NEXP * D / 8, D);
    k_convert<<<2048, 256, 0, stream>>>(pv, nullptr, vb, (size_t)NEXP * D / 8, D);
    k_gemm_naive<EpiProj><<<dim3(INC / 64, T / 64), 256, 0, stream>>>(xb, w1t, T, INC, D, EpiProj{proj, rstd1, b_in});
    k_conv_naive<<<T, 256, 0, stream>>>(proj, cw, cb, lg, lb, mixed);
    k_attn_naive<<<T * NQH / 4, 256, 0, stream>>>(proj, pos, qg, kg, sinks, mixed);
    k_gemm_naive<EpiX1><<<dim3(D / 64, T / 64), 256, 0, stream>>>(mixed, w2t, T, D, D, EpiX1{x, out, x1b});
    k_ssq<<<1024, 256, 0, stream>>>(out, ssq);
    k_gemm_naive<EpiQp><<<dim3(D / 64, T / 64), 256, 0, stream>>>(x1b, w3t, T, D, D, EpiQp{qp, ssq});
    k_peer_naive<<<T / 4, 256, 0, stream>>>(qp, skb, x1b, ssq, ub, vb, out);
}
```

```cpp
#include <hip/hip_runtime.h>
#include <hip/hip_cooperative_groups.h>
namespace cg = cooperative_groups;
#include <cstdio>
#include <cstdint>

typedef unsigned short bf16;
typedef unsigned v4u __attribute__((ext_vector_type(4)));
typedef unsigned v2u __attribute__((ext_vector_type(2)));
typedef float f32x4 __attribute__((ext_vector_type(4)));

constexpr int T = 8192, D = 2048, CONVC = 1024, HD = 64, NQH = 16, NKVH = 2, ATT = 1024, KVC = 128;
constexpr int INC = 2 * CONVC + ATT + 2 * KVC;
constexpr int QOFF = 2 * CONVC, KOFF = QOFF + ATT, VOFF = KOFF + KVC;
constexpr int CK = 31, WIN = 128;
constexpr int NKEYS = 128, NEXP = NKEYS * NKEYS, PH = 8, PTOPK = 16;
constexpr float EPS = 1e-6f;

constexpr size_t MiB = 1u << 20;
constexpr size_t WS_CTL = 0, CTL_ZERO_BYTES = 1 * MiB;
constexpr size_t WS_SSQ = 64 * 1024;
constexpr size_t WS_RSTD1 = 1 * MiB;
constexpr size_t WS_ROPE = 3 * MiB;
constexpr size_t WS_SKB = 2 * MiB;
constexpr size_t WS_W1T = 4 * MiB;
constexpr size_t WS_W2T = 20 * MiB;
constexpr size_t WS_W3T = 28 * MiB;
constexpr size_t WS_XB = 64 * MiB;
constexpr size_t WS_PROJ = 96 * MiB;
constexpr size_t WS_MIXED = 160 * MiB;
constexpr size_t WS_X1B = 192 * MiB;
constexpr size_t WS_QP = 224 * MiB;
constexpr size_t WS_UB = 256 * MiB;
constexpr size_t WS_VB = 320 * MiB;
constexpr size_t WS_END = 384 * MiB;

__device__ __forceinline__ unsigned f2bf(float f) { unsigned u = __float_as_uint(f); return (u + 0x7fffu + ((u >> 16) & 1u)) >> 16; }
__device__ __forceinline__ unsigned pk2(float lo, float hi) { return f2bf(lo) | (f2bf(hi) << 16); }
__device__ __forceinline__ float bf2f(unsigned b) { return __uint_as_float(b << 16); }
__device__ __forceinline__ float bflo(unsigned w) { return __uint_as_float(w << 16); }
__device__ __forceinline__ float bfhi(unsigned w) { return __uint_as_float(w & 0xffff0000u); }
__device__ __forceinline__ float wave_sum(float v) {
#pragma unroll
    for (int o = 1; o < 64; o <<= 1) v += __shfl_xor(v, o);
    return v;
}
__device__ __forceinline__ float wave_max(float v) {
#pragma unroll
    for (int o = 1; o < 64; o <<= 1) v = fmaxf(v, __shfl_xor(v, o));
    return v;
}
__device__ __forceinline__ int wave_min_i(int v) {
#pragma unroll
    for (int o = 1; o < 64; o <<= 1) { int t = __shfl_xor(v, o); v = t < v ? t : v; }
    return v;
}

__global__ void k_prep_x(const float* __restrict__ x, bf16* __restrict__ xb, float* __restrict__ rstd1) {
    const int lane = threadIdx.x & 63, gw = (blockIdx.x * blockDim.x + threadIdx.x) >> 6, ngw = (gridDim.x * blockDim.x) >> 6;
    for (int row = gw; row < T; row += ngw) {
        const f32x4* xr = (const f32x4*)(x + (size_t)row * D) + lane;
        f32x4 v[8]; float ss = 0.f;
#pragma unroll
        for (int j = 0; j < 8; ++j) { v[j] = xr[64 * j]; ss += v[j].x * v[j].x + v[j].y * v[j].y + v[j].z * v[j].z + v[j].w * v[j].w; }
        ss = wave_sum(ss);
        if (lane == 0) rstd1[row] = rsqrtf(ss * (1.f / D) + EPS);
        v2u* o = (v2u*)(xb + (size_t)row * D) + lane;
#pragma unroll
        for (int j = 0; j < 8; ++j) { v2u w; w.x = pk2(v[j].x, v[j].y); w.y = pk2(v[j].z, v[j].w); o[64 * j] = w; }
    }
}
__global__ void k_transpose_w(const float* __restrict__ W, const float* __restrict__ g, bf16* __restrict__ Wt, int K, int N) {
    __shared__ float tile[32][33];
    const int k0 = blockIdx.y * 32, n0 = blockIdx.x * 32, tx = threadIdx.x & 31, ty = threadIdx.x >> 5;
    for (int i = ty; i < 32; i += 8) { const float gv = g ? g[k0 + i] : 1.f; tile[i][tx] = W[(size_t)(k0 + i) * N + n0 + tx] * gv; }
    __syncthreads();
    for (int i = ty; i < 32; i += 8) Wt[(size_t)(n0 + i) * K + k0 + tx] = (bf16)f2bf(tile[tx][i]);
}
__global__ void k_convert(const float* __restrict__ src, const float* __restrict__ g, bf16* __restrict__ dst, size_t n8, int ncol) {
    for (size_t i = (size_t)blockIdx.x * blockDim.x + threadIdx.x; i < n8; i += (size_t)gridDim.x * blockDim.x) {
        f32x4 a = ((const f32x4*)src)[2 * i], b = ((const f32x4*)src)[2 * i + 1];
        if (g) { const int c = (int)((i * 8) % ncol); const f32x4 ga = *(const f32x4*)(g + c), gb = *(const f32x4*)(g + c + 4); a = a * ga; b = b * gb; }
        v4u w; w.x = pk2(a.x, a.y); w.y = pk2(a.z, a.w); w.z = pk2(b.x, b.y); w.w = pk2(b.z, b.w);
        ((v4u*)dst)[i] = w;
    }
}

struct EpiProj { bf16* proj; const float* rstd1; const float* bias;
    __device__ void operator()(int r, int c, float v) const { proj[(size_t)r * INC + c] = (bf16)f2bf(rstd1[r] * v + bias[c]); } };
struct EpiX1 { const float* x; float* out; bf16* x1b;
    __device__ void operator()(int r, int c, float v) const { const float x1 = x[(size_t)r * D + c] + v; out[(size_t)r * D + c] = x1; x1b[(size_t)r * D + c] = (bf16)f2bf(x1); } };
struct EpiQp { bf16* qp; const float* ssq;
    __device__ void operator()(int r, int c, float v) const { qp[(size_t)r * D + c] = (bf16)f2bf(rsqrtf(ssq[r] * (1.f / D) + EPS) * v); } };
template <class Epi>
__global__ void __launch_bounds__(256) k_gemm_naive(const bf16* __restrict__ A, const bf16* __restrict__ Bt, int M, int N, int K, Epi E) {
    __shared__ float As[32][65], Bs[32][65];
    const int tx = threadIdx.x & 15, ty = threadIdx.x >> 4, m0 = blockIdx.y * 64, n0 = blockIdx.x * 64;
    float acc[4][4] = {};
    for (int k0 = 0; k0 < K; k0 += 32) {
        for (int i = threadIdx.x; i < 64 * 32; i += 256) { const int r = i >> 5, k = i & 31;
            As[k][r] = bf2f(A[(size_t)(m0 + r) * K + k0 + k]); Bs[k][r] = bf2f(Bt[(size_t)(n0 + r) * K + k0 + k]); }
        __syncthreads();
#pragma unroll 8
        for (int k = 0; k < 32; ++k) {
            float a[4], b[4];
#pragma unroll
            for (int i = 0; i < 4; ++i) { a[i] = As[k][ty * 4 + i]; b[i] = Bs[k][tx * 4 + i]; }
#pragma unroll
            for (int i = 0; i < 4; ++i)
#pragma unroll
                for (int j = 0; j < 4; ++j) acc[i][j] += a[i] * b[j];
        }
        __syncthreads();
    }
#pragma unroll
    for (int i = 0; i < 4; ++i)
#pragma unroll
        for (int j = 0; j < 4; ++j) E(m0 + ty * 4 + i, n0 + tx * 4 + j, acc[i][j]);
}

__global__ void __launch_bounds__(256) k_conv_naive(const bf16* __restrict__ proj, const float* __restrict__ cw, const float* __restrict__ cb,
                                                     const float* __restrict__ lg, const float* __restrict__ lb, bf16* __restrict__ mixed) {
    __shared__ float red[2][4];
    const int t = blockIdx.x, c0 = threadIdx.x * 4, lane = threadIdx.x & 63, wv = threadIdx.x >> 6;
    float acc[4];
#pragma unroll
    for (int i = 0; i < 4; ++i) acc[i] = cb[c0 + i];
    for (int j = 0; j < CK; ++j) {
        const int tt = t + j - (CK - 1);
        if (tt < 0) continue;
        const v2u a = *(const v2u*)(proj + (size_t)tt * INC + c0), gt = *(const v2u*)(proj + (size_t)tt * INC + CONVC + c0);
        const float av[4] = {bflo(a.x), bfhi(a.x), bflo(a.y), bfhi(a.y)}, gv[4] = {bflo(gt.x), bfhi(gt.x), bflo(gt.y), bfhi(gt.y)};
#pragma unroll
        for (int i = 0; i < 4; ++i) { const float h = av[i] / (1.f + __expf(-gv[i])); acc[i] += h * cw[j * CONVC + c0 + i]; }
    }
    float s = acc[0] + acc[1] + acc[2] + acc[3];
    s = wave_sum(s); if (lane == 0) red[0][wv] = s; __syncthreads();
    const float mu = (red[0][0] + red[0][1] + red[0][2] + red[0][3]) * (1.f / CONVC);
    float q = 0.f;
#pragma unroll
    for (int i = 0; i < 4; ++i) { const float d = acc[i] - mu; q += d * d; }
    q = wave_sum(q); if (lane == 0) red[1][wv] = q; __syncthreads();
    const float rstd = rsqrtf((red[1][0] + red[1][1] + red[1][2] + red[1][3]) * (1.f / CONVC) + EPS);
    float o[4];
#pragma unroll
    for (int i = 0; i < 4; ++i) { const float y = (acc[i] - mu) * rstd * lg[c0 + i] + lb[c0 + i]; o[i] = y / (1.f + __expf(-y)); }
    v2u w; w.x = pk2(o[0], o[1]); w.y = pk2(o[2], o[3]);
    *(v2u*)(mixed + (size_t)t * D + c0) = w;
}

__global__ void __launch_bounds__(256) k_attn_naive(const bf16* __restrict__ proj, const int* __restrict__ pos, const float* __restrict__ qg, const float* __restrict__ kg,
                                                     const float* __restrict__ sinks, bf16* __restrict__ mixed) {
    __shared__ float qs[4][64];
    const int lane = threadIdx.x & 63, wv = threadIdx.x >> 6, gw = blockIdx.x * 4 + wv;
    const int t = gw >> 4, hq = gw & 15, kvh = hq >> 3;
    {
        float q = bf2f(proj[(size_t)t * INC + QOFF + hq * HD + lane]);
        const float ss = wave_sum(q * q);
        q = q * rsqrtf(ss * (1.f / HD) + EPS) * qg[lane];
        const float pv = __shfl(q, lane < 8 ? lane + 8 : (lane < 16 ? lane - 8 : lane));
        if (lane < 16) { const int i = lane & 7; const float ang = (float)pos[t] * powf(500000.f, -(float)(2 * i) / 16.f); float sn, cs; sincosf(ang, &sn, &cs);
            q = lane < 8 ? q * cs - pv * sn : q * cs + pv * sn; }
        qs[wv][lane] = q;
    }
    __syncthreads();
    float sc[2];
#pragma unroll
    for (int h = 0; h < 2; ++h) {
        const int kp = t - lane - 64 * h;
        float s = -1e30f;
        if (kp >= 0) {
            const bf16* kr = proj + (size_t)kp * INC + KOFF + kvh * HD;
            float kv[64]; float ss = 0.f;
#pragma unroll
            for (int d = 0; d < 64; ++d) { kv[d] = bf2f(kr[d]); ss += kv[d] * kv[d]; }
            const float r = rsqrtf(ss * (1.f / HD) + EPS);
#pragma unroll
            for (int d = 0; d < 64; ++d) kv[d] = kv[d] * r * kg[d];
            const float p = (float)pos[kp];
#pragma unroll
            for (int i = 0; i < 8; ++i) { const float ang = p * powf(500000.f, -(float)(2 * i) / 16.f); float sn, cs; sincosf(ang, &sn, &cs);
                const float r1 = kv[i], r2 = kv[i + 8]; kv[i] = r1 * cs - r2 * sn; kv[i + 8] = r2 * cs + r1 * sn; }
            float dot = 0.f;
#pragma unroll
            for (int d = 0; d < 64; ++d) dot += kv[d] * qs[wv][d];
            s = dot * 0.125f;
        }
        sc[h] = s;
    }
    const float sink = sinks[hq];
    const float m = fmaxf(wave_max(fmaxf(sc[0], sc[1])), sink);
    const float p0 = (t - lane >= 0) ? __expf(sc[0] - m) : 0.f, p1 = (t - lane - 64 >= 0) ? __expf(sc[1] - m) : 0.f;
    const float denom = wave_sum(p0 + p1) + __expf(sink - m);
    float acc = 0.f;
    for (int j = 0; j < WIN; ++j) {
        const float pj = __shfl(j < 64 ? p0 : p1, j & 63);
        const int kp = t - j;
        if (kp >= 0) acc += pj * bf2f(proj[(size_t)kp * INC + VOFF + kvh * HD + lane]);
    }
    mixed[(size_t)t * D + CONVC + hq * HD + lane] = (bf16)f2bf(acc / denom);
}

__global__ void k_ssq(const float* __restrict__ x1, float* __restrict__ ssq) {
    const int lane = threadIdx.x & 63, gw = (blockIdx.x * blockDim.x + threadIdx.x) >> 6, ngw = (gridDim.x * blockDim.x) >> 6;
    for (int row = gw; row < T; row += ngw) {
        const f32x4* xr = (const f32x4*)(x1 + (size_t)row * D) + lane; float ss = 0.f;
#pragma unroll
        for (int j = 0; j < 8; ++j) { const f32x4 v = xr[64 * j]; ss += v.x * v.x + v.y * v.y + v.z * v.z + v.w * v.w; }
        ss = wave_sum(ss); if (lane == 0) ssq[row] = ss;
    }
}

__global__ void __launch_bounds__(256) k_peer_naive(const bf16* __restrict__ qp, const bf16* __restrict__ skb, const bf16* __restrict__ x1b, const float* __restrict__ ssq,
                                                     const bf16* __restrict__ Ub, const bf16* __restrict__ Vb, float* __restrict__ out) {
    __shared__ float q_s[4][256];
    __shared__ float tkv[4][2][16];
    __shared__ int tki[4][2][16];
    __shared__ int sel_e[4][128];
    __shared__ float sel_g[4][128];
    __shared__ float act[4][128];
    const int lane = threadIdx.x & 63, wv = threadIdx.x >> 6, t = blockIdx.x * 4 + wv;
    const float rstd2 = rsqrtf(ssq[t] * (1.f / D) + EPS);
    for (int h = 0; h < PH; ++h) {
        for (int i = lane; i < 256; i += 64) q_s[wv][i] = bf2f(qp[(size_t)t * D + h * 256 + i]);
        __builtin_amdgcn_s_waitcnt(0); __builtin_amdgcn_wave_barrier();
        for (int p = 0; p < 2; ++p) {
            float v0 = 0.f, v1 = 0.f;
            const bf16* k0 = skb + ((size_t)(h * 2 + p) * NKEYS + lane) * 128, * k1 = k0 + 64 * 128;
            for (int c8 = 0; c8 < 16; ++c8) {
                const v4u a = ((const v4u*)k0)[c8], b = ((const v4u*)k1)[c8]; const float* qv = &q_s[wv][p * 128 + c8 * 8];
                v0 += qv[0] * bflo(a.x) + qv[1] * bfhi(a.x) + qv[2] * bflo(a.y) + qv[3] * bfhi(a.y) + qv[4] * bflo(a.z) + qv[5] * bfhi(a.z) + qv[6] * bflo(a.w) + qv[7] * bfhi(a.w);
                v1 += qv[0] * bflo(b.x) + qv[1] * bfhi(b.x) + qv[2] * bflo(b.y) + qv[3] * bfhi(b.y) + qv[4] * bflo(b.z) + qv[5] * bfhi(b.z) + qv[6] * bflo(b.w) + qv[7] * bfhi(b.w);
            }
            float tv = 0.f; int ti = 0;
            for (int r = 0; r < PTOPK; ++r) {
                const float M = wave_max(fmaxf(v0, v1));
                const int cn = (v0 == M) ? lane : ((v1 == M) ? lane + 64 : 9999);
                const int nm = wave_min_i(cn);
                if (lane == r) { tv = M; ti = nm; }
                if (nm == lane) v0 = -3.0e38f;
                if (nm == lane + 64) v1 = -3.0e38f;
            }
            if (lane < 16) { tkv[wv][p][lane] = tv; tki[wv][p][lane] = ti; }
        }
        __builtin_amdgcn_s_waitcnt(0); __builtin_amdgcn_wave_barrier();
        float cs[4];
#pragma unroll
        for (int i = 0; i < 4; ++i) cs[i] = tkv[wv][0][lane >> 2] + tkv[wv][1][(lane & 3) * 4 + i];
        float sv = 0.f; int sf = 0;
        for (int r = 0; r < PTOPK; ++r) {
            const float M = wave_max(fmaxf(fmaxf(cs[0], cs[1]), fmaxf(cs[2], cs[3])));
            int cn = 9999;
#pragma unroll
            for (int i = 3; i >= 0; --i) if (cs[i] == M) cn = (lane >> 2) * 16 + (lane & 3) * 4 + i;
            const int nm = wave_min_i(cn);
            if (lane == r) { sv = M; sf = nm; }
#pragma unroll
            for (int i = 0; i < 4; ++i) if (nm == (lane >> 2) * 16 + (lane & 3) * 4 + i) cs[i] = -3.0e38f;
        }
        const float smax = __shfl(sv, 0);
        const float ge = lane < 16 ? __expf(sv - smax) : 0.f;
        const float gs = wave_sum(ge);
        if (lane < 16) { sel_e[wv][h * 16 + lane] = tki[wv][0][sf >> 4] * NKEYS + tki[wv][1][sf & 15]; sel_g[wv][h * 16 + lane] = ge / gs; }
        __builtin_amdgcn_s_waitcnt(0); __builtin_amdgcn_wave_barrier();
    }
    {
        const v4u* xr = (const v4u*)(x1b + (size_t)t * D) + lane;
        float xv[32];
#pragma unroll
        for (int j = 0; j < 4; ++j) { const v4u w = xr[64 * j]; xv[8 * j + 0] = bflo(w.x); xv[8 * j + 1] = bfhi(w.x); xv[8 * j + 2] = bflo(w.y); xv[8 * j + 3] = bfhi(w.y);
            xv[8 * j + 4] = bflo(w.z); xv[8 * j + 5] = bfhi(w.z); xv[8 * j + 6] = bflo(w.w); xv[8 * j + 7] = bfhi(w.w); }
        for (int k = 0; k < 128; ++k) {
            const v4u* ur = (const v4u*)(Ub + (size_t)sel_e[wv][k] * D) + lane; float dot = 0.f;
#pragma unroll
            for (int j = 0; j < 4; ++j) { const v4u w = ur[64 * j];
                dot += xv[8 * j + 0] * bflo(w.x) + xv[8 * j + 1] * bfhi(w.x) + xv[8 * j + 2] * bflo(w.y) + xv[8 * j + 3] * bfhi(w.y)
                     + xv[8 * j + 4] * bflo(w.z) + xv[8 * j + 5] * bfhi(w.z) + xv[8 * j + 6] * bflo(w.w) + xv[8 * j + 7] * bfhi(w.w); }
            dot = wave_sum(dot);
            const float hh = rstd2 * dot;
            if (lane == 0) act[wv][k] = 0.5f * hh * (1.f + erff(hh * 0.70710678118654752f)) * sel_g[wv][k];
        }
    }
    __builtin_amdgcn_s_waitcnt(0); __builtin_amdgcn_wave_barrier();
    {
        float acc[32];
#pragma unroll
        for (int i = 0; i < 32; ++i) acc[i] = 0.f;
        for (int k = 0; k < 128; ++k) {
            const v4u* vr = (const v4u*)(Vb + (size_t)sel_e[wv][k] * D) + lane; const float a = act[wv][k];
#pragma unroll
            for (int j = 0; j < 4; ++j) { const v4u w = vr[64 * j];
                acc[8 * j + 0] += a * bflo(w.x); acc[8 * j + 1] += a * bfhi(w.x); acc[8 * j + 2] += a * bflo(w.y); acc[8 * j + 3] += a * bfhi(w.y);
                acc[8 * j + 4] += a * bflo(w.z); acc[8 * j + 5] += a * bfhi(w.z); acc[8 * j + 6] += a * bflo(w.w); acc[8 * j + 7] += a * bfhi(w.w); }
        }
        f32x4* orow = (f32x4*)(out + (size_t)t * D);
#pragma unroll
        for (int j = 0; j < 4; ++j) {
            f32x4 a = orow[128 * j + 2 * lane], b = orow[128 * j + 2 * lane + 1];
            a.x += acc[8 * j + 0]; a.y += acc[8 * j + 1]; a.z += acc[8 * j + 2]; a.w += acc[8 * j + 3];
            b.x += acc[8 * j + 4]; b.y += acc[8 * j + 5]; b.z += acc[8 * j + 6]; b.w += acc[8 * j + 7];
            orow[128 * j + 2 * lane] = a; orow[128 * j + 2 * lane + 1] = b;
        }
    }
}


namespace pg8 {
#define PG8_LAS __attribute__((address_space(3)))
typedef unsigned short bf16_t;
typedef short bf16x8 __attribute__((ext_vector_type(8)));
typedef float f32x4 __attribute__((ext_vector_type(4)));
typedef unsigned u32x4 __attribute__((ext_vector_type(4)));
constexpr int BM = 256, BK = 64, HALF = 128, HTB = HALF * BK * 2  , STAGE_BYTES = 8 * HTB, NXCD = 8, WGM = 8;

__host__ __device__ __forceinline__ int lds_byte(int r, int c) { const int st = (r >> 4) * 2 + (c >> 5), rr = r & 15, cc = c & 31, ob = rr * 64 + cc * 2; return st * 1024 + (ob ^ (((ob >> 9) & 1) << 5)); }
__host__ __device__ __forceinline__ void stage_rc(int b, int& R, int& C) { const int st = b / 1024, sb = b % 1024, swz = sb ^ (((sb >> 9) & 1) << 5); R = (st >> 1) * 16 + swz / 64; C = (st & 1) * 32 + (swz % 64) / 2; }
__host__ __device__ __forceinline__ int perm32(int rho) { const int n = rho >> 4, i = rho & 15; return 8 * (i >> 2) + 4 * n + (i & 3); }

struct Unit { int pm, pn; };
struct Gemm { const bf16_t* A; const bf16_t* Bt; int M, N, K; };

struct StaticOrder {
    int nM, nN, nwg, G, c;
    __host__ __device__ void init(int M, int N, int G_, int c_) { nM = M / BM; nN = N / BM; nwg = nM * nN; G = G_; c = c_; }
    __host__ __device__ bool next(int i, Unit& u) const {
        const long L = (long)i * G + c; if (L >= nwg) return false;
        int wgid = (int)L; { const int q = nwg / NXCD, r = nwg % NXCD, xcd = wgid % NXCD, off = wgid / NXCD; wgid = (xcd < r ? xcd * (q + 1) : r * (q + 1) + (xcd - r) * q) + off; }
        const int nig = WGM * nN, gid = wgid / nig, fm = gid * WGM, gsz = (nM - fm) < WGM ? (nM - fm) : WGM;
        u.pm = fm + ((wgid % nig) % gsz); u.pn = (wgid % nig) / gsz; return true;
    }
    __device__ __forceinline__ void a_ready(const Unit&) const {}
    __device__ __forceinline__ void done(const Unit&) const {}
};

__device__ __forceinline__ unsigned cvt_pk_bf16(float lo, float hi) { unsigned r; asm volatile("v_cvt_pk_bf16_f32 %0, %1, %2" : "=v"(r) : "v"(lo), "v"(hi)); return r; }

template <bool RSQ> struct EpiScaleBf16 {
    static constexpr bool PERM = true, AFTER_DRAIN = false;
    bf16_t* O; int ldc; const float* sv; const float* bias;
    __device__ __forceinline__ void operator()(const f32x4 (&acc)[2][2][4][2], const Unit& u, int wr, int wc, int fr, int fq) const {
        const int row0 = u.pm * BM + wr * 64 + fr, col0 = u.pn * BM + wc * 32 + 8 * fq;
        f32x4 bv[2][2];
#pragma unroll
        for (int bj = 0; bj < 2; ++bj)
#pragma unroll
            for (int n = 0; n < 2; ++n) bv[bj][n] = bias ? *(const f32x4*)(bias + col0 + bj * HALF + 4 * n) : (f32x4){0.f, 0.f, 0.f, 0.f};
#pragma unroll
        for (int ai = 0; ai < 2; ++ai)
#pragma unroll
            for (int m = 0; m < 4; ++m) { const int r = row0 + ai * HALF + m * 16; float s = sv[r]; if (RSQ) s = rsqrtf(s * (1.0f / 2048.0f) + 1e-6f);
                bf16_t* rowp = O + (size_t)r * ldc + col0;
#pragma unroll
                for (int bj = 0; bj < 2; ++bj) { const f32x4 v0 = acc[ai][bj][m][0] * s + bv[bj][0], v1 = acc[ai][bj][m][1] * s + bv[bj][1];
                    u32x4 w; w.x = cvt_pk_bf16(v0[0], v0[1]); w.y = cvt_pk_bf16(v0[2], v0[3]); w.z = cvt_pk_bf16(v1[0], v1[1]); w.w = cvt_pk_bf16(v1[2], v1[3]);
                    *(u32x4*)(rowp + bj * HALF) = w; } }
    }
};
struct EpiResid {
    static constexpr bool PERM = true, AFTER_DRAIN = false;
    const float* X; float* out; bf16_t* x1b; float* ssq; int ldc;
    __device__ __forceinline__ void operator()(const f32x4 (&acc)[2][2][4][2], const Unit& u, int wr, int wc, int fr, int fq) const {
        const int row0 = u.pm * BM + wr * 64 + fr, col0 = u.pn * BM + wc * 32 + 8 * fq;
#pragma unroll
        for (int ai = 0; ai < 2; ++ai)
#pragma unroll
            for (int m = 0; m < 4; ++m) { const int r = row0 + ai * HALF + m * 16; const size_t off = (size_t)r * ldc + col0; float q = 0.f;
#pragma unroll
                for (int bj = 0; bj < 2; ++bj) {
                    const f32x4 v0 = *(const f32x4*)(X + off + bj * HALF) + acc[ai][bj][m][0], v1 = *(const f32x4*)(X + off + bj * HALF + 4) + acc[ai][bj][m][1];
                    *(f32x4*)(out + off + bj * HALF) = v0; *(f32x4*)(out + off + bj * HALF + 4) = v1;
                    u32x4 w; w.x = cvt_pk_bf16(v0[0], v0[1]); w.y = cvt_pk_bf16(v0[2], v0[3]); w.z = cvt_pk_bf16(v1[0], v1[1]); w.w = cvt_pk_bf16(v1[2], v1[3]);
                    *(u32x4*)(x1b + off + bj * HALF) = w;
                    q += (v0[0] * v0[0] + v0[1] * v0[1]) + (v0[2] * v0[2] + v0[3] * v0[3]) + (v1[0] * v1[0] + v1[1] * v1[1]) + (v1[2] * v1[2] + v1[3] * v1[3]); }
                q += __shfl_xor(q, 16); q += __shfl_xor(q, 32);
                if (fq == 0) atomicAdd(ssq + r, q);
                asm volatile("" ::: "memory"); }
    }
};
template <class Epi, class Sched, bool ALIGN_EPI = false, bool SP2 = false>
__device__ __forceinline__ void gemm_phase(PG8_LAS unsigned char* lds, const Gemm g, const Sched& S, const Epi& E) {
    const int tid = threadIdx.x, wid = __builtin_amdgcn_readfirstlane(tid >> 6), lane = tid & 63, wr = wid >> 2, wc = wid & 3, fr = lane & 15, fq = lane >> 4;
    const int K = g.K, nt = K / BK;
    unsigned voffA[2], voffB[2];
#pragma unroll
    for (int i = 0; i < 2; ++i) { int R, C; stage_rc(tid * 16 + i * 8192, R, C); const int Rb = Epi::PERM ? ((R & ~31) + perm32(R & 31)) : R;
        voffA[i] = (unsigned)(R * K + C) * 2u; voffB[i] = (unsigned)(Rb * K + C) * 2u; }
    const size_t kstep = (size_t)(BK * 2);
    const size_t hstep = (size_t)HALF * K * 2;
    const size_t tstep = 2 * hstep;
    const unsigned ldsw = (unsigned)wid * 1024u;
    const int aoff = lds_byte(wr * 64 + fr, fq * 8), boff = lds_byte(wc * 32 + fr, fq * 8);
#define PG8_SA(b, h) (((b) * 2 + (h)) * HTB)
#define PG8_SB(b, h) ((4 + (b) * 2 + (h)) * HTB)
#define PG8_STAGE(bufoff, gbase, voff) do { _Pragma("unroll") for (int _i = 0; _i < 2; ++_i) \
        __builtin_amdgcn_global_load_lds((const unsigned*)((const char*)(gbase) + (voff)[_i]), (PG8_LAS unsigned*)(lds + (bufoff) + ldsw + _i * 8192), 16, 0, 0); } while (0)
#define PG8_LDA(dst, b, h) do { _Pragma("unroll") for (int m = 0; m < 4; ++m) _Pragma("unroll") for (int k = 0; k < 2; ++k) dst[m][k] = *(const PG8_LAS bf16x8*)(lds + PG8_SA(b, h) + aoff + m * 2048 + k * 1024); } while (0)
#define PG8_LDB(dst, b, h) do { _Pragma("unroll") for (int n = 0; n < 2; ++n) _Pragma("unroll") for (int k = 0; k < 2; ++k) dst[n][k] = *(const PG8_LAS bf16x8*)(lds + PG8_SB(b, h) + boff + n * 2048 + k * 1024); } while (0)
#define PG8_MMA(ai, bj, At, Bt) do { __builtin_amdgcn_s_setprio(1); _Pragma("unroll") for (int m = 0; m < 4; ++m) _Pragma("unroll") for (int n = 0; n < 2; ++n) _Pragma("unroll") for (int k = 0; k < 2; ++k) \
        acc[ai][bj][m][n] = __builtin_amdgcn_mfma_f32_16x16x32_bf16(Bt[n][k], At[m][k], acc[ai][bj][m][n], 0, 0, 0); __builtin_amdgcn_s_setprio(0); } while (0)
#define PG8_WAIT_V(n) asm volatile("s_waitcnt vmcnt(" #n ")" ::: "memory")
#define PG8_WAIT_L(n) asm volatile("s_waitcnt lgkmcnt(" #n ")" ::: "memory")
#define PG8_BAR __builtin_amdgcn_s_barrier()
#define PG8_SCHED __builtin_amdgcn_sched_barrier(0)
    Unit cur, nxt; int ui = 0;
    if (!S.next(0, cur)) return;
    f32x4 acc[2][2][4][2];
#pragma unroll
    for (int a = 0; a < 2; ++a)
#pragma unroll
        for (int b = 0; b < 2; ++b)
#pragma unroll
            for (int m = 0; m < 4; ++m)
#pragma unroll
                for (int n = 0; n < 2; ++n) acc[a][b][m][n] = (f32x4){0.f, 0.f, 0.f, 0.f};
    bf16x8 At[4][2], B0[2][2], B1[2][2];
    const char* cA = (const char*)g.A + (size_t)cur.pm * tstep; const char* cB = (const char*)g.Bt + (size_t)cur.pn * tstep;
    S.a_ready(cur);
    if constexpr (SP2) {
        PG8_STAGE(PG8_SB(0, 0), cB, voffB); PG8_STAGE(PG8_SB(0, 1), cB + hstep, voffB); PG8_STAGE(PG8_SA(0, 0), cA, voffA); PG8_STAGE(PG8_SA(0, 1), cA + hstep, voffA);
        if (wr == 1) PG8_BAR;
        PG8_WAIT_V(2); PG8_BAR;
        PG8_STAGE(PG8_SB(1, 0), cB + kstep, voffB); PG8_STAGE(PG8_SA(1, 0), cA + kstep, voffA); PG8_STAGE(PG8_SB(1, 1), cB + hstep + kstep, voffB);
        PG8_WAIT_V(6); PG8_BAR;
    } else {
        PG8_STAGE(PG8_SB(0, 0), cB, voffB); PG8_STAGE(PG8_SA(0, 0), cA, voffA); PG8_STAGE(PG8_SB(0, 1), cB + hstep, voffB); PG8_STAGE(PG8_SA(0, 1), cA + hstep, voffA);
        if (wr == 1) PG8_BAR;
        PG8_WAIT_V(4); PG8_BAR;
        PG8_STAGE(PG8_SB(1, 0), cB + kstep, voffB); PG8_STAGE(PG8_SA(1, 0), cA + kstep, voffA); PG8_STAGE(PG8_SB(1, 1), cB + hstep + kstep, voffB);
        PG8_WAIT_V(6); PG8_BAR;
    }
    for (;;) {
        const bool has_next = S.next(ui + 1, nxt);
        const char* nA = has_next ? (const char*)g.A + (size_t)nxt.pm * tstep : cA; const char* nB = has_next ? (const char*)g.Bt + (size_t)nxt.pn * tstep : cB;
        for (int t = 0; t < nt; t += 2) {
            const bool last = (t == nt - 2);
            const char* a1 = cA + (size_t)(t + 1) * kstep;
            const char* a2 = last ? nA : cA + (size_t)(t + 2) * kstep; const char* b2 = last ? nB : cB + (size_t)(t + 2) * kstep;
            const char* a3 = a2 + kstep; const char* b3 = b2 + kstep;
            if (last && has_next) S.a_ready(nxt);
            if constexpr (SP2) {
            PG8_LDB(B0, 0, 0); PG8_LDB(B1, 0, 1); PG8_SCHED; PG8_LDA(At, 0, 0); PG8_STAGE(PG8_SA(1, 1), a1 + hstep, voffA);
            PG8_WAIT_V(8); PG8_WAIT_L(0); PG8_BAR; PG8_MMA(0, 0, At, B0); PG8_MMA(0, 1, At, B1); PG8_BAR; PG8_SCHED;
            PG8_LDA(At, 0, 1); PG8_STAGE(PG8_SB(0, 0), b2, voffB); PG8_STAGE(PG8_SB(0, 1), b2 + hstep, voffB); PG8_STAGE(PG8_SA(0, 0), a2, voffA);
            PG8_WAIT_V(8); PG8_WAIT_L(0); PG8_BAR; PG8_MMA(1, 0, At, B0); PG8_MMA(1, 1, At, B1); PG8_BAR; PG8_SCHED;
            PG8_LDB(B0, 1, 0); PG8_LDB(B1, 1, 1); PG8_SCHED; PG8_LDA(At, 1, 0); PG8_STAGE(PG8_SA(0, 1), a2 + hstep, voffA);
            PG8_WAIT_V(8); PG8_WAIT_L(0); PG8_BAR; PG8_MMA(0, 0, At, B0); PG8_MMA(0, 1, At, B1); PG8_BAR; PG8_SCHED;
            PG8_LDA(At, 1, 1); PG8_STAGE(PG8_SB(1, 0), b3, voffB); PG8_STAGE(PG8_SB(1, 1), b3 + hstep, voffB); PG8_STAGE(PG8_SA(1, 0), a3, voffA);
            PG8_WAIT_V(8); PG8_WAIT_L(0); PG8_BAR; PG8_MMA(1, 0, At, B0); PG8_MMA(1, 1, At, B1); PG8_BAR; PG8_SCHED;
            } else {
            PG8_LDB(B0, 0, 0); PG8_SCHED; PG8_LDA(At, 0, 0); PG8_STAGE(PG8_SA(1, 1), a1 + hstep, voffA);
            PG8_WAIT_L(8); PG8_BAR; PG8_WAIT_L(0); PG8_MMA(0, 0, At, B0); PG8_BAR; PG8_SCHED;
            PG8_LDB(B1, 0, 1); PG8_STAGE(PG8_SB(0, 0), b2, voffB);
            PG8_BAR; PG8_WAIT_L(0); PG8_MMA(0, 1, At, B1); PG8_BAR;
            PG8_LDA(At, 0, 1); PG8_STAGE(PG8_SA(0, 0), a2, voffA);
            PG8_BAR; PG8_WAIT_L(0); PG8_MMA(1, 0, At, B0); PG8_BAR; PG8_SCHED;
            PG8_STAGE(PG8_SB(0, 1), b2 + hstep, voffB);
            PG8_WAIT_V(6); PG8_BAR; PG8_MMA(1, 1, At, B1); PG8_BAR;
            PG8_LDB(B0, 1, 0); PG8_SCHED; PG8_LDA(At, 1, 0); PG8_STAGE(PG8_SA(0, 1), a2 + hstep, voffA);
            PG8_WAIT_L(8); PG8_BAR; PG8_WAIT_L(0); PG8_MMA(0, 0, At, B0); PG8_BAR; PG8_SCHED;
            PG8_LDB(B1, 1, 1); PG8_STAGE(PG8_SB(1, 0), b3, voffB);
            PG8_BAR; PG8_WAIT_L(0); PG8_MMA(0, 1, At, B1); PG8_BAR;
            PG8_LDA(At, 1, 1); PG8_STAGE(PG8_SA(1, 0), a3, voffA);
            PG8_BAR; PG8_WAIT_L(0); PG8_MMA(1, 0, At, B0); PG8_BAR; PG8_SCHED;
            PG8_STAGE(PG8_SB(1, 1), b3 + hstep, voffB);
            PG8_WAIT_V(6); PG8_BAR; PG8_MMA(1, 1, At, B1); PG8_BAR;
            }
        }
        if constexpr (ALIGN_EPI) { if (wr == 0) PG8_BAR; }
        if constexpr (!Epi::AFTER_DRAIN) { E(acc, cur, wr, wc, fr, fq); S.done(cur); }
        if (!has_next) break;
#pragma unroll
        for (int a = 0; a < 2; ++a)
#pragma unroll
            for (int b = 0; b < 2; ++b)
#pragma unroll
                for (int m = 0; m < 4; ++m)
#pragma unroll
                    for (int n = 0; n < 2; ++n) acc[a][b][m][n] = (f32x4){0.f, 0.f, 0.f, 0.f};
        cur = nxt; cA = nA; cB = nB; ++ui;
        if constexpr (ALIGN_EPI) { if (wr == 1) PG8_BAR; }
    }
    PG8_WAIT_V(0);
    if constexpr (!ALIGN_EPI) { if (wr == 0) PG8_BAR; }
    PG8_BAR;
    if constexpr (Epi::AFTER_DRAIN) { E.fused(acc, cur, wr, wc, fr, fq, lds, wid, lane); S.done(cur); }
#undef PG8_SA
#undef PG8_SB
#undef PG8_STAGE
#undef PG8_LDA
#undef PG8_LDB
#undef PG8_MMA
#undef PG8_WAIT_V
#undef PG8_WAIT_L
#undef PG8_BAR
#undef PG8_SCHED
}
}

#ifndef PG8_SP2
#define PG8_SP2 true
#endif
#ifndef PG8_ALIGN
#define PG8_ALIGN true
#endif

constexpr int NWAVES = 8, NTHR = 512;
constexpr int LDS_BYTES = 160 * 1024;
#define LAS __attribute__((address_space(3)))
typedef short bf16x8 __attribute__((ext_vector_type(8)));
typedef float f32x16 __attribute__((ext_vector_type(16)));
typedef float f32x2 __attribute__((ext_vector_type(2)));
#define LDS_WAIT() asm volatile("s_waitcnt lgkmcnt(0)" ::: "memory")

struct Args {
    const float* x; const int* pos; const float* g1; const float* w_in; const float* b_in; const float* cw; const float* cb; const float* lg; const float* lb;
    const float* qg; const float* kg; const float* sinks; const float* w_out; const float* g2; const float* wq; const float* skeys; const float* pu; const float* pv;
    float* out; unsigned char* ws; int ph_lo, ph_hi;
};

__device__ __forceinline__ void p0_transpose_item(const float* W, const float* g, int K, int N, bf16* WT, LAS float* scr, int item, int lane) {
    const int nblk = N / 32, kb = item / nblk, nb = item % nblk, k0 = 64 * kb, n0 = 32 * nb;
#pragma unroll 8
    for (int i = 0; i < 32; ++i) { const int kk = 2 * i + (lane >> 5); const float gv = g ? g[k0 + kk] : 1.f; scr[kk * 33 + (lane & 31)] = W[(size_t)(k0 + kk) * N + n0 + (lane & 31)] * gv; }
    LDS_WAIT(); asm volatile("" ::: "memory");
    const int c = lane & 7;
#pragma unroll
    for (int j = 0; j < 4; ++j) { const int n = (lane >> 3) + 8 * j; const LAS float* s = scr + (8 * c) * 33 + n;
        v4u o; o.x = pk2(s[0 * 33], s[1 * 33]); o.y = pk2(s[2 * 33], s[3 * 33]); o.z = pk2(s[4 * 33], s[5 * 33]); o.w = pk2(s[6 * 33], s[7 * 33]);
        *(v4u*)(WT + (size_t)(n0 + n) * K + k0 + 8 * c) = o; }
    LDS_WAIT(); asm volatile("" ::: "memory");
}
__device__ __forceinline__ void p0_convert(const float* src, const float* g, bf16* dst, size_t n8, int ncol, size_t gtid, size_t nthr) {
    for (size_t i = gtid; i < n8; i += nthr) {
        f32x4 a = ((const f32x4*)src)[2 * i], b = ((const f32x4*)src)[2 * i + 1];
        if (g) { const int c = (int)((i * 8) % ncol); const f32x4 ga = *(const f32x4*)(g + c), gb = *(const f32x4*)(g + c + 4); a = a * ga; b = b * gb; }
        v4u w; w.x = pk2(a.x, a.y); w.y = pk2(a.z, a.w); w.z = pk2(b.x, b.y); w.w = pk2(b.z, b.w);
        ((v4u*)dst)[i] = w;
    }
}
__device__ __forceinline__ void p0_prologue(const Args& A, LAS unsigned char* lds, int vcu, int G, int tid) {
    const int lane = tid & 63, wave = tid >> 6;
    unsigned char* ws = A.ws;
    LAS float* scr = (LAS float*)(lds + wave * 16384);
    const int gw = vcu * NWAVES + wave, NGW = G * NWAVES;
    constexpr int I_1 = (D / 64) * (INC / 32), I_2 = (D / 64) * (D / 32);
    for (int it = gw; it < I_1 + 2 * I_2; it += NGW) {
        int r = it;
        if (r < I_1) { p0_transpose_item(A.w_in, A.g1, D, INC, (bf16*)(ws + WS_W1T), scr, r, lane); continue; } r -= I_1;
        if (r < I_2) { p0_transpose_item(A.w_out, nullptr, D, D, (bf16*)(ws + WS_W2T), scr, r, lane); continue; } r -= I_2;
        p0_transpose_item(A.wq, A.g2, D, D, (bf16*)(ws + WS_W3T), scr, r, lane);
    }
    {
        bf16* xb = (bf16*)(ws + WS_XB); float* rstd1 = (float*)(ws + WS_RSTD1);
        for (int row = gw; row < T; row += NGW) {
            const f32x4* xr = (const f32x4*)(A.x + (size_t)row * D) + lane;
            f32x4 v[8]; float ss = 0.f;
#pragma unroll
            for (int j = 0; j < 8; ++j) { v[j] = xr[64 * j]; ss += v[j].x * v[j].x + v[j].y * v[j].y + v[j].z * v[j].z + v[j].w * v[j].w; }
            ss = wave_sum(ss);
            if (lane == 0) rstd1[row] = rsqrtf(ss * (1.f / D) + EPS);
            v2u* o = (v2u*)(xb + (size_t)row * D) + lane;
#pragma unroll
            for (int j = 0; j < 8; ++j) { v2u w; w.x = pk2(v[j].x, v[j].y); w.y = pk2(v[j].z, v[j].w); o[64 * j] = w; }
        }
    }
    const size_t gtid = (size_t)vcu * NTHR + tid, nthr = (size_t)G * NTHR;
    {
        float* rope = (float*)(ws + WS_ROPE);
        for (size_t i = gtid; i < (size_t)T * 8; i += nthr) { const int t = (int)(i >> 3), f = (int)(i & 7);
            const float ang = (float)A.pos[t] * powf(500000.f, -(float)(2 * f) / 16.f); float sn, cs; sincosf(ang, &sn, &cs);
            rope[t * 16 + f] = cs; rope[t * 16 + 8 + f] = sn; }
    }
    p0_convert(A.skeys, nullptr, (bf16*)(ws + WS_SKB), (size_t)16 * 128 * 128 / 8, 128, gtid, nthr);
    p0_convert(A.pu, A.g2, (bf16*)(ws + WS_UB), (size_t)NEXP * D / 8, D, gtid, nthr);
    p0_convert(A.pv, nullptr, (bf16*)(ws + WS_VB), (size_t)NEXP * D / 8, D, gtid, nthr);
}

__device__ __forceinline__ void conv_unit(const Args& A, LAS unsigned char* lds, int t0, int tid) {
    const bf16* proj = (const bf16*)(A.ws + WS_PROJ); bf16* mixed = (bf16*)(A.ws + WS_MIXED);
    const int lane = tid & 63, wave = tid >> 6;
    LAS bf16* H = (LAS bf16*)lds;
    for (int it = tid; it < 62 * 128; it += NTHR) {
        const int row = it >> 7, ch = (it & 127) * 8, tt = t0 - 30 + row;
        v4u w = {0u, 0u, 0u, 0u};
        if (tt >= 0) {
            const v4u a = *(const v4u*)(proj + (size_t)tt * INC + ch), g = *(const v4u*)(proj + (size_t)tt * INC + CONVC + ch);
            const unsigned aw[4] = {a.x, a.y, a.z, a.w}, gw_[4] = {g.x, g.y, g.z, g.w}; unsigned ow[4];
#pragma unroll
            for (int q = 0; q < 4; ++q) { const float h0 = bflo(aw[q]) / (1.f + __expf(-bflo(gw_[q]))), h1 = bfhi(aw[q]) / (1.f + __expf(-bfhi(gw_[q]))); ow[q] = pk2(h0, h1); }
            w.x = ow[0]; w.y = ow[1]; w.z = ow[2]; w.w = ow[3];
        }
        *(LAS v4u*)(H + row * 1024 + ch) = w;
    }
    __syncthreads();
    LAS float* Cf = (LAS float*)(lds + 62 * 1024 * 2);
    float w0[CK], w1[CK];
#pragma unroll
    for (int j = 0; j < CK; ++j) { const f32x2 wv = *(const f32x2*)(A.cw + j * CONVC + 2 * tid); w0[j] = wv.x; w1[j] = wv.y; }
    const f32x2 bv = *(const f32x2*)(A.cb + 2 * tid);
#pragma unroll 1
    for (int c = 0; c < 4; ++c) {
        float a0[8], a1[8];
#pragma unroll
        for (int tt = 0; tt < 8; ++tt) { a0[tt] = bv.x; a1[tt] = bv.y; }
        const LAS bf16* Hc = H + (8 * c) * 1024 + 2 * tid;
#pragma unroll
        for (int i = 0; i < 38; ++i) {
            const unsigned hw = *(const LAS unsigned*)(Hc + i * 1024); const float h0 = bflo(hw), h1 = bfhi(hw);
#pragma unroll
            for (int tt = 0; tt < 8; ++tt) { const int j = i - tt; if (j >= 0 && j < CK) { a0[tt] += h0 * w0[j]; a1[tt] += h1 * w1[j]; } }
        }
#pragma unroll
        for (int tt = 0; tt < 8; ++tt) *(LAS f32x2*)(Cf + tt * 1024 + 2 * tid) = (f32x2){a0[tt], a1[tt]};
        __syncthreads();
        {
            const int tt = wave;
            f32x4 v[4]; float s = 0.f;
#pragma unroll
            for (int j = 0; j < 4; ++j) { v[j] = *(const LAS f32x4*)(Cf + tt * 1024 + 4 * lane + 256 * j); s += (v[j].x + v[j].y) + (v[j].z + v[j].w); }
            const float mu = wave_sum(s) * (1.f / CONVC); float s2 = 0.f;
#pragma unroll
            for (int j = 0; j < 4; ++j) { v[j] = v[j] - mu; s2 += (v[j].x * v[j].x + v[j].y * v[j].y) + (v[j].z * v[j].z + v[j].w * v[j].w); }
            const float rstd = rsqrtf(wave_sum(s2) * (1.f / CONVC) + EPS);
#pragma unroll
            for (int j = 0; j < 4; ++j) {
                const int ch = 4 * lane + 256 * j; const f32x4 gg = *(const f32x4*)(A.lg + ch), bb = *(const f32x4*)(A.lb + ch);
                f32x4 y = v[j] * rstd * gg + bb;
                y.x = y.x / (1.f + __expf(-y.x)); y.y = y.y / (1.f + __expf(-y.y)); y.z = y.z / (1.f + __expf(-y.z)); y.w = y.w / (1.f + __expf(-y.w));
                v2u w; w.x = pk2(y.x, y.y); w.y = pk2(y.z, y.w);
                *(v2u*)(mixed + (size_t)(t0 + 8 * c + tt) * D + ch) = w;
            }
        }
        __syncthreads();
    }
}

__device__ __forceinline__ void attn_unit(const Args& A, LAS unsigned char* lds, int qb, int kvh, int gh, int tid) {
    const bf16* proj = (const bf16*)(A.ws + WS_PROJ); bf16* mixed = (bf16*)(A.ws + WS_MIXED); const float* rope = (const float*)(A.ws + WS_ROPE);
    constexpr int KST = 72, VST = 260;
    LAS bf16* Kn = (LAS bf16*)lds;
    LAS bf16* Vt = (LAS bf16*)(lds + 256 * KST * 2);
    const int lane = tid & 63, wave = tid >> 6;
    const int kbase = (qb - 1) * 128;
    {
        const int key = tid >> 1, half = tid & 1, kp = kbase + key;
        float v[32]; unsigned vw[16];
        if (kp >= 0) {
            const v4u* kr = (const v4u*)(proj + (size_t)kp * INC + KOFF + kvh * HD + 32 * half);
            const v4u* vr = (const v4u*)(proj + (size_t)kp * INC + VOFF + kvh * HD + 32 * half);
#pragma unroll
            for (int j = 0; j < 4; ++j) { const v4u w = kr[j]; v[8 * j + 0] = bflo(w.x); v[8 * j + 1] = bfhi(w.x); v[8 * j + 2] = bflo(w.y); v[8 * j + 3] = bfhi(w.y);
                v[8 * j + 4] = bflo(w.z); v[8 * j + 5] = bfhi(w.z); v[8 * j + 6] = bflo(w.w); v[8 * j + 7] = bfhi(w.w);
                const v4u u = vr[j]; vw[4 * j + 0] = u.x; vw[4 * j + 1] = u.y; vw[4 * j + 2] = u.z; vw[4 * j + 3] = u.w; }
        } else {
#pragma unroll
            for (int i = 0; i < 32; ++i) v[i] = 0.f;
#pragma unroll
            for (int i = 0; i < 16; ++i) vw[i] = 0u;
        }
        float ss = 0.f;
#pragma unroll
        for (int i = 0; i < 32; ++i) ss += v[i] * v[i];
        ss += __shfl_xor(ss, 1);
        const float r = rsqrtf(ss * (1.f / HD) + EPS);
#pragma unroll
        for (int i = 0; i < 32; ++i) v[i] = v[i] * r * A.kg[32 * half + i];
        if (half == 0 && kp >= 0) {
#pragma unroll
            for (int i = 0; i < 8; ++i) { const float cs = rope[kp * 16 + i], sn = rope[kp * 16 + 8 + i]; const float r1 = v[i], r2 = v[i + 8]; v[i] = r1 * cs - r2 * sn; v[i + 8] = r2 * cs + r1 * sn; }
        }
#pragma unroll
        for (int j = 0; j < 4; ++j) { v4u w; w.x = pk2(v[8 * j + 0], v[8 * j + 1]); w.y = pk2(v[8 * j + 2], v[8 * j + 3]); w.z = pk2(v[8 * j + 4], v[8 * j + 5]); w.w = pk2(v[8 * j + 6], v[8 * j + 7]);
            *(LAS v4u*)(Kn + key * KST + 32 * half + 8 * j) = w; }
#pragma unroll
        for (int i = 0; i < 16; ++i) { Vt[(32 * half + 2 * i) * VST + key] = (bf16)(vw[i] & 0xffffu); Vt[(32 * half + 2 * i + 1) * VST + key] = (bf16)(vw[i] >> 16); }
    }
    __syncthreads();
    const int hq = kvh * 8 + gh * 4 + (wave >> 1);
    const float sink = A.sinks[hq];
    const int h = lane >> 5, lq = lane & 31;
#pragma unroll 1
    for (int si = 0; si < 2; ++si) {
        const int s = (wave & 1) * 2 + si;
        const int qtok = qb * 128 + 32 * s + lq;
        bf16x8 qf[4];
        {
            float qv[4][8]; float ss = 0.f;
#pragma unroll
            for (int ks = 0; ks < 4; ++ks) { const v4u w = *(const v4u*)(proj + (size_t)qtok * INC + QOFF + hq * HD + 16 * ks + 8 * h);
                qv[ks][0] = bflo(w.x); qv[ks][1] = bfhi(w.x); qv[ks][2] = bflo(w.y); qv[ks][3] = bfhi(w.y); qv[ks][4] = bflo(w.z); qv[ks][5] = bfhi(w.z); qv[ks][6] = bflo(w.w); qv[ks][7] = bfhi(w.w);
#pragma unroll
                for (int j = 0; j < 8; ++j) ss += qv[ks][j] * qv[ks][j]; }
            ss += __shfl_xor(ss, 32);
            const float r = rsqrtf(ss * (1.f / HD) + EPS) * 0.125f;
#pragma unroll
            for (int ks = 0; ks < 4; ++ks)
#pragma unroll
                for (int j = 0; j < 8; ++j) qv[ks][j] = qv[ks][j] * r * A.qg[16 * ks + 8 * h + j];
#pragma unroll
            for (int j = 0; j < 8; ++j) { const float pv = __shfl_xor(qv[0][j], 32); const float cs = rope[qtok * 16 + j], sn = rope[qtok * 16 + 8 + j];
                qv[0][j] = h == 0 ? qv[0][j] * cs - pv * sn : qv[0][j] * cs + pv * sn; }
#pragma unroll
            for (int ks = 0; ks < 4; ++ks) { v4u w; w.x = pk2(qv[ks][0], qv[ks][1]); w.y = pk2(qv[ks][2], qv[ks][3]); w.z = pk2(qv[ks][4], qv[ks][5]); w.w = pk2(qv[ks][6], qv[ks][7]);
                qf[ks] = __builtin_bit_cast(bf16x8, w); }
        }
        f32x16 S[5];
#pragma unroll
        for (int k5 = 0; k5 < 5; ++k5) {
            f32x16 c;
#pragma unroll
            for (int i = 0; i < 16; ++i) c[i] = 0.f;
#pragma unroll
            for (int ks = 0; ks < 4; ++ks) { const bf16x8 a = *(const LAS bf16x8*)(Kn + (32 * (s + k5) + lq) * KST + 16 * ks + 8 * h);
                c = __builtin_amdgcn_mfma_f32_32x32x16_bf16(a, qf[ks], c, 0, 0, 0); }
            S[k5] = c;
        }
        float m = sink;
#pragma unroll
        for (int k5 = 0; k5 < 5; ++k5)
#pragma unroll
            for (int i = 0; i < 16; ++i) {
                const int keyb = 32 * (s + k5) + (i & 3) + 8 * (i >> 2) + 4 * h, diff = 128 + 32 * s + lq - keyb;
                const bool valid = diff >= 0 && diff < WIN && (qb > 0 || keyb >= 128);
                const float sv = valid ? S[k5][i] : -1e30f; S[k5][i] = sv; m = fmaxf(m, sv);
            }
        m = fmaxf(m, __shfl_xor(m, 32));
        float l = 0.f;
#pragma unroll
        for (int k5 = 0; k5 < 5; ++k5)
#pragma unroll
            for (int i = 0; i < 16; ++i) { const float p = __expf(S[k5][i] - m); S[k5][i] = p; l += p; }
        l += __shfl_xor(l, 32);
        l += __expf(sink - m);
        f32x16 O0, O1;
#pragma unroll
        for (int i = 0; i < 16; ++i) { O0[i] = 0.f; O1[i] = 0.f; }
#pragma unroll
        for (int k5 = 0; k5 < 5; ++k5)
#pragma unroll
            for (int s2 = 0; s2 < 2; ++s2) {
                v4u pw; pw.x = pk2(S[k5][8 * s2 + 0], S[k5][8 * s2 + 1]); pw.y = pk2(S[k5][8 * s2 + 2], S[k5][8 * s2 + 3]);
                pw.z = pk2(S[k5][8 * s2 + 4], S[k5][8 * s2 + 5]); pw.w = pk2(S[k5][8 * s2 + 6], S[k5][8 * s2 + 7]);
                const bf16x8 pf = __builtin_bit_cast(bf16x8, pw);
                const int kk = 32 * (s + k5) + 16 * s2 + 4 * h;
                { const v2u lo = *(const LAS v2u*)(Vt + lq * VST + kk), hi = *(const LAS v2u*)(Vt + lq * VST + kk + 8);
                  v4u aw; aw.x = lo.x; aw.y = lo.y; aw.z = hi.x; aw.w = hi.y;
                  O0 = __builtin_amdgcn_mfma_f32_32x32x16_bf16(__builtin_bit_cast(bf16x8, aw), pf, O0, 0, 0, 0); }
                { const v2u lo = *(const LAS v2u*)(Vt + (32 + lq) * VST + kk), hi = *(const LAS v2u*)(Vt + (32 + lq) * VST + kk + 8);
                  v4u aw; aw.x = lo.x; aw.y = lo.y; aw.z = hi.x; aw.w = hi.y;
                  O1 = __builtin_amdgcn_mfma_f32_32x32x16_bf16(__builtin_bit_cast(bf16x8, aw), pf, O1, 0, 0, 0); }
            }
        const float inv = 1.f / l;
        bf16* orow = mixed + (size_t)qtok * D + CONVC + hq * HD;
#pragma unroll
        for (int g = 0; g < 4; ++g) {
            v2u w0; w0.x = pk2(O0[4 * g + 0] * inv, O0[4 * g + 1] * inv); w0.y = pk2(O0[4 * g + 2] * inv, O0[4 * g + 3] * inv);
            *(v2u*)(orow + 8 * g + 4 * h) = w0;
            v2u w1; w1.x = pk2(O1[4 * g + 0] * inv, O1[4 * g + 1] * inv); w1.y = pk2(O1[4 * g + 2] * inv, O1[4 * g + 3] * inv);
            *(v2u*)(orow + 32 + 8 * g + 4 * h) = w1;
        }
    }
    __syncthreads();
}

__device__ __forceinline__ unsigned mono_key(float f) { const unsigned u = __float_as_uint(f); return u ^ ((unsigned)((int)u >> 31) | 0x80000000u); }
__device__ __forceinline__ float mono_val(unsigned k) { const unsigned u = (k & 0x80000000u) ? (k ^ 0x80000000u) : ~k; return __uint_as_float(u); }
__host__ __device__ constexpr int cand_a(int c) { return c < 16 ? 0 : c < 24 ? 1 : c < 29 ? 2 : c < 33 ? 3 : c < 36 ? 4 : c < 38 ? 5 : c < 40 ? 6 : c < 42 ? 7 : c - 34; }
__host__ __device__ constexpr int cand_b(int c) { return c < 16 ? c : c < 24 ? c - 16 : c < 29 ? c - 24 : c < 33 ? c - 29 : c < 36 ? c - 33 : c < 38 ? c - 36 : c < 40 ? c - 38 : c < 42 ? c - 40 : 0; }

__device__ __forceinline__ void peer_tile(const Args& A, LAS unsigned char* lds, int t0, int tid) {
    const bf16* qp = (const bf16*)(A.ws + WS_QP); const bf16* skb = (const bf16*)(A.ws + WS_SKB); const bf16* x1b = (const bf16*)(A.ws + WS_X1B);
    const bf16* Ub = (const bf16*)(A.ws + WS_UB); const bf16* Vb = (const bf16*)(A.ws + WS_VB); const float* ssq = (const float*)(A.ws + WS_SSQ);
    LAS unsigned* TK = (LAS unsigned*)lds;
    LAS int* SE = (LAS int*)(lds + 32768);
    LAS float* SG = (LAS float*)(lds + 49152);
    LAS float* ACT = (LAS float*)(lds + 65536);
    const int lane = tid & 63, wave = tid >> 6, h = lane >> 5, lq = lane & 31;
#pragma unroll 1
    for (int hp2 = 0; hp2 < 2; ++hp2) {
        const int hp = 2 * wave + hp2;
        bf16x8 qf[8];
#pragma unroll
        for (int ks = 0; ks < 8; ++ks) qf[ks] = *(const bf16x8*)(qp + (size_t)(t0 + lq) * D + hp * 128 + 16 * ks + 8 * h);
        unsigned key[64];
#pragma unroll
        for (int nt = 0; nt < 4; ++nt) {
            f32x16 c;
#pragma unroll
            for (int i = 0; i < 16; ++i) c[i] = 0.f;
#pragma unroll
            for (int ks = 0; ks < 8; ++ks) { const bf16x8 a = *(const bf16x8*)(skb + (size_t)(hp * 128 + 32 * nt + lq) * 128 + 16 * ks + 8 * h);
                c = __builtin_amdgcn_mfma_f32_32x32x16_bf16(a, qf[ks], c, 0, 0, 0); }
#pragma unroll
            for (int i = 0; i < 16; ++i) { const int n = 32 * nt + (i & 3) + 8 * (i >> 2) + 4 * h; key[16 * nt + i] = (mono_key(c[i]) & ~127u) | (unsigned)(127 - n); }
        }
#pragma unroll 1
        for (int r = 0; r < PTOPK; ++r) {
            unsigned M = key[0];
#pragma unroll
            for (int i = 1; i < 64; ++i) M = M > key[i] ? M : key[i];
            const unsigned pm = (unsigned)__shfl_xor((int)M, 32);
            M = M > pm ? M : pm;
            if (h == 0) TK[((lq * 16) + hp) * 16 + r] = M;
#pragma unroll
            for (int i = 0; i < 64; ++i) key[i] = key[i] == M ? 0u : key[i];
        }
    }
    __syncthreads();
    {
        const int ca = cand_a(lane < 50 ? lane : 0), cb_ = cand_b(lane < 50 ? lane : 0), myflat = ca * 16 + cb_;
#pragma unroll 1
        for (int i = 0; i < 32; ++i) {
            const int p = wave * 32 + i, t = p >> 3, hd = p & 7;
            const unsigned k1 = TK[(t * 16 + 2 * hd) * 16 + ca], k2 = TK[(t * 16 + 2 * hd + 1) * 16 + cb_];
            const float s = lane < 50 ? mono_val(k1 & ~127u) + mono_val(k2 & ~127u) : -3.0e38f;
            int rank = 0;
#pragma unroll
            for (int c = 0; c < 50; ++c) { const float sc = __uint_as_float((unsigned)__builtin_amdgcn_readlane((int)__float_as_uint(s), c)); const int fl = cand_a(c) * 16 + cand_b(c);
                rank += (sc > s || (sc == s && fl < myflat)) ? 1 : 0; }
            const bool sel = lane < 50 && rank < PTOPK;
            const float smax = __uint_as_float((unsigned)__builtin_amdgcn_readlane((int)__float_as_uint(s), 0));
            const float ge = sel ? __expf(s - smax) : 0.f;
            const float gs = wave_sum(ge);
            if (sel) { SE[t * 128 + hd * 16 + rank] = (int)(127u - (k1 & 127u)) * NKEYS + (int)(127u - (k2 & 127u)); SG[t * 128 + hd * 16 + rank] = ge / gs; }
        }
    }
    __syncthreads();
#pragma unroll 1
    for (int q = 0; q < 4; ++q) {
        const int tl = wave * 4 + q, t = t0 + tl;
        const float rstd2 = rsqrtf(ssq[t] * (1.f / D) + EPS);
        const v4u* xr = (const v4u*)(x1b + (size_t)t * D) + lane;
        float xv[32];
#pragma unroll
        for (int j = 0; j < 4; ++j) { const v4u w = xr[64 * j]; xv[8 * j + 0] = bflo(w.x); xv[8 * j + 1] = bfhi(w.x); xv[8 * j + 2] = bflo(w.y); xv[8 * j + 3] = bfhi(w.y);
            xv[8 * j + 4] = bflo(w.z); xv[8 * j + 5] = bfhi(w.z); xv[8 * j + 6] = bflo(w.w); xv[8 * j + 7] = bfhi(w.w); }
#pragma unroll 4
        for (int k = 0; k < 128; ++k) {
            const v4u* ur = (const v4u*)(Ub + (size_t)(SE[tl * 128 + k] & (NEXP - 1)) * D) + lane; float dot = 0.f;
#pragma unroll
            for (int j = 0; j < 4; ++j) { const v4u w = ur[64 * j];
                dot += xv[8 * j + 0] * bflo(w.x) + xv[8 * j + 1] * bfhi(w.x) + xv[8 * j + 2] * bflo(w.y) + xv[8 * j + 3] * bfhi(w.y)
                     + xv[8 * j + 4] * bflo(w.z) + xv[8 * j + 5] * bfhi(w.z) + xv[8 * j + 6] * bflo(w.w) + xv[8 * j + 7] * bfhi(w.w); }
            dot = wave_sum(dot);
            const float hh = rstd2 * dot;
            if (lane == 0) ACT[tl * 128 + k] = 0.5f * hh * (1.f + erff(hh * 0.70710678118654752f)) * SG[tl * 128 + k];
        }
    }
    __syncthreads();
#pragma unroll 1
    for (int q = 0; q < 4; ++q) {
        const int tl = wave * 4 + q, t = t0 + tl;
        float acc[32];
#pragma unroll
        for (int i = 0; i < 32; ++i) acc[i] = 0.f;
#pragma unroll 4
        for (int k = 0; k < 128; ++k) {
            const v4u* vr = (const v4u*)(Vb + (size_t)(SE[tl * 128 + k] & (NEXP - 1)) * D) + lane; const float a = ACT[tl * 128 + k];
#pragma unroll
            for (int j = 0; j < 4; ++j) { const v4u w = vr[64 * j];
                acc[8 * j + 0] += a * bflo(w.x); acc[8 * j + 1] += a * bfhi(w.x); acc[8 * j + 2] += a * bflo(w.y); acc[8 * j + 3] += a * bfhi(w.y);
                acc[8 * j + 4] += a * bflo(w.z); acc[8 * j + 5] += a * bfhi(w.z); acc[8 * j + 6] += a * bflo(w.w); acc[8 * j + 7] += a * bfhi(w.w); }
        }
        f32x4* orow = (f32x4*)(A.out + (size_t)t * D);
#pragma unroll
        for (int j = 0; j < 4; ++j) {
            f32x4 a = orow[128 * j + 2 * lane], b = orow[128 * j + 2 * lane + 1];
            a.x += acc[8 * j + 0]; a.y += acc[8 * j + 1]; a.z += acc[8 * j + 2]; a.w += acc[8 * j + 3];
            b.x += acc[8 * j + 4]; b.y += acc[8 * j + 5]; b.z += acc[8 * j + 6]; b.w += acc[8 * j + 7];
            orow[128 * j + 2 * lane] = a; orow[128 * j + 2 * lane + 1] = b;
        }
    }
    __syncthreads();
}

__global__ void __launch_bounds__(NTHR, 2) mega_fwd(Args args) {
    extern __shared__ __attribute__((aligned(16))) unsigned char lds_raw[];
    LAS unsigned char* lds = (LAS unsigned char*)lds_raw;
    cg::grid_group grid = cg::this_grid();
    const int tid = threadIdx.x, G = gridDim.x, bx = blockIdx.x;
    const int vcu = (G % 8 == 0) ? (bx % 8) * (G / 8) + bx / 8 : bx;
    unsigned char* ws = args.ws;
    const int lo = args.ph_lo, hi = args.ph_hi;
#ifndef PH_MASK
#define PH_MASK 63
#endif
#define IN(k) (((PH_MASK >> (k)) & 1) && lo <= (k) && (k) < hi)
#define BOTH(k) (IN(k) && IN((k) + 1))
    if (IN(0)) { p0_prologue(args, lds, vcu, G, tid); if (BOTH(0)) grid.sync(); }
    if (IN(1)) {
        pg8::Gemm g{(const bf16*)(ws + WS_XB), (const bf16*)(ws + WS_W1T), T, INC, D}; pg8::StaticOrder S; S.init(T, INC, G, bx);
        pg8::EpiScaleBf16<false> E{(bf16*)(ws + WS_PROJ), INC, (const float*)(ws + WS_RSTD1), args.b_in};
        pg8::gemm_phase<pg8::EpiScaleBf16<false>, pg8::StaticOrder, PG8_ALIGN, PG8_SP2>(lds, g, S, E);
        if (BOTH(1)) grid.sync();
    }
    if (IN(2)) {
#ifndef NO_CONV
        for (int u = vcu; u < 256; u += G) conv_unit(args, lds, 32 * u, tid);
#endif
#ifndef NO_ATTN
        for (int u = vcu; u < 256; u += G) attn_unit(args, lds, u >> 2, (u >> 1) & 1, u & 1, tid);
#endif
        if (BOTH(2)) grid.sync();
    }
    if (IN(3)) {
        pg8::Gemm g{(const bf16*)(ws + WS_MIXED), (const bf16*)(ws + WS_W2T), T, D, D}; pg8::StaticOrder S; S.init(T, D, G, bx);
        pg8::EpiResid E{args.x, args.out, (bf16*)(ws + WS_X1B), (float*)(ws + WS_SSQ), D};
        pg8::gemm_phase<pg8::EpiResid, pg8::StaticOrder, PG8_ALIGN, PG8_SP2>(lds, g, S, E);
        if (BOTH(3)) grid.sync();
    }
    if (IN(4)) {
        pg8::Gemm g{(const bf16*)(ws + WS_X1B), (const bf16*)(ws + WS_W3T), T, D, D}; pg8::StaticOrder S; S.init(T, D, G, bx);
        pg8::EpiScaleBf16<true> E{(bf16*)(ws + WS_QP), D, (const float*)(ws + WS_SSQ), nullptr};
        pg8::gemm_phase<pg8::EpiScaleBf16<true>, pg8::StaticOrder, PG8_ALIGN, PG8_SP2>(lds, g, S, E);
        if (BOTH(4)) grid.sync();
    }
    if (IN(5)) {
        for (int u = vcu; u < T / 32; u += G) peer_tile(args, lds, 32 * u, tid);
    }
#undef IN
#undef BOTH
}

__global__ void k_rope_naive(const int* __restrict__ pos, float* __restrict__ rope) {
    const int i = blockIdx.x * blockDim.x + threadIdx.x; if (i >= T * 8) return;
    const int t = i >> 3, f = i & 7; const float ang = (float)pos[t] * powf(500000.f, -(float)(2 * f) / 16.f); float sn, cs; sincosf(ang, &sn, &cs);
    rope[t * 16 + f] = cs; rope[t * 16 + 8 + f] = sn;
}

#ifndef MK_MODE
#define MK_MODE 1
#endif
#ifndef NAIVE_MASK
#define NAIVE_MASK 0
#endif
extern "C" void kernel_launch(void* const* d_in, const int* in_sizes, int n_in, void* d_out, int out_size, void* d_ws, size_t ws_size, hipStream_t stream) {
    static int grid = 0;
    if (grid == 0) {
        if (n_in != 18 || in_sizes[0] != T * D || out_size != T * D || ws_size < WS_END) {
            fprintf(stderr, "kernel_launch: unexpected shapes: n_in %d in0 %d out %d ws %zu (need %zu)\n", n_in, n_in > 0 ? in_sizes[0] : -1, out_size, ws_size, (size_t)WS_END); grid = -1; return; }
        int dev = 0, cus = 0, per_cu = 0;
        if (hipGetDevice(&dev) != hipSuccess || hipDeviceGetAttribute(&cus, hipDeviceAttributeMultiprocessorCount, dev) != hipSuccess) { fprintf(stderr, "kernel_launch: device query failed\n"); grid = -1; return; }
        if (hipFuncSetAttribute((const void*)mega_fwd, hipFuncAttributeMaxDynamicSharedMemorySize, LDS_BYTES) != hipSuccess) { fprintf(stderr, "kernel_launch: hipFuncSetAttribute failed\n"); grid = -1; return; }
        if (hipOccupancyMaxActiveBlocksPerMultiprocessor(&per_cu, (const void*)mega_fwd, NTHR, LDS_BYTES) != hipSuccess || per_cu < 1) {
            fprintf(stderr, "kernel_launch: occupancy query says %d blocks per CU\n", per_cu); (void)hipGetLastError(); per_cu = 1; }
        grid = cus * 1;
        (void)per_cu;
    }
    if (grid < 0) return;
    unsigned char* ws = (unsigned char*)d_ws;
    hipMemsetAsync(ws + WS_CTL, 0, CTL_ZERO_BYTES, stream);
    Args a{};
    a.x = (const float*)d_in[0]; a.pos = (const int*)d_in[1]; a.g1 = (const float*)d_in[2]; a.w_in = (const float*)d_in[3]; a.b_in = (const float*)d_in[4];
    a.cw = (const float*)d_in[5]; a.cb = (const float*)d_in[6]; a.lg = (const float*)d_in[7]; a.lb = (const float*)d_in[8]; a.qg = (const float*)d_in[9];
    a.kg = (const float*)d_in[10]; a.sinks = (const float*)d_in[11]; a.w_out = (const float*)d_in[12]; a.g2 = (const float*)d_in[13]; a.wq = (const float*)d_in[14];
    a.skeys = (const float*)d_in[15]; a.pu = (const float*)d_in[16]; a.pv = (const float*)d_in[17];
    a.out = (float*)d_out; a.ws = ws;
#if MK_MODE == 1
    a.ph_lo = 0; a.ph_hi = 6;
    void* kargs[] = {&a};
    hipError_t e = hipLaunchCooperativeKernel((const void*)mega_fwd, dim3(grid), dim3(NTHR), kargs, LDS_BYTES, stream);
    if (e != hipSuccess) fprintf(stderr, "kernel_launch: cooperative launch failed: %s (grid %d)\n", hipGetErrorString(e), grid);
#else
    float* ssq = (float*)(ws + WS_SSQ); float* rstd1 = (float*)(ws + WS_RSTD1); float* rope = (float*)(ws + WS_ROPE);
    bf16 *skb = (bf16*)(ws + WS_SKB), *w1t = (bf16*)(ws + WS_W1T), *w2t = (bf16*)(ws + WS_W2T), *w3t = (bf16*)(ws + WS_W3T);
    bf16 *xb = (bf16*)(ws + WS_XB), *proj = (bf16*)(ws + WS_PROJ), *mixed = (bf16*)(ws + WS_MIXED), *x1b = (bf16*)(ws + WS_X1B), *qp = (bf16*)(ws + WS_QP);
    bf16 *ub = (bf16*)(ws + WS_UB), *vb = (bf16*)(ws + WS_VB);
    for (int ph = 0; ph < 6; ++ph) {
        if (!((NAIVE_MASK >> ph) & 1)) { a.ph_lo = ph; a.ph_hi = ph + 1; hipLaunchKernelGGL(mega_fwd, dim3(grid), dim3(NTHR), LDS_BYTES, stream, a); continue; }
        switch (ph) {
        case 0:
            k_prep_x<<<1024, 256, 0, stream>>>(a.x, xb, rstd1);
            k_transpose_w<<<dim3(INC / 32, D / 32), 256, 0, stream>>>(a.w_in, a.g1, w1t, D, INC);
            k_transpose_w<<<dim3(D / 32, D / 32), 256, 0, stream>>>(a.w_out, nullptr, w2t, D, D);
            k_transpose_w<<<dim3(D / 32, D / 32), 256, 0, stream>>>(a.wq, a.g2, w3t, D, D);
            k_convert<<<256, 256, 0, stream>>>(a.skeys, nullptr, skb, (size_t)16 * 128 * 128 / 8, 128);
            k_convert<<<2048, 256, 0, stream>>>(a.pu, a.g2, ub, (size_t)NEXP * D / 8, D);
            k_convert<<<2048, 256, 0, stream>>>(a.pv, nullptr, vb, (size_t)NEXP * D / 8, D);
            k_rope_naive<<<T * 8 / 256, 256, 0, stream>>>(a.pos, rope);
            break;
        case 1: k_gemm_naive<EpiProj><<<dim3(INC / 64, T / 64), 256, 0, stream>>>(xb, w1t, T, INC, D, EpiProj{proj, rstd1, a.b_in}); break;
        case 2: k_conv_naive<<<T, 256, 0, stream>>>(proj, a.cw, a.cb, a.lg, a.lb, mixed);
                k_attn_naive<<<T * NQH / 4, 256, 0, stream>>>(proj, a.pos, a.qg, a.kg, a.sinks, mixed); break;
        case 3: k_gemm_naive<EpiX1><<<dim3(D / 64, T / 64), 256, 0, stream>>>(mixed, w2t, T, D, D, EpiX1{a.x, a.out, x1b});
                k_ssq<<<1024, 256, 0, stream>>>(a.out, ssq); break;
        case 4: k_gemm_naive<EpiQp><<<dim3(D / 64, T / 64), 256, 0, stream>>>(x1b, w3t, T, D, D, EpiQp{qp, ssq}); break;
        case 5: k_peer_naive<<<T / 4, 256, 0, stream>>>(qp, skb, x1b, ssq, ub, vb, a.out); break;
        }
    }
#endif
}
```

```cpp
#include <hip/hip_runtime.h>
#include <hip/hip_cooperative_groups.h>
namespace cg = cooperative_groups;
#include <cstdio>
#include <cstdint>

typedef unsigned short bf16;
typedef unsigned v4u __attribute__((ext_vector_type(4)));
typedef unsigned v2u __attribute__((ext_vector_type(2)));
typedef float f32x4 __attribute__((ext_vector_type(4)));

constexpr int T = 8192, D = 2048, CONVC = 1024, HD = 64, NQH = 16, NKVH = 2, ATT = 1024, KVC = 128;
constexpr int INC = 2 * CONVC + ATT + 2 * KVC;
constexpr int QOFF = 2 * CONVC, KOFF = QOFF + ATT, VOFF = KOFF + KVC;
constexpr int CK = 31, WIN = 128;
constexpr int NKEYS = 128, NEXP = NKEYS * NKEYS, PH = 8, PTOPK = 16;
constexpr float EPS = 1e-6f;

constexpr size_t MiB = 1u << 20;
constexpr size_t WS_CTL = 0, CTL_ZERO_BYTES = 1 * MiB;
constexpr size_t WS_SSQ = 64 * 1024;
constexpr size_t WS_RSTD1 = 1 * MiB;
constexpr size_t WS_ROPE = 3 * MiB;
constexpr size_t WS_SKB = 2 * MiB;
constexpr size_t WS_W1T = 4 * MiB;
constexpr size_t WS_W2T = 20 * MiB;
constexpr size_t WS_W3T = 28 * MiB;
constexpr size_t WS_XB = 64 * MiB;
constexpr size_t WS_PROJ = 96 * MiB;
constexpr size_t WS_MIXED = 160 * MiB;
constexpr size_t WS_X1B = 192 * MiB;
constexpr size_t WS_QP = 224 * MiB;
constexpr size_t WS_UB = 256 * MiB;
constexpr size_t WS_VB = 320 * MiB;
constexpr size_t WS_END = 384 * MiB;

__device__ __forceinline__ unsigned f2bf(float f) { unsigned u = __float_as_uint(f); return (u + 0x7fffu + ((u >> 16) & 1u)) >> 16; }
__device__ __forceinline__ unsigned pk2(float lo, float hi) { return f2bf(lo) | (f2bf(hi) << 16); }
__device__ __forceinline__ float bf2f(unsigned b) { return __uint_as_float(b << 16); }
__device__ __forceinline__ float bflo(unsigned w) { return __uint_as_float(w << 16); }
__device__ __forceinline__ float bfhi(unsigned w) { return __uint_as_float(w & 0xffff0000u); }
__device__ __forceinline__ float wave_sum(float v) {
#pragma unroll
    for (int o = 1; o < 64; o <<= 1) v += __shfl_xor(v, o);
    return v;
}
__device__ __forceinline__ float wave_max(float v) {
#pragma unroll
    for (int o = 1; o < 64; o <<= 1) v = fmaxf(v, __shfl_xor(v, o));
    return v;
}
__device__ __forceinline__ int wave_min_i(int v) {
#pragma unroll
    for (int o = 1; o < 64; o <<= 1) { int t = __shfl_xor(v, o); v = t < v ? t : v; }
    return v;
}

__global__ void k_prep_x(const float* __restrict__ x, bf16* __restrict__ xb, float* __restrict__ rstd1) {
    const int lane = threadIdx.x & 63, gw = (blockIdx.x * blockDim.x + threadIdx.x) >> 6, ngw = (gridDim.x * blockDim.x) >> 6;
    for (int row = gw; row < T; row += ngw) {
        const f32x4* xr = (const f32x4*)(x + (size_t)row * D) + lane;
        f32x4 v[8]; float ss = 0.f;
#pragma unroll
        for (int j = 0; j < 8; ++j) { v[j] = xr[64 * j]; ss += v[j].x * v[j].x + v[j].y * v[j].y + v[j].z * v[j].z + v[j].w * v[j].w; }
        ss = wave_sum(ss);
        if (lane == 0) rstd1[row] = rsqrtf(ss * (1.f / D) + EPS);
        v2u* o = (v2u*)(xb + (size_t)row * D) + lane;
#pragma unroll
        for (int j = 0; j < 8; ++j) { v2u w; w.x = pk2(v[j].x, v[j].y); w.y = pk2(v[j].z, v[j].w); o[64 * j] = w; }
    }
}
__global__ void k_transpose_w(const float* __restrict__ W, const float* __restrict__ g, bf16* __restrict__ Wt, int K, int N) {
    __shared__ float tile[32][33];
    const int k0 = blockIdx.y * 32, n0 = blockIdx.x * 32, tx = threadIdx.x & 31, ty = threadIdx.x >> 5;
    for (int i = ty; i < 32; i += 8) { const float gv = g ? g[k0 + i] : 1.f; tile[i][tx] = W[(size_t)(k0 + i) * N + n0 + tx] * gv; }
    __syncthreads();
    for (int i = ty; i < 32; i += 8) Wt[(size_t)(n0 + i) * K + k0 + tx] = (bf16)f2bf(tile[tx][i]);
}
__global__ void k_convert(const float* __restrict__ src, const float* __restrict__ g, bf16* __restrict__ dst, size_t n8, int ncol) {
    for (size_t i = (size_t)blockIdx.x * blockDim.x + threadIdx.x; i < n8; i += (size_t)gridDim.x * blockDim.x) {
        f32x4 a = ((const f32x4*)src)[2 * i], b = ((const f32x4*)src)[2 * i + 1];
        if (g) { const int c = (int)((i * 8) % ncol); const f32x4 ga = *(const f32x4*)(g + c), gb = *(const f32x4*)(g + c + 4); a = a * ga; b = b * gb; }
        v4u w; w.x = pk2(a.x, a.y); w.y = pk2(a.z, a.w); w.z = pk2(b.x, b.y); w.w = pk2(b.z, b.w);
        ((v4u*)dst)[i] = w;
    }
}

struct EpiProj { bf16* proj; const float* rstd1; const float* bias;
    __device__ void operator()(int r, int c, float v) const { proj[(size_t)r * INC + c] = (bf16)f2bf(rstd1[r] * v + bias[c]); } };
struct EpiX1 { const float* x; float* out; bf16* x1b;
    __device__ void operator()(int r, int c, float v) const { const float x1 = x[(size_t)r * D + c] + v; out[(size_t)r * D + c] = x1; x1b[(size_t)r * D + c] = (bf16)f2bf(x1); } };
struct EpiQp { bf16* qp; const float* ssq;
    __device__ void operator()(int r, int c, float v) const { qp[(size_t)r * D + c] = (bf16)f2bf(rsqrtf(ssq[r] * (1.f / D) + EPS) * v); } };
template <class Epi>
__global__ void __launch_bounds__(256) k_gemm_naive(const bf16* __restrict__ A, const bf16* __restrict__ Bt, int M, int N, int K, Epi E) {
    __shared__ float As[32][65], Bs[32][65];
    const int tx = threadIdx.x & 15, ty = threadIdx.x >> 4, m0 = blockIdx.y * 64, n0 = blockIdx.x * 64;
    float acc[4][4] = {};
    for (int k0 = 0; k0 < K; k0 += 32) {
        for (int i = threadIdx.x; i < 64 * 32; i += 256) { const int r = i >> 5, k = i & 31;
            As[k][r] = bf2f(A[(size_t)(m0 + r) * K + k0 + k]); Bs[k][r] = bf2f(Bt[(size_t)(n0 + r) * K + k0 + k]); }
        __syncthreads();
#pragma unroll 8
        for (int k = 0; k < 32; ++k) {
            float a[4], b[4];
#pragma unroll
            for (int i = 0; i < 4; ++i) { a[i] = As[k][ty * 4 + i]; b[i] = Bs[k][tx * 4 + i]; }
#pragma unroll
            for (int i = 0; i < 4; ++i)
#pragma unroll
                for (int j = 0; j < 4; ++j) acc[i][j] += a[i] * b[j];
        }
        __syncthreads();
    }
#pragma unroll
    for (int i = 0; i < 4; ++i)
#pragma unroll
        for (int j = 0; j < 4; ++j) E(m0 + ty * 4 + i, n0 + tx * 4 + j, acc[i][j]);
}

__global__ void __launch_bounds__(256) k_conv_naive(const bf16* __restrict__ proj, const float* __restrict__ cw, const float* __restrict__ cb,
                                                     const float* __restrict__ lg, const float* __restrict__ lb, bf16* __restrict__ mixed) {
    __shared__ float red[2][4];
    const int t = blockIdx.x, c0 = threadIdx.x * 4, lane = threadIdx.x & 63, wv = threadIdx.x >> 6;
    float acc[4];
#pragma unroll
    for (int i = 0; i < 4; ++i) acc[i] = cb[c0 + i];
    for (int j = 0; j < CK; ++j) {
        const int tt = t + j - (CK - 1);
        if (tt < 0) continue;
        const v2u a = *(const v2u*)(proj + (size_t)tt * INC + c0), gt = *(const v2u*)(proj + (size_t)tt * INC + CONVC + c0);
        const float av[4] = {bflo(a.x), bfhi(a.x), bflo(a.y), bfhi(a.y)}, gv[4] = {bflo(gt.x), bfhi(gt.x), bflo(gt.y), bfhi(gt.y)};
#pragma unroll
        for (int i = 0; i < 4; ++i) { const float h = av[i] / (1.f + __expf(-gv[i])); acc[i] += h * cw[j * CONVC + c0 + i]; }
    }
    float s = acc[0] + acc[1] + acc[2] + acc[3];
    s = wave_sum(s); if (lane == 0) red[0][wv] = s; __syncthreads();
    const float mu = (red[0][0] + red[0][1] + red[0][2] + red[0][3]) * (1.f / CONVC);
    float q = 0.f;
#pragma unroll
    for (int i = 0; i < 4; ++i) { const float d = acc[i] - mu; q += d * d; }
    q = wave_sum(q); if (lane == 0) red[1][wv] = q; __syncthreads();
    const float rstd = rsqrtf((red[1][0] + red[1][1] + red[1][2] + red[1][3]) * (1.f / CONVC) + EPS);
    float o[4];
#pragma unroll
    for (int i = 0; i < 4; ++i) { const float y = (acc[i] - mu) * rstd * lg[c0 + i] + lb[c0 + i]; o[i] = y / (1.f + __expf(-y)); }
    v2u w; w.x = pk2(o[0], o[1]); w.y = pk2(o[2], o[3]);
    *(v2u*)(mixed + (size_t)t * D + c0) = w;
}

__global__ void __launch_bounds__(256) k_attn_naive(const bf16* __restrict__ proj, const int* __restrict__ pos, const float* __restrict__ qg, const float* __restrict__ kg,
                                                     const float* __restrict__ sinks, bf16* __restrict__ mixed) {
    __shared__ float qs[4][64];
    const int lane = threadIdx.x & 63, wv = threadIdx.x >> 6, gw = blockIdx.x * 4 + wv;
    const int t = gw >> 4, hq = gw & 15, kvh = hq >> 3;
    {
        float q = bf2f(proj[(size_t)t * INC + QOFF + hq * HD + lane]);
        const float ss = wave_sum(q * q);
        q = q * rsqrtf(ss * (1.f / HD) + EPS) * qg[lane];
        const float pv = __shfl(q, lane < 8 ? lane + 8 : (lane < 16 ? lane - 8 : lane));
        if (lane < 16) { const int i = lane & 7; const float ang = (float)pos[t] * powf(500000.f, -(float)(2 * i) / 16.f); float sn, cs; sincosf(ang, &sn, &cs);
            q = lane < 8 ? q * cs - pv * sn : q * cs + pv * sn; }
        qs[wv][lane] = q;
    }
    __syncthreads();
    float sc[2];
#pragma unroll
    for (int h = 0; h < 2; ++h) {
        const int kp = t - lane - 64 * h;
        float s = -1e30f;
        if (kp >= 0) {
            const bf16* kr = proj + (size_t)kp * INC + KOFF + kvh * HD;
            float kv[64]; float ss = 0.f;
#pragma unroll
            for (int d = 0; d < 64; ++d) { kv[d] = bf2f(kr[d]); ss += kv[d] * kv[d]; }
            const float r = rsqrtf(ss * (1.f / HD) + EPS);
#pragma unroll
            for (int d = 0; d < 64; ++d) kv[d] = kv[d] * r * kg[d];
            const float p = (float)pos[kp];
#pragma unroll
            for (int i = 0; i < 8; ++i) { const float ang = p * powf(500000.f, -(float)(2 * i) / 16.f); float sn, cs; sincosf(ang, &sn, &cs);
                const float r1 = kv[i], r2 = kv[i + 8]; kv[i] = r1 * cs - r2 * sn; kv[i + 8] = r2 * cs + r1 * sn; }
            float dot = 0.f;
#pragma unroll
            for (int d = 0; d < 64; ++d) dot += kv[d] * qs[wv][d];
            s = dot * 0.125f;
        }
        sc[h] = s;
    }
    const float sink = sinks[hq];
    const float m = fmaxf(wave_max(fmaxf(sc[0], sc[1])), sink);
    const float p0 = (t - lane >= 0) ? __expf(sc[0] - m) : 0.f, p1 = (t - lane - 64 >= 0) ? __expf(sc[1] - m) : 0.f;
    const float denom = wave_sum(p0 + p1) + __expf(sink - m);
    float acc = 0.f;
    for (int j = 0; j < WIN; ++j) {
        const float pj = __shfl(j < 64 ? p0 : p1, j & 63);
        const int kp = t - j;
        if (kp >= 0) acc += pj * bf2f(proj[(size_t)kp * INC + VOFF + kvh * HD + lane]);
    }
    mixed[(size_t)t * D + CONVC + hq * HD + lane] = (bf16)f2bf(acc / denom);
}

__global__ void k_ssq(const float* __restrict__ x1, float* __restrict__ ssq) {
    const int lane = threadIdx.x & 63, gw = (blockIdx.x * blockDim.x + threadIdx.x) >> 6, ngw = (gridDim.x * blockDim.x) >> 6;
    for (int row = gw; row < T; row += ngw) {
        const f32x4* xr = (const f32x4*)(x1 + (size_t)row * D) + lane; float ss = 0.f;
#pragma unroll
        for (int j = 0; j < 8; ++j) { const f32x4 v = xr[64 * j]; ss += v.x * v.x + v.y * v.y + v.z * v.z + v.w * v.w; }
        ss = wave_sum(ss); if (lane == 0) ssq[row] = ss;
    }
}

__global__ void __launch_bounds__(256) k_peer_naive(const bf16* __restrict__ qp, const bf16* __restrict__ skb, const bf16* __restrict__ x1b, const float* __restrict__ ssq,
                                                     const bf16* __restrict__ Ub, const bf16* __restrict__ Vb, float* __restrict__ out) {
    __shared__ float q_s[4][256];
    __shared__ float tkv[4][2][16];
    __shared__ int tki[4][2][16];
    __shared__ int sel_e[4][128];
    __shared__ float sel_g[4][128];
    __shared__ float act[4][128];
    const int lane = threadIdx.x & 63, wv = threadIdx.x >> 6, t = blockIdx.x * 4 + wv;
    const float rstd2 = rsqrtf(ssq[t] * (1.f / D) + EPS);
    for (int h = 0; h < PH; ++h) {
        for (int i = lane; i < 256; i += 64) q_s[wv][i] = bf2f(qp[(size_t)t * D + h * 256 + i]);
        __builtin_amdgcn_s_waitcnt(0); __builtin_amdgcn_wave_barrier();
        for (int p = 0; p < 2; ++p) {
            float v0 = 0.f, v1 = 0.f;
            const bf16* k0 = skb + ((size_t)(h * 2 + p) * NKEYS + lane) * 128, * k1 = k0 + 64 * 128;
            for (int c8 = 0; c8 < 16; ++c8) {
                const v4u a = ((const v4u*)k0)[c8], b = ((const v4u*)k1)[c8]; const float* qv = &q_s[wv][p * 128 + c8 * 8];
                v0 += qv[0] * bflo(a.x) + qv[1] * bfhi(a.x) + qv[2] * bflo(a.y) + qv[3] * bfhi(a.y) + qv[4] * bflo(a.z) + qv[5] * bfhi(a.z) + qv[6] * bflo(a.w) + qv[7] * bfhi(a.w);
                v1 += qv[0] * bflo(b.x) + qv[1] * bfhi(b.x) + qv[2] * bflo(b.y) + qv[3] * bfhi(b.y) + qv[4] * bflo(b.z) + qv[5] * bfhi(b.z) + qv[6] * bflo(b.w) + qv[7] * bfhi(b.w);
            }
            float tv = 0.f; int ti = 0;
            for (int r = 0; r < PTOPK; ++r) {
                const float M = wave_max(fmaxf(v0, v1));
                const int cn = (v0 == M) ? lane : ((v1 == M) ? lane + 64 : 9999);
                const int nm = wave_min_i(cn);
                if (lane == r) { tv = M; ti = nm; }
                if (nm == lane) v0 = -3.0e38f;
                if (nm == lane + 64) v1 = -3.0e38f;
            }
            if (lane < 16) { tkv[wv][p][lane] = tv; tki[wv][p][lane] = ti; }
        }
        __builtin_amdgcn_s_waitcnt(0); __builtin_amdgcn_wave_barrier();
        float cs[4];
#pragma unroll
        for (int i = 0; i < 4; ++i) cs[i] = tkv[wv][0][lane >> 2] + tkv[wv][1][(lane & 3) * 4 + i];
        float sv = 0.f; int sf = 0;
        for (int r = 0; r < PTOPK; ++r) {
            const float M = wave_max(fmaxf(fmaxf(cs[0], cs[1]), fmaxf(cs[2], cs[3])));
            int cn = 9999;
#pragma unroll
            for (int i = 3; i >= 0; --i) if (cs[i] == M) cn = (lane >> 2) * 16 + (lane & 3) * 4 + i;
            const int nm = wave_min_i(cn);
            if (lane == r) { sv = M; sf = nm; }
#pragma unroll
            for (int i = 0; i < 4; ++i) if (nm == (lane >> 2) * 16 + (lane & 3) * 4 + i) cs[i] = -3.0e38f;
        }
        const float smax = __shfl(sv, 0);
        const float ge = lane < 16 ? __expf(sv - smax) : 0.f;
        const float gs = wave_sum(ge);
        if (lane < 16) { sel_e[wv][h * 16 + lane] = tki[wv][0][sf >> 4] * NKEYS + tki[wv][1][sf & 15]; sel_g[wv][h * 16 + lane] = ge / gs; }
        __builtin_amdgcn_s_waitcnt(0); __builtin_amdgcn_wave_barrier();
    }
    {
        const v4u* xr = (const v4u*)(x1b + (size_t)t * D) + lane;
        float xv[32];
#pragma unroll
        for (int j = 0; j < 4; ++j) { const v4u w = xr[64 * j]; xv[8 * j + 0] = bflo(w.x); xv[8 * j + 1] = bfhi(w.x); xv[8 * j + 2] = bflo(w.y); xv[8 * j + 3] = bfhi(w.y);
            xv[8 * j + 4] = bflo(w.z); xv[8 * j + 5] = bfhi(w.z); xv[8 * j + 6] = bflo(w.w); xv[8 * j + 7] = bfhi(w.w); }
        for (int k = 0; k < 128; ++k) {
            const v4u* ur = (const v4u*)(Ub + (size_t)sel_e[wv][k] * D) + lane; float dot = 0.f;
#pragma unroll
            for (int j = 0; j < 4; ++j) { const v4u w = ur[64 * j];
                dot += xv[8 * j + 0] * bflo(w.x) + xv[8 * j + 1] * bfhi(w.x) + xv[8 * j + 2] * bflo(w.y) + xv[8 * j + 3] * bfhi(w.y)
                     + xv[8 * j + 4] * bflo(w.z) + xv[8 * j + 5] * bfhi(w.z) + xv[8 * j + 6] * bflo(w.w) + xv[8 * j + 7] * bfhi(w.w); }
            dot = wave_sum(dot);
            const float hh = rstd2 * dot;
            if (lane == 0) act[wv][k] = 0.5f * hh * (1.f + erff(hh * 0.70710678118654752f)) * sel_g[wv][k];
        }
    }
    __builtin_amdgcn_s_waitcnt(0); __builtin_amdgcn_wave_barrier();
    {
        float acc[32];
#pragma unroll
        for (int i = 0; i < 32; ++i) acc[i] = 0.f;
        for (int k = 0; k < 128; ++k) {
            const v4u* vr = (const v4u*)(Vb + (size_t)sel_e[wv][k] * D) + lane; const float a = act[wv][k];
#pragma unroll
            for (int j = 0; j < 4; ++j) { const v4u w = vr[64 * j];
                acc[8 * j + 0] += a * bflo(w.x); acc[8 * j + 1] += a * bfhi(w.x); acc[8 * j + 2] += a * bflo(w.y); acc[8 * j + 3] += a * bfhi(w.y);
                acc[8 * j + 4] += a * bflo(w.z); acc[8 * j + 5] += a * bfhi(w.z); acc[8 * j + 6] += a * bflo(w.w); acc[8 * j + 7] += a * bfhi(w.w); }
        }
        f32x4* orow = (f32x4*)(out + (size_t)t * D);
#pragma unroll
        for (int j = 0; j < 4; ++j) {
            f32x4 a = orow[128 * j + 2 * lane], b = orow[128 * j + 2 * lane + 1];
            a.x += acc[8 * j + 0]; a.y += acc[8 * j + 1]; a.z += acc[8 * j + 2]; a.w += acc[8 * j + 3];
            b.x += acc[8 * j + 4]; b.y += acc[8 * j + 5]; b.z += acc[8 * j + 6]; b.w += acc[8 * j + 7];
            orow[128 * j + 2 * lane] = a; orow[128 * j + 2 * lane + 1] = b;
        }
    }
}


namespace pg8 {
#define PG8_LAS __attribute__((address_space(3)))
typedef unsigned short bf16_t;
typedef short bf16x8 __attribute__((ext_vector_type(8)));
typedef float f32x4 __attribute__((ext_vector_type(4)));
typedef unsigned u32x4 __attribute__((ext_vector_type(4)));
constexpr int BM = 256, BK = 64, HALF = 128, HTB = HALF * BK * 2  , STAGE_BYTES = 8 * HTB, NXCD = 8, WGM = 8;

__host__ __device__ __forceinline__ int lds_byte(int r, int c) { const int st = (r >> 4) * 2 + (c >> 5), rr = r & 15, cc = c & 31, ob = rr * 64 + cc * 2; return st * 1024 + (ob ^ (((ob >> 9) & 1) << 5)); }
__host__ __device__ __forceinline__ void stage_rc(int b, int& R, int& C) { const int st = b / 1024, sb = b % 1024, swz = sb ^ (((sb >> 9) & 1) << 5); R = (st >> 1) * 16 + swz / 64; C = (st & 1) * 32 + (swz % 64) / 2; }
__host__ __device__ __forceinline__ int perm32(int rho) { const int n = rho >> 4, i = rho & 15; return 8 * (i >> 2) + 4 * n + (i & 3); }

struct Unit { int pm, pn; };
struct Gemm { const bf16_t* A; const bf16_t* Bt; int M, N, K; };

struct StaticOrder {
    int nM, nN, nwg, G, c;
    __host__ __device__ void init(int M, int N, int G_, int c_) { nM = M / BM; nN = N / BM; nwg = nM * nN; G = G_; c = c_; }
    __host__ __device__ bool next(int i, Unit& u) const {
        const long L = (long)i * G + c; if (L >= nwg) return false;
        int wgid = (int)L; { const int q = nwg / NXCD, r = nwg % NXCD, xcd = wgid % NXCD, off = wgid / NXCD; wgid = (xcd < r ? xcd * (q + 1) : r * (q + 1) + (xcd - r) * q) + off; }
        const int nig = WGM * nN, gid = wgid / nig, fm = gid * WGM, gsz = (nM - fm) < WGM ? (nM - fm) : WGM;
        u.pm = fm + ((wgid % nig) % gsz); u.pn = (wgid % nig) / gsz; return true;
    }
    __device__ __forceinline__ void a_ready(const Unit&) const {}
    __device__ __forceinline__ void done(const Unit&) const {}
};

__device__ __forceinline__ unsigned cvt_pk_bf16(float lo, float hi) { unsigned r; asm volatile("v_cvt_pk_bf16_f32 %0, %1, %2" : "=v"(r) : "v"(lo), "v"(hi)); return r; }

template <bool RSQ> struct EpiScaleBf16 {
    static constexpr bool PERM = true, AFTER_DRAIN = false;
    bf16_t* O; int ldc; const float* sv; const float* bias;
    __device__ __forceinline__ void operator()(const f32x4 (&acc)[2][2][4][2], const Unit& u, int wr, int wc, int fr, int fq) const {
        const int row0 = u.pm * BM + wr * 64 + fr, col0 = u.pn * BM + wc * 32 + 8 * fq;
        f32x4 bv[2][2];
#pragma unroll
        for (int bj = 0; bj < 2; ++bj)
#pragma unroll
            for (int n = 0; n < 2; ++n) bv[bj][n] = bias ? *(const f32x4*)(bias + col0 + bj * HALF + 4 * n) : (f32x4){0.f, 0.f, 0.f, 0.f};
#pragma unroll
        for (int ai = 0; ai < 2; ++ai)
#pragma unroll
            for (int m = 0; m < 4; ++m) { const int r = row0 + ai * HALF + m * 16; float s = sv[r]; if (RSQ) s = rsqrtf(s * (1.0f / 2048.0f) + 1e-6f);
                bf16_t* rowp = O + (size_t)r * ldc + col0;
#pragma unroll
                for (int bj = 0; bj < 2; ++bj) { const f32x4 v0 = acc[ai][bj][m][0] * s + bv[bj][0], v1 = acc[ai][bj][m][1] * s + bv[bj][1];
                    u32x4 w; w.x = cvt_pk_bf16(v0[0], v0[1]); w.y = cvt_pk_bf16(v0[2], v0[3]); w.z = cvt_pk_bf16(v1[0], v1[1]); w.w = cvt_pk_bf16(v1[2], v1[3]);
                    *(u32x4*)(rowp + bj * HALF) = w; } }
    }
};
struct EpiResid {
    static constexpr bool PERM = true, AFTER_DRAIN = false;
    const float* X; float* out; bf16_t* x1b; float* ssq; int ldc;
    __device__ __forceinline__ void operator()(const f32x4 (&acc)[2][2][4][2], const Unit& u, int wr, int wc, int fr, int fq) const {
        const int row0 = u.pm * BM + wr * 64 + fr, col0 = u.pn * BM + wc * 32 + 8 * fq;
#pragma unroll
        for (int ai = 0; ai < 2; ++ai)
#pragma unroll
            for (int m = 0; m < 4; ++m) { const int r = row0 + ai * HALF + m * 16; const size_t off = (size_t)r * ldc + col0; float q = 0.f;
#pragma unroll
                for (int bj = 0; bj < 2; ++bj) {
                    const f32x4 v0 = *(const f32x4*)(X + off + bj * HALF) + acc[ai][bj][m][0], v1 = *(const f32x4*)(X + off + bj * HALF + 4) + acc[ai][bj][m][1];
                    *(f32x4*)(out + off + bj * HALF) = v0; *(f32x4*)(out + off + bj * HALF + 4) = v1;
                    u32x4 w; w.x = cvt_pk_bf16(v0[0], v0[1]); w.y = cvt_pk_bf16(v0[2], v0[3]); w.z = cvt_pk_bf16(v1[0], v1[1]); w.w = cvt_pk_bf16(v1[2], v1[3]);
                    *(u32x4*)(x1b + off + bj * HALF) = w;
                    q += (v0[0] * v0[0] + v0[1] * v0[1]) + (v0[2] * v0[2] + v0[3] * v0[3]) + (v1[0] * v1[0] + v1[1] * v1[1]) + (v1[2] * v1[2] + v1[3] * v1[3]); }
                q += __shfl_xor(q, 16); q += __shfl_xor(q, 32);
                if (fq == 0) atomicAdd(ssq + r, q);
                asm volatile("" ::: "memory"); }
    }
};
template <class Epi, class Sched, bool ALIGN_EPI = false, bool SP2 = false>
__device__ __forceinline__ void gemm_phase(PG8_LAS unsigned char* lds, const Gemm g, const Sched& S, const Epi& E) {
    const int tid = threadIdx.x, wid = __builtin_amdgcn_readfirstlane(tid >> 6), lane = tid & 63, wr = wid >> 2, wc = wid & 3, fr = lane & 15, fq = lane >> 4;
    const int K = g.K, nt = K / BK;
    unsigned voffA[2], voffB[2];
#pragma unroll
    for (int i = 0; i < 2; ++i) { int R, C; stage_rc(tid * 16 + i * 8192, R, C); const int Rb = Epi::PERM ? ((R & ~31) + perm32(R & 31)) : R;
        voffA[i] = (unsigned)(R * K + C) * 2u; voffB[i] = (unsigned)(Rb * K + C) * 2u; }
    const size_t kstep = (size_t)(BK * 2);
    const size_t hstep = (size_t)HALF * K * 2;
    const size_t tstep = 2 * hstep;
    const unsigned ldsw = (unsigned)wid * 1024u;
    const int aoff = lds_byte(wr * 64 + fr, fq * 8), boff = lds_byte(wc * 32 + fr, fq * 8);
#define PG8_SA(b, h) (((b) * 2 + (h)) * HTB)
#define PG8_SB(b, h) ((4 + (b) * 2 + (h)) * HTB)
#define PG8_STAGE(bufoff, gbase, voff) do { _Pragma("unroll") for (int _i = 0; _i < 2; ++_i) \
        __builtin_amdgcn_global_load_lds((const unsigned*)((const char*)(gbase) + (voff)[_i]), (PG8_LAS unsigned*)(lds + (bufoff) + ldsw + _i * 8192), 16, 0, 0); } while (0)
#define PG8_LDA(dst, b, h) do { _Pragma("unroll") for (int m = 0; m < 4; ++m) _Pragma("unroll") for (int k = 0; k < 2; ++k) dst[m][k] = *(const PG8_LAS bf16x8*)(lds + PG8_SA(b, h) + aoff + m * 2048 + k * 1024); } while (0)
#define PG8_LDB(dst, b, h) do { _Pragma("unroll") for (int n = 0; n < 2; ++n) _Pragma("unroll") for (int k = 0; k < 2; ++k) dst[n][k] = *(const PG8_LAS bf16x8*)(lds + PG8_SB(b, h) + boff + n * 2048 + k * 1024); } while (0)
#define PG8_MMA(ai, bj, At, Bt) do { __builtin_amdgcn_s_setprio(1); _Pragma("unroll") for (int m = 0; m < 4; ++m) _Pragma("unroll") for (int n = 0; n < 2; ++n) _Pragma("unroll") for (int k = 0; k < 2; ++k) \
        acc[ai][bj][m][n] = __builtin_amdgcn_mfma_f32_16x16x32_bf16(Bt[n][k], At[m][k], acc[ai][bj][m][n], 0, 0, 0); __builtin_amdgcn_s_setprio(0); } while (0)
#define PG8_WAIT_V(n) asm volatile("s_waitcnt vmcnt(" #n ")" ::: "memory")
#define PG8_WAIT_L(n) asm volatile("s_waitcnt lgkmcnt(" #n ")" ::: "memory")
#define PG8_BAR __builtin_amdgcn_s_barrier()
#define PG8_SCHED __builtin_amdgcn_sched_barrier(0)
    Unit cur, nxt; int ui = 0;
    if (!S.next(0, cur)) return;
    f32x4 acc[2][2][4][2];
#pragma unroll
    for (int a = 0; a < 2; ++a)
#pragma unroll
        for (int b = 0; b < 2; ++b)
#pragma unroll
            for (int m = 0; m < 4; ++m)
#pragma unroll
                for (int n = 0; n < 2; ++n) acc[a][b][m][n] = (f32x4){0.f, 0.f, 0.f, 0.f};
    bf16x8 At[4][2], B0[2][2], B1[2][2];
    const char* cA = (const char*)g.A + (size_t)cur.pm * tstep; const char* cB = (const char*)g.Bt + (size_t)cur.pn * tstep;
    S.a_ready(cur);
    if constexpr (SP2) {
        PG8_STAGE(PG8_SB(0, 0), cB, voffB); PG8_STAGE(PG8_SB(0, 1), cB + hstep, voffB); PG8_STAGE(PG8_SA(0, 0), cA, voffA); PG8_STAGE(PG8_SA(0, 1), cA + hstep, voffA);
        if (wr == 1) PG8_BAR;
        PG8_WAIT_V(2); PG8_BAR;
        PG8_STAGE(PG8_SB(1, 0), cB + kstep, voffB); PG8_STAGE(PG8_SA(1, 0), cA + kstep, voffA); PG8_STAGE(PG8_SB(1, 1), cB + hstep + kstep, voffB);
        PG8_WAIT_V(6); PG8_BAR;
    } else {
        PG8_STAGE(PG8_SB(0, 0), cB, voffB); PG8_STAGE(PG8_SA(0, 0), cA, voffA); PG8_STAGE(PG8_SB(0, 1), cB + hstep, voffB); PG8_STAGE(PG8_SA(0, 1), cA + hstep, voffA);
        if (wr == 1) PG8_BAR;
        PG8_WAIT_V(4); PG8_BAR;
        PG8_STAGE(PG8_SB(1, 0), cB + kstep, voffB); PG8_STAGE(PG8_SA(1, 0), cA + kstep, voffA); PG8_STAGE(PG8_SB(1, 1), cB + hstep + kstep, voffB);
        PG8_WAIT_V(6); PG8_BAR;
    }
    for (;;) {
        const bool has_next = S.next(ui + 1, nxt);
        const char* nA = has_next ? (const char*)g.A + (size_t)nxt.pm * tstep : cA; const char* nB = has_next ? (const char*)g.Bt + (size_t)nxt.pn * tstep : cB;
        for (int t = 0; t < nt; t += 2) {
            const bool last = (t == nt - 2);
            const char* a1 = cA + (size_t)(t + 1) * kstep;
            const char* a2 = last ? nA : cA + (size_t)(t + 2) * kstep; const char* b2 = last ? nB : cB + (size_t)(t + 2) * kstep;
            const char* a3 = a2 + kstep; const char* b3 = b2 + kstep;
            if (last && has_next) S.a_ready(nxt);
            if constexpr (SP2) {
            PG8_LDB(B0, 0, 0); PG8_LDB(B1, 0, 1); PG8_SCHED; PG8_LDA(At, 0, 0); PG8_STAGE(PG8_SA(1, 1), a1 + hstep, voffA);
            PG8_WAIT_V(8); PG8_WAIT_L(0); PG8_BAR; PG8_MMA(0, 0, At, B0); PG8_MMA(0, 1, At, B1); PG8_BAR; PG8_SCHED;
            PG8_LDA(At, 0, 1); PG8_STAGE(PG8_SB(0, 0), b2, voffB); PG8_STAGE(PG8_SB(0, 1), b2 + hstep, voffB); PG8_STAGE(PG8_SA(0, 0), a2, voffA);
            PG8_WAIT_V(8); PG8_WAIT_L(0); PG8_BAR; PG8_MMA(1, 0, At, B0); PG8_MMA(1, 1, At, B1); PG8_BAR; PG8_SCHED;
            PG8_LDB(B0, 1, 0); PG8_LDB(B1, 1, 1); PG8_SCHED; PG8_LDA(At, 1, 0); PG8_STAGE(PG8_SA(0, 1), a2 + hstep, voffA);
            PG8_WAIT_V(8); PG8_WAIT_L(0); PG8_BAR; PG8_MMA(0, 0, At, B0); PG8_MMA(0, 1, At, B1); PG8_BAR; PG8_SCHED;
            PG8_LDA(At, 1, 1); PG8_STAGE(PG8_SB(1, 0), b3, voffB); PG8_STAGE(PG8_SB(1, 1), b3 + hstep, voffB); PG8_STAGE(PG8_SA(1, 0), a3, voffA);
            PG8_WAIT_V(8); PG8_WAIT_L(0); PG8_BAR; PG8_MMA(1, 0, At, B0); PG8_MMA(1, 1, At, B1); PG8_BAR; PG8_SCHED;
            } else {
            PG8_LDB(B0, 0, 0); PG8_SCHED; PG8_LDA(At, 0, 0); PG8_STAGE(PG8_SA(1, 1), a1 + hstep, voffA);
            PG8_WAIT_L(8); PG8_BAR; PG8_WAIT_L(0); PG8_MMA(0, 0, At, B0); PG8_BAR; PG8_SCHED;
            PG8_LDB(B1, 0, 1); PG8_STAGE(PG8_SB(0, 0), b2, voffB);
            PG8_BAR; PG8_WAIT_L(0); PG8_MMA(0, 1, At, B1); PG8_BAR;
            PG8_LDA(At, 0, 1); PG8_STAGE(PG8_SA(0, 0), a2, voffA);
            PG8_BAR; PG8_WAIT_L(0); PG8_MMA(1, 0, At, B0); PG8_BAR; PG8_SCHED;
            PG8_STAGE(PG8_SB(0, 1), b2 + hstep, voffB);
            PG8_WAIT_V(6); PG8_BAR; PG8_MMA(1, 1, At, B1); PG8_BAR;
            PG8_LDB(B0, 1, 0); PG8_SCHED; PG8_LDA(At, 1, 0); PG8_STAGE(PG8_SA(0, 1), a2 + hstep, voffA);
            PG8_WAIT_L(8); PG8_BAR; PG8_WAIT_L(0); PG8_MMA(0, 0, At, B0); PG8_BAR; PG8_SCHED;
            PG8_LDB(B1, 1, 1); PG8_STAGE(PG8_SB(1, 0), b3, voffB);
            PG8_BAR; PG8_WAIT_L(0); PG8_MMA(0, 1, At, B1); PG8_BAR;
            PG8_LDA(At, 1, 1); PG8_STAGE(PG8_SA(1, 0), a3, voffA);
            PG8_BAR; PG8_WAIT_L(0); PG8_MMA(1, 0, At, B0); PG8_BAR; PG8_SCHED;
            PG8_STAGE(PG8_SB(1, 1), b3 + hstep, voffB);
            PG8_WAIT_V(6); PG8_BAR; PG8_MMA(1, 1, At, B1); PG8_BAR;
            }
        }
        if constexpr (ALIGN_EPI) { if (wr == 0) PG8_BAR; }
        if constexpr (!Epi::AFTER_DRAIN) { E(acc, cur, wr, wc, fr, fq); S.done(cur); }
        if (!has_next) break;
#pragma unroll
        for (int a = 0; a < 2; ++a)
#pragma unroll
            for (int b = 0; b < 2; ++b)
#pragma unroll
                for (int m = 0; m < 4; ++m)
#pragma unroll
                    for (int n = 0; n < 2; ++n) acc[a][b][m][n] = (f32x4){0.f, 0.f, 0.f, 0.f};
        cur = nxt; cA = nA; cB = nB; ++ui;
        if constexpr (ALIGN_EPI) { if (wr == 1) PG8_BAR; }
    }
    PG8_WAIT_V(0);
    if constexpr (!ALIGN_EPI) { if (wr == 0) PG8_BAR; }
    PG8_BAR;
    if constexpr (Epi::AFTER_DRAIN) { E.fused(acc, cur, wr, wc, fr, fq, lds, wid, lane); S.done(cur); }
#undef PG8_SA
#undef PG8_SB
#undef PG8_STAGE
#undef PG8_LDA
#undef PG8_LDB
#undef PG8_MMA
#undef PG8_WAIT_V
#undef PG8_WAIT_L
#undef PG8_BAR
#undef PG8_SCHED
}
}

#ifndef REP_P0
#define REP_P0 1
#endif
#ifndef REP_P1
#define REP_P1 1
#endif
#ifndef REP_P2
#define REP_P2 1
#endif
#ifndef REP_CONV
#define REP_CONV 1
#endif
#ifndef REP_ATTN
#define REP_ATTN 1
#endif
#ifndef REP_P4
#define REP_P4 1
#endif
#ifndef REP_P5A
#define REP_P5A 1
#endif
#ifndef REP_P5U
#define REP_P5U 1
#endif
#ifndef REP_P5V
#define REP_P5V 1
#endif
#ifndef PG8_SP2
#define PG8_SP2 true
#endif
#ifndef PG8_ALIGN
#define PG8_ALIGN true
#endif

constexpr int NWAVES = 8, NTHR = 512;
constexpr int LDS_BYTES = 160 * 1024;
#define LAS __attribute__((address_space(3)))
typedef short bf16x8 __attribute__((ext_vector_type(8)));
typedef float f32x16 __attribute__((ext_vector_type(16)));
typedef float f32x2 __attribute__((ext_vector_type(2)));
#define LDS_WAIT() asm volatile("s_waitcnt lgkmcnt(0)" ::: "memory")

struct Args {
    const float* x; const int* pos; const float* g1; const float* w_in; const float* b_in; const float* cw; const float* cb; const float* lg; const float* lb;
    const float* qg; const float* kg; const float* sinks; const float* w_out; const float* g2; const float* wq; const float* skeys; const float* pu; const float* pv;
    float* out; unsigned char* ws; int ph_lo, ph_hi;
};

__device__ __forceinline__ void p0_transpose_item(const float* W, const float* g, int K, int N, bf16* WT, LAS float* scr, int item, int lane) {
    const int nblk = N / 32, kb = item / nblk, nb = item % nblk, k0 = 64 * kb, n0 = 32 * nb;
#pragma unroll 8
    for (int i = 0; i < 32; ++i) { const int kk = 2 * i + (lane >> 5); const float gv = g ? g[k0 + kk] : 1.f; scr[kk * 33 + (lane & 31)] = W[(size_t)(k0 + kk) * N + n0 + (lane & 31)] * gv; }
    LDS_WAIT(); asm volatile("" ::: "memory");
    const int c = lane & 7;
#pragma unroll
    for (int j = 0; j < 4; ++j) { const int n = (lane >> 3) + 8 * j; const LAS float* s = scr + (8 * c) * 33 + n;
        v4u o; o.x = pk2(s[0 * 33], s[1 * 33]); o.y = pk2(s[2 * 33], s[3 * 33]); o.z = pk2(s[4 * 33], s[5 * 33]); o.w = pk2(s[6 * 33], s[7 * 33]);
        *(v4u*)(WT + (size_t)(n0 + n) * K + k0 + 8 * c) = o; }
    LDS_WAIT(); asm volatile("" ::: "memory");
}
__device__ __forceinline__ void p0_convert(const float* src, const float* g, bf16* dst, size_t n8, int ncol, size_t gtid, size_t nthr) {
    for (size_t i = gtid; i < n8; i += nthr) {
        f32x4 a = ((const f32x4*)src)[2 * i], b = ((const f32x4*)src)[2 * i + 1];
        if (g) { const int c = (int)((i * 8) % ncol); const f32x4 ga = *(const f32x4*)(g + c), gb = *(const f32x4*)(g + c + 4); a = a * ga; b = b * gb; }
        v4u w; w.x = pk2(a.x, a.y); w.y = pk2(a.z, a.w); w.z = pk2(b.x, b.y); w.w = pk2(b.z, b.w);
        ((v4u*)dst)[i] = w;
    }
}
__device__ __forceinline__ void p0_prologue(const Args& A, LAS unsigned char* lds, int vcu, int G, int tid) {
    const int lane = tid & 63, wave = tid >> 6;
    unsigned char* ws = A.ws;
    LAS float* scr = (LAS float*)(lds + wave * 16384);
    const int gw = vcu * NWAVES + wave, NGW = G * NWAVES;
    constexpr int I_1 = (D / 64) * (INC / 32), I_2 = (D / 64) * (D / 32);
    for (int it = gw; it < I_1 + 2 * I_2; it += NGW) {
        int r = it;
        if (r < I_1) { p0_transpose_item(A.w_in, A.g1, D, INC, (bf16*)(ws + WS_W1T), scr, r, lane); continue; } r -= I_1;
        if (r < I_2) { p0_transpose_item(A.w_out, nullptr, D, D, (bf16*)(ws + WS_W2T), scr, r, lane); continue; } r -= I_2;
        p0_transpose_item(A.wq, A.g2, D, D, (bf16*)(ws + WS_W3T), scr, r, lane);
    }
    {
        bf16* xb = (bf16*)(ws + WS_XB); float* rstd1 = (float*)(ws + WS_RSTD1);
        for (int row = gw; row < T; row += NGW) {
            const f32x4* xr = (const f32x4*)(A.x + (size_t)row * D) + lane;
            f32x4 v[8]; float ss = 0.f;
#pragma unroll
            for (int j = 0; j < 8; ++j) { v[j] = xr[64 * j]; ss += v[j].x * v[j].x + v[j].y * v[j].y + v[j].z * v[j].z + v[j].w * v[j].w; }
            ss = wave_sum(ss);
            if (lane == 0) rstd1[row] = rsqrtf(ss * (1.f / D) + EPS);
            v2u* o = (v2u*)(xb + (size_t)row * D) + lane;
#pragma unroll
            for (int j = 0; j < 8; ++j) { v2u w; w.x = pk2(v[j].x, v[j].y); w.y = pk2(v[j].z, v[j].w); o[64 * j] = w; }
        }
    }
    const size_t gtid = (size_t)vcu * NTHR + tid, nthr = (size_t)G * NTHR;
    {
        float* rope = (float*)(ws + WS_ROPE);
        for (size_t i = gtid; i < (size_t)T * 8; i += nthr) { const int t = (int)(i >> 3), f = (int)(i & 7);
            const float ang = (float)A.pos[t] * powf(500000.f, -(float)(2 * f) / 16.f); float sn, cs; sincosf(ang, &sn, &cs);
            rope[t * 16 + f] = cs; rope[t * 16 + 8 + f] = sn; }
    }
    p0_convert(A.skeys, nullptr, (bf16*)(ws + WS_SKB), (size_t)16 * 128 * 128 / 8, 128, gtid, nthr);
    p0_convert(A.pu, A.g2, (bf16*)(ws + WS_UB), (size_t)NEXP * D / 8, D, gtid, nthr);
    p0_convert(A.pv, nullptr, (bf16*)(ws + WS_VB), (size_t)NEXP * D / 8, D, gtid, nthr);
}

__device__ __forceinline__ void conv_unit(const Args& A, LAS unsigned char* lds, int t0, int tid) {
    const bf16* proj = (const bf16*)(A.ws + WS_PROJ); bf16* mixed = (bf16*)(A.ws + WS_MIXED);
    const int lane = tid & 63, wave = tid >> 6;
    LAS bf16* H = (LAS bf16*)lds;
    for (int it = tid; it < 62 * 128; it += NTHR) {
        const int row = it >> 7, ch = (it & 127) * 8, tt = t0 - 30 + row;
        v4u w = {0u, 0u, 0u, 0u};
        if (tt >= 0) {
            const v4u a = *(const v4u*)(proj + (size_t)tt * INC + ch), g = *(const v4u*)(proj + (size_t)tt * INC + CONVC + ch);
            const unsigned aw[4] = {a.x, a.y, a.z, a.w}, gw_[4] = {g.x, g.y, g.z, g.w}; unsigned ow[4];
#pragma unroll
            for (int q = 0; q < 4; ++q) { const float h0 = bflo(aw[q]) / (1.f + __expf(-bflo(gw_[q]))), h1 = bfhi(aw[q]) / (1.f + __expf(-bfhi(gw_[q]))); ow[q] = pk2(h0, h1); }
            w.x = ow[0]; w.y = ow[1]; w.z = ow[2]; w.w = ow[3];
        }
        *(LAS v4u*)(H + row * 1024 + ch) = w;
    }
    __syncthreads();
    LAS float* Cf = (LAS float*)(lds + 62 * 1024 * 2);
    float w0[CK], w1[CK];
#pragma unroll
    for (int j = 0; j < CK; ++j) { const f32x2 wv = *(const f32x2*)(A.cw + j * CONVC + 2 * tid); w0[j] = wv.x; w1[j] = wv.y; }
    const f32x2 bv = *(const f32x2*)(A.cb + 2 * tid);
#pragma unroll 1
    for (int c = 0; c < 4; ++c) {
        float a0[8], a1[8];
#pragma unroll
        for (int tt = 0; tt < 8; ++tt) { a0[tt] = bv.x; a1[tt] = bv.y; }
        const LAS bf16* Hc = H + (8 * c) * 1024 + 2 * tid;
#pragma unroll
        for (int i = 0; i < 38; ++i) {
            const unsigned hw = *(const LAS unsigned*)(Hc + i * 1024); const float h0 = bflo(hw), h1 = bfhi(hw);
#pragma unroll
            for (int tt = 0; tt < 8; ++tt) { const int j = i - tt; if (j >= 0 && j < CK) { a0[tt] += h0 * w0[j]; a1[tt] += h1 * w1[j]; } }
        }
#pragma unroll
        for (int tt = 0; tt < 8; ++tt) *(LAS f32x2*)(Cf + tt * 1024 + 2 * tid) = (f32x2){a0[tt], a1[tt]};
        __syncthreads();
        {
            const int tt = wave;
            f32x4 v[4]; float s = 0.f;
#pragma unroll
            for (int j = 0; j < 4; ++j) { v[j] = *(const LAS f32x4*)(Cf + tt * 1024 + 4 * lane + 256 * j); s += (v[j].x + v[j].y) + (v[j].z + v[j].w); }
            const float mu = wave_sum(s) * (1.f / CONVC); float s2 = 0.f;
#pragma unroll
            for (int j = 0; j < 4; ++j) { v[j] = v[j] - mu; s2 += (v[j].x * v[j].x + v[j].y * v[j].y) + (v[j].z * v[j].z + v[j].w * v[j].w); }
            const float rstd = rsqrtf(wave_sum(s2) * (1.f / CONVC) + EPS);
#pragma unroll
            for (int j = 0; j < 4; ++j) {
                const int ch = 4 * lane + 256 * j; const f32x4 gg = *(const f32x4*)(A.lg + ch), bb = *(const f32x4*)(A.lb + ch);
                f32x4 y = v[j] * rstd * gg + bb;
                y.x = y.x / (1.f + __expf(-y.x)); y.y = y.y / (1.f + __expf(-y.y)); y.z = y.z / (1.f + __expf(-y.z)); y.w = y.w / (1.f + __expf(-y.w));
                v2u w; w.x = pk2(y.x, y.y); w.y = pk2(y.z, y.w);
                *(v2u*)(mixed + (size_t)(t0 + 8 * c + tt) * D + ch) = w;
            }
        }
        __syncthreads();
    }
}

__device__ __forceinline__ void attn_unit(const Args& A, LAS unsigned char* lds, int qb, int kvh, int gh, int tid) {
    const bf16* proj = (const bf16*)(A.ws + WS_PROJ); bf16* mixed = (bf16*)(A.ws + WS_MIXED); const float* rope = (const float*)(A.ws + WS_ROPE);
    constexpr int KST = 72, VST = 260;
    LAS bf16* Kn = (LAS bf16*)lds;
    LAS bf16* Vt = (LAS bf16*)(lds + 256 * KST * 2);
    const int lane = tid & 63, wave = tid >> 6;
    const int kbase = (qb - 1) * 128;
    {
        const int key = tid >> 1, half = tid & 1, kp = kbase + key;
        float v[32]; unsigned vw[16];
        if (kp >= 0) {
            const v4u* kr = (const v4u*)(proj + (size_t)kp * INC + KOFF + kvh * HD + 32 * half);
            const v4u* vr = (const v4u*)(proj + (size_t)kp * INC + VOFF + kvh * HD + 32 * half);
#pragma unroll
            for (int j = 0; j < 4; ++j) { const v4u w = kr[j]; v[8 * j + 0] = bflo(w.x); v[8 * j + 1] = bfhi(w.x); v[8 * j + 2] = bflo(w.y); v[8 * j + 3] = bfhi(w.y);
                v[8 * j + 4] = bflo(w.z); v[8 * j + 5] = bfhi(w.z); v[8 * j + 6] = bflo(w.w); v[8 * j + 7] = bfhi(w.w);
                const v4u u = vr[j]; vw[4 * j + 0] = u.x; vw[4 * j + 1] = u.y; vw[4 * j + 2] = u.z; vw[4 * j + 3] = u.w; }
        } else {
#pragma unroll
            for (int i = 0; i < 32; ++i) v[i] = 0.f;
#pragma unroll
            for (int i = 0; i < 16; ++i) vw[i] = 0u;
        }
        float ss = 0.f;
#pragma unroll
        for (int i = 0; i < 32; ++i) ss += v[i] * v[i];
        ss += __shfl_xor(ss, 1);
        const float r = rsqrtf(ss * (1.f / HD) + EPS);
#pragma unroll
        for (int i = 0; i < 32; ++i) v[i] = v[i] * r * A.kg[32 * half + i];
        if (half == 0 && kp >= 0) {
#pragma unroll
            for (int i = 0; i < 8; ++i) { const float cs = rope[kp * 16 + i], sn = rope[kp * 16 + 8 + i]; const float r1 = v[i], r2 = v[i + 8]; v[i] = r1 * cs - r2 * sn; v[i + 8] = r2 * cs + r1 * sn; }
        }
#pragma unroll
        for (int j = 0; j < 4; ++j) { v4u w; w.x = pk2(v[8 * j + 0], v[8 * j + 1]); w.y = pk2(v[8 * j + 2], v[8 * j + 3]); w.z = pk2(v[8 * j + 4], v[8 * j + 5]); w.w = pk2(v[8 * j + 6], v[8 * j + 7]);
            *(LAS v4u*)(Kn + key * KST + 32 * half + 8 * j) = w; }
#pragma unroll
        for (int i = 0; i < 16; ++i) { Vt[(32 * half + 2 * i) * VST + key] = (bf16)(vw[i] & 0xffffu); Vt[(32 * half + 2 * i + 1) * VST + key] = (bf16)(vw[i] >> 16); }
    }
    __syncthreads();
    const int hq = kvh * 8 + gh * 4 + (wave >> 1);
    const float sink = A.sinks[hq];
    const int h = lane >> 5, lq = lane & 31;
#pragma unroll 1
    for (int si = 0; si < 2; ++si) {
        const int s = (wave & 1) * 2 + si;
        const int qtok = qb * 128 + 32 * s + lq;
        bf16x8 qf[4];
        {
            float qv[4][8]; float ss = 0.f;
#pragma unroll
            for (int ks = 0; ks < 4; ++ks) { const v4u w = *(const v4u*)(proj + (size_t)qtok * INC + QOFF + hq * HD + 16 * ks + 8 * h);
                qv[ks][0] = bflo(w.x); qv[ks][1] = bfhi(w.x); qv[ks][2] = bflo(w.y); qv[ks][3] = bfhi(w.y); qv[ks][4] = bflo(w.z); qv[ks][5] = bfhi(w.z); qv[ks][6] = bflo(w.w); qv[ks][7] = bfhi(w.w);
#pragma unroll
                for (int j = 0; j < 8; ++j) ss += qv[ks][j] * qv[ks][j]; }
            ss += __shfl_xor(ss, 32);
            const float r = rsqrtf(ss * (1.f / HD) + EPS) * 0.125f;
#pragma unroll
            for (int ks = 0; ks < 4; ++ks)
#pragma unroll
                for (int j = 0; j < 8; ++j) qv[ks][j] = qv[ks][j] * r * A.qg[16 * ks + 8 * h + j];
#pragma unroll
            for (int j = 0; j < 8; ++j) { const float pv = __shfl_xor(qv[0][j], 32); const float cs = rope[qtok * 16 + j], sn = rope[qtok * 16 + 8 + j];
                qv[0][j] = h == 0 ? qv[0][j] * cs - pv * sn : qv[0][j] * cs + pv * sn; }
#pragma unroll
            for (int ks = 0; ks < 4; ++ks) { v4u w; w.x = pk2(qv[ks][0], qv[ks][1]); w.y = pk2(qv[ks][2], qv[ks][3]); w.z = pk2(qv[ks][4], qv[ks][5]); w.w = pk2(qv[ks][6], qv[ks][7]);
                qf[ks] = __builtin_bit_cast(bf16x8, w); }
        }
        f32x16 S[5];
#pragma unroll
        for (int k5 = 0; k5 < 5; ++k5) {
            f32x16 c;
#pragma unroll
            for (int i = 0; i < 16; ++i) c[i] = 0.f;
#pragma unroll
            for (int ks = 0; ks < 4; ++ks) { const bf16x8 a = *(const LAS bf16x8*)(Kn + (32 * (s + k5) + lq) * KST + 16 * ks + 8 * h);
                c = __builtin_amdgcn_mfma_f32_32x32x16_bf16(a, qf[ks], c, 0, 0, 0); }
            S[k5] = c;
        }
        float m = sink;
#pragma unroll
        for (int k5 = 0; k5 < 5; ++k5)
#pragma unroll
            for (int i = 0; i < 16; ++i) {
                const int keyb = 32 * (s + k5) + (i & 3) + 8 * (i >> 2) + 4 * h, diff = 128 + 32 * s + lq - keyb;
                const bool valid = diff >= 0 && diff < WIN && (qb > 0 || keyb >= 128);
                const float sv = valid ? S[k5][i] : -1e30f; S[k5][i] = sv; m = fmaxf(m, sv);
            }
        m = fmaxf(m, __shfl_xor(m, 32));
        float l = 0.f;
#pragma unroll
        for (int k5 = 0; k5 < 5; ++k5)
#pragma unroll
            for (int i = 0; i < 16; ++i) { const float p = __expf(S[k5][i] - m); S[k5][i] = p; l += p; }
        l += __shfl_xor(l, 32);
        l += __expf(sink - m);
        f32x16 O0, O1;
#pragma unroll
        for (int i = 0; i < 16; ++i) { O0[i] = 0.f; O1[i] = 0.f; }
#pragma unroll
        for (int k5 = 0; k5 < 5; ++k5)
#pragma unroll
            for (int s2 = 0; s2 < 2; ++s2) {
                v4u pw; pw.x = pk2(S[k5][8 * s2 + 0], S[k5][8 * s2 + 1]); pw.y = pk2(S[k5][8 * s2 + 2], S[k5][8 * s2 + 3]);
                pw.z = pk2(S[k5][8 * s2 + 4], S[k5][8 * s2 + 5]); pw.w = pk2(S[k5][8 * s2 + 6], S[k5][8 * s2 + 7]);
                const bf16x8 pf = __builtin_bit_cast(bf16x8, pw);
                const int kk = 32 * (s + k5) + 16 * s2 + 4 * h;
                { const v2u lo = *(const LAS v2u*)(Vt + lq * VST + kk), hi = *(const LAS v2u*)(Vt + lq * VST + kk + 8);
                  v4u aw; aw.x = lo.x; aw.y = lo.y; aw.z = hi.x; aw.w = hi.y;
                  O0 = __builtin_amdgcn_mfma_f32_32x32x16_bf16(__builtin_bit_cast(bf16x8, aw), pf, O0, 0, 0, 0); }
                { const v2u lo = *(const LAS v2u*)(Vt + (32 + lq) * VST + kk), hi = *(const LAS v2u*)(Vt + (32 + lq) * VST + kk + 8);
                  v4u aw; aw.x = lo.x; aw.y = lo.y; aw.z = hi.x; aw.w = hi.y;
                  O1 = __builtin_amdgcn_mfma_f32_32x32x16_bf16(__builtin_bit_cast(bf16x8, aw), pf, O1, 0, 0, 0); }
            }
        const float inv = 1.f / l;
        bf16* orow = mixed + (size_t)qtok * D + CONVC + hq * HD;
#pragma unroll
        for (int g = 0; g < 4; ++g) {
            v2u w0; w0.x = pk2(O0[4 * g + 0] * inv, O0[4 * g + 1] * inv); w0.y = pk2(O0[4 * g + 2] * inv, O0[4 * g + 3] * inv);
            *(v2u*)(orow + 8 * g + 4 * h) = w0;
            v2u w1; w1.x = pk2(O1[4 * g + 0] * inv, O1[4 * g + 1] * inv); w1.y = pk2(O1[4 * g + 2] * inv, O1[4 * g + 3] * inv);
            *(v2u*)(orow + 32 + 8 * g + 4 * h) = w1;
        }
    }
    __syncthreads();
}

__device__ __forceinline__ unsigned mono_key(float f) { const unsigned u = __float_as_uint(f); return u ^ ((unsigned)((int)u >> 31) | 0x80000000u); }
__device__ __forceinline__ float mono_val(unsigned k) { const unsigned u = (k & 0x80000000u) ? (k ^ 0x80000000u) : ~k; return __uint_as_float(u); }
__host__ __device__ constexpr int cand_a(int c) { return c < 16 ? 0 : c < 24 ? 1 : c < 29 ? 2 : c < 33 ? 3 : c < 36 ? 4 : c < 38 ? 5 : c < 40 ? 6 : c < 42 ? 7 : c - 34; }
__host__ __device__ constexpr int cand_b(int c) { return c < 16 ? c : c < 24 ? c - 16 : c < 29 ? c - 24 : c < 33 ? c - 29 : c < 36 ? c - 33 : c < 38 ? c - 36 : c < 40 ? c - 38 : c < 42 ? c - 40 : 0; }

typedef __bf16 bf16x2 __attribute__((ext_vector_type(2)));
__device__ __forceinline__ float dot2bf(unsigned w, unsigned x, float acc) { return __builtin_amdgcn_fdot2_f32_bf16(__builtin_bit_cast(bf16x2, w), __builtin_bit_cast(bf16x2, x), acc, false); }
template <int JC> __device__ __forceinline__ float dotn(const unsigned (&x)[4 * JC], const v4u (&u)[JC]) {
    float a0 = 0.f, a1 = 0.f, a2 = 0.f, a3 = 0.f;
#pragma unroll
    for (int j = 0; j < JC; ++j) { a0 = dot2bf(u[j].x, x[4 * j + 0], a0); a1 = dot2bf(u[j].y, x[4 * j + 1], a1); a2 = dot2bf(u[j].z, x[4 * j + 2], a2); a3 = dot2bf(u[j].w, x[4 * j + 3], a3); }
    return (a0 + a1) + (a2 + a3);
}
template <int JC> __device__ __forceinline__ void fman(float (&acc)[8 * JC], float a, const v4u (&v)[JC]) {
#pragma unroll
    for (int j = 0; j < JC; ++j) { const v4u w = v[j];
        acc[8 * j + 0] += a * bflo(w.x); acc[8 * j + 1] += a * bfhi(w.x); acc[8 * j + 2] += a * bflo(w.y); acc[8 * j + 3] += a * bfhi(w.y);
        acc[8 * j + 4] += a * bflo(w.z); acc[8 * j + 5] += a * bfhi(w.z); acc[8 * j + 6] += a * bflo(w.w); acc[8 * j + 7] += a * bfhi(w.w); }
}
__device__ __forceinline__ float row_sum16(float v) {
    v += __builtin_bit_cast(float, __builtin_amdgcn_update_dpp(0, __builtin_bit_cast(int, v), 0x128, 0xF, 0xF, true));
    v += __builtin_bit_cast(float, __builtin_amdgcn_update_dpp(0, __builtin_bit_cast(int, v), 0x124, 0xF, 0xF, true));
    v += __builtin_bit_cast(float, __builtin_amdgcn_update_dpp(0, __builtin_bit_cast(int, v), 0x122, 0xF, 0xF, true));
    v += __builtin_bit_cast(float, __builtin_amdgcn_update_dpp(0, __builtin_bit_cast(int, v), 0x121, 0xF, 0xF, true));
    return v;
}
#ifndef EPT
#define EPT 2
#endif
#ifndef NPU
#define NPU 4
#endif
#ifndef NPV
#define NPV 4
#endif

__device__ __forceinline__ void peer_tile(const Args& A, LAS unsigned char* lds, int t0, int tid) {
    const bf16* qp = (const bf16*)(A.ws + WS_QP); const bf16* skb = (const bf16*)(A.ws + WS_SKB); const bf16* x1b = (const bf16*)(A.ws + WS_X1B);
    const bf16* Ub = (const bf16*)(A.ws + WS_UB); const bf16* Vb = (const bf16*)(A.ws + WS_VB); const float* ssq = (const float*)(A.ws + WS_SSQ);
    LAS unsigned* TK = (LAS unsigned*)lds;
    LAS int* SE = (LAS int*)(lds + 32768);
    LAS float* SG = (LAS float*)(lds + 49152);
    LAS float* ACT = (LAS float*)(lds + 65536);
    const int lane = tid & 63, wave = tid >> 6, h = lane >> 5, lq = lane & 31;
#ifndef DBG_NO_S1
#pragma unroll 1
    for (int repA = 0; repA < REP_P5A; ++repA) {
#pragma unroll 1
    for (int hp2 = 0; hp2 < 2; ++hp2) {
        const int hp = 2 * wave + hp2;
        bf16x8 qf[8];
#pragma unroll
        for (int ks = 0; ks < 8; ++ks) qf[ks] = *(const bf16x8*)(qp + (size_t)(t0 + lq) * D + hp * 128 + 16 * ks + 8 * h);
        unsigned key[64];
#pragma unroll
        for (int nt = 0; nt < 4; ++nt) {
            f32x16 c;
#pragma unroll
            for (int i = 0; i < 16; ++i) c[i] = 0.f;
#pragma unroll
            for (int ks = 0; ks < 8; ++ks) { const bf16x8 a = *(const bf16x8*)(skb + (size_t)(hp * 128 + 32 * nt + lq) * 128 + 16 * ks + 8 * h);
                c = __builtin_amdgcn_mfma_f32_32x32x16_bf16(a, qf[ks], c, 0, 0, 0); }
#pragma unroll
            for (int i = 0; i < 16; ++i) { const int n = 32 * nt + (i & 3) + 8 * (i >> 2) + 4 * h; key[16 * nt + i] = (mono_key(c[i]) & ~127u) | (unsigned)(127 - n); }
        }
#pragma unroll 1
        for (int r = 0; r < PTOPK; ++r) {
            unsigned M = key[0];
#pragma unroll
            for (int i = 1; i < 64; ++i) M = M > key[i] ? M : key[i];
            const unsigned pm = (unsigned)__shfl_xor((int)M, 32);
            M = M > pm ? M : pm;
            if (h == 0) TK[((lq * 16) + hp) * 16 + r] = M;
#pragma unroll
            for (int i = 0; i < 64; ++i) key[i] = key[i] == M ? 0u : key[i];
        }
    }
    __syncthreads();
    {
        const int ca = cand_a(lane < 50 ? lane : 0), cb_ = cand_b(lane < 50 ? lane : 0), myflat = ca * 16 + cb_;
#pragma unroll 1
        for (int i = 0; i < 32; ++i) {
            const int p = wave * 32 + i, t = p >> 3, hd = p & 7;
            const unsigned k1 = TK[(t * 16 + 2 * hd) * 16 + ca], k2 = TK[(t * 16 + 2 * hd + 1) * 16 + cb_];
            const float s = lane < 50 ? mono_val(k1 & ~127u) + mono_val(k2 & ~127u) : -3.0e38f;
            const unsigned ik = lane < 50 ? ((mono_key(s) & ~255u) | (unsigned)(255 - myflat)) : 0u;
            int rank = 0;
#pragma unroll
            for (int c = 0; c < 50; ++c) rank += ((unsigned)__builtin_amdgcn_readlane((int)ik, c) > ik) ? 1 : 0;
            const bool sel = lane < 50 && rank < PTOPK;
            const float smax = __uint_as_float((unsigned)__builtin_amdgcn_readlane((int)__float_as_uint(s), 0));
            const float ge = sel ? __expf(s - smax) : 0.f;
            const float gs = wave_sum(ge);
            if (sel) { SE[t * 128 + hd * 16 + rank] = (int)(127u - (k1 & 127u)) * NKEYS + (int)(127u - (k2 & 127u)); SG[t * 128 + hd * 16 + rank] = ge / gs; }
        }
    }
    __syncthreads();
    }
#endif
    {
        const int g = lane >> 4, l16 = lane & 15, tl = wave * 4 + g, t = t0 + tl;
        LAS unsigned* ORD = (LAS unsigned*)(lds + 81920);
        const LAS int* SEt = SE + tl * 128; LAS float* ACTt = ACT + tl * 128;
        {
            unsigned key[8]; int rank[8];
#pragma unroll
            for (int j = 0; j < 8; ++j) { key[j] = (((unsigned)SEt[j * 16 + l16] & (unsigned)(NEXP - 1)) << 7) | (unsigned)(j * 16 + l16); rank[j] = 0; }
#pragma unroll 4
            for (int m = 0; m < 128; ++m) { const unsigned km = (((unsigned)SEt[m] & (unsigned)(NEXP - 1)) << 7) | (unsigned)m;
#pragma unroll
                for (int j = 0; j < 8; ++j) rank[j] += km < key[j] ? 1 : 0; }
#pragma unroll
            for (int j = 0; j < 8; ++j) ORD[tl * 128 + rank[j]] = key[j];
            LDS_WAIT(); __builtin_amdgcn_wave_barrier();
        }
        const LAS unsigned* ORDt = ORD + tl * 128;
#ifndef DBG_NO_U
        {
            constexpr int NCH = 16 / NPU;
            const float rs = rsqrtf(ssq[t] * (1.f / D) + EPS);
#pragma unroll 1
            for (int ps = 0; ps < NPU * REP_P5U; ++ps) {
                const int pp = ps % NPU; const int cofs = (pp * (D / NPU) + l16 * 8) * 2;
                unsigned xq[4 * NCH];
                { const char* xr = (const char*)(x1b + (size_t)t * D) + cofs;
#pragma unroll
                  for (int j = 0; j < NCH; ++j) { const v4u w = *(const v4u*)(xr + 256 * j); xq[4 * j + 0] = w.x; xq[4 * j + 1] = w.y; xq[4 * j + 2] = w.z; xq[4 * j + 3] = w.w; } }
#pragma unroll 1
                for (int i = 0; i < 128; i += EPT) {
                    unsigned en[EPT]; v4u u[EPT][NCH];
#pragma unroll
                    for (int c = 0; c < EPT; ++c) { en[c] = ORDt[i + c]; const char* up = (const char*)Ub + (size_t)(en[c] >> 7) * (D * 2) + cofs;
#pragma unroll
                        for (int j = 0; j < NCH; ++j) u[c][j] = *(const v4u*)(up + 256 * j); }
#pragma unroll
                    for (int c = 0; c < EPT; ++c) { const float d = row_sum16(dotn<NCH>(xq, u[c]));
                        if (l16 == 0) { const int k = (int)(en[c] & 127u); ACTt[k] = (pp == 0 ? 0.f : ACTt[k]) + rs * d; } }
                }
                LDS_WAIT(); __builtin_amdgcn_wave_barrier();
            }
#pragma unroll
            for (int j = 0; j < 8; ++j) { const int ix = j * 16 + l16; const float hh = ACTt[ix];
                ACTt[ix] = 0.5f * hh * (1.f + erff(hh * 0.70710678118654752f)) * SG[tl * 128 + ix]; }
            LDS_WAIT(); __builtin_amdgcn_wave_barrier();
        }
#endif
#ifndef DBG_NO_V
        {
            constexpr int NCH = 16 / NPV;
#pragma unroll 1
            for (int ps = 0; ps < NPV * REP_P5V; ++ps) {
                const int pp = ps % NPV; const int cofs = (pp * (D / NPV) + l16 * 8) * 2;
                float acc[8 * NCH];
#pragma unroll
                for (int i = 0; i < 8 * NCH; ++i) acc[i] = 0.f;
#pragma unroll 1
                for (int i = 0; i < 128; i += EPT) {
                    unsigned en[EPT]; v4u v[EPT][NCH];
#pragma unroll
                    for (int c = 0; c < EPT; ++c) { en[c] = ORDt[i + c]; const char* vp = (const char*)Vb + (size_t)(en[c] >> 7) * (D * 2) + cofs;
#pragma unroll
                        for (int j = 0; j < NCH; ++j) v[c][j] = *(const v4u*)(vp + 256 * j); }
#pragma unroll
                    for (int c = 0; c < EPT; ++c) fman<NCH>(acc, ACTt[en[c] & 127u], v[c]);
                }
                if (ps < NPV) {
                    char* orow = (char*)(A.out + (size_t)t * D) + 2 * cofs;
#pragma unroll
                    for (int j = 0; j < NCH; ++j) {
                        f32x4 a = *(f32x4*)(orow + 512 * j), b = *(f32x4*)(orow + 512 * j + 16);
                        a.x += acc[8 * j + 0]; a.y += acc[8 * j + 1]; a.z += acc[8 * j + 2]; a.w += acc[8 * j + 3];
                        b.x += acc[8 * j + 4]; b.y += acc[8 * j + 5]; b.z += acc[8 * j + 6]; b.w += acc[8 * j + 7];
                        *(f32x4*)(orow + 512 * j) = a; *(f32x4*)(orow + 512 * j + 16) = b;
                    }
                }
            }
        }
#endif
    }
    __syncthreads();
}

__global__ void __launch_bounds__(NTHR, 2) mega_fwd(Args args) {
    extern __shared__ __attribute__((aligned(16))) unsigned char lds_raw[];
    LAS unsigned char* lds = (LAS unsigned char*)lds_raw;
    cg::grid_group grid = cg::this_grid();
    const int tid = threadIdx.x, G = gridDim.x, bx = blockIdx.x;
    const int vcu = (G % 8 == 0) ? (bx % 8) * (G / 8) + bx / 8 : bx;
    unsigned char* ws = args.ws;
    const int lo = args.ph_lo, hi = args.ph_hi;
#ifndef PH_MASK
#define PH_MASK 63
#endif
#define IN(k) (((PH_MASK >> (k)) & 1) && lo <= (k) && (k) < hi)
#define BOTH(k) (IN(k) && IN((k) + 1))
    if (IN(0)) { for (int rep = 0; rep < REP_P0; ++rep) { p0_prologue(args, lds, vcu, G, tid); __syncthreads(); } if (BOTH(0)) grid.sync(); }
    if (IN(1)) {
        pg8::Gemm g{(const bf16*)(ws + WS_XB), (const bf16*)(ws + WS_W1T), T, INC, D}; pg8::StaticOrder S; S.init(T, INC, G, bx);
        pg8::EpiScaleBf16<false> E{(bf16*)(ws + WS_PROJ), INC, (const float*)(ws + WS_RSTD1), args.b_in};
        for (int rep = 0; rep < REP_P1; ++rep) pg8::gemm_phase<pg8::EpiScaleBf16<false>, pg8::StaticOrder, PG8_ALIGN, PG8_SP2>(lds, g, S, E);
        if (BOTH(1)) grid.sync();
    }
    if (IN(2)) {
        for (int rep = 0; rep < REP_P2; ++rep) {
#ifndef NO_CONV
        for (int r2 = 0; r2 < REP_CONV; ++r2) for (int u = vcu; u < 256; u += G) conv_unit(args, lds, 32 * u, tid);
#endif
#ifndef NO_ATTN
        for (int r2 = 0; r2 < REP_ATTN; ++r2) for (int u = vcu; u < 256; u += G) attn_unit(args, lds, u >> 2, (u >> 1) & 1, u & 1, tid);
#endif
        }
        if (BOTH(2)) grid.sync();
    }
    if (IN(3)) {
        pg8::Gemm g{(const bf16*)(ws + WS_MIXED), (const bf16*)(ws + WS_W2T), T, D, D}; pg8::StaticOrder S; S.init(T, D, G, bx);
        pg8::EpiResid E{args.x, args.out, (bf16*)(ws + WS_X1B), (float*)(ws + WS_SSQ), D};
        pg8::gemm_phase<pg8::EpiResid, pg8::StaticOrder, PG8_ALIGN, PG8_SP2>(lds, g, S, E);
        if (BOTH(3)) grid.sync();
    }
    if (IN(4)) {
        pg8::Gemm g{(const bf16*)(ws + WS_X1B), (const bf16*)(ws + WS_W3T), T, D, D}; pg8::StaticOrder S; S.init(T, D, G, bx);
        pg8::EpiScaleBf16<true> E{(bf16*)(ws + WS_QP), D, (const float*)(ws + WS_SSQ), nullptr};
        for (int rep = 0; rep < REP_P4; ++rep) pg8::gemm_phase<pg8::EpiScaleBf16<true>, pg8::StaticOrder, PG8_ALIGN, PG8_SP2>(lds, g, S, E);
        if (BOTH(4)) grid.sync();
    }
    if (IN(5)) {
        for (int u = vcu; u < T / 32; u += G) peer_tile(args, lds, 32 * u, tid);
    }
#undef IN
#undef BOTH
}

__global__ void k_rope_naive(const int* __restrict__ pos, float* __restrict__ rope) {
    const int i = blockIdx.x * blockDim.x + threadIdx.x; if (i >= T * 8) return;
    const int t = i >> 3, f = i & 7; const float ang = (float)pos[t] * powf(500000.f, -(float)(2 * f) / 16.f); float sn, cs; sincosf(ang, &sn, &cs);
    rope[t * 16 + f] = cs; rope[t * 16 + 8 + f] = sn;
}

#ifndef MK_MODE
#define MK_MODE 1
#endif
#ifndef NAIVE_MASK
#define NAIVE_MASK 0
#endif
extern "C" void kernel_launch(void* const* d_in, const int* in_sizes, int n_in, void* d_out, int out_size, void* d_ws, size_t ws_size, hipStream_t stream) {
    static int grid = 0;
    if (grid == 0) {
        if (n_in != 18 || in_sizes[0] != T * D || out_size != T * D || ws_size < WS_END) {
            fprintf(stderr, "kernel_launch: unexpected shapes: n_in %d in0 %d out %d ws %zu (need %zu)\n", n_in, n_in > 0 ? in_sizes[0] : -1, out_size, ws_size, (size_t)WS_END); grid = -1; return; }
        int dev = 0, cus = 0, per_cu = 0;
        if (hipGetDevice(&dev) != hipSuccess || hipDeviceGetAttribute(&cus, hipDeviceAttributeMultiprocessorCount, dev) != hipSuccess) { fprintf(stderr, "kernel_launch: device query failed\n"); grid = -1; return; }
        if (hipFuncSetAttribute((const void*)mega_fwd, hipFuncAttributeMaxDynamicSharedMemorySize, LDS_BYTES) != hipSuccess) { fprintf(stderr, "kernel_launch: hipFuncSetAttribute failed\n"); grid = -1; return; }
        if (hipOccupancyMaxActiveBlocksPerMultiprocessor(&per_cu, (const void*)mega_fwd, NTHR, LDS_BYTES) != hipSuccess || per_cu < 1) {
            fprintf(stderr, "kernel_launch: occupancy query says %d blocks per CU\n", per_cu); (void)hipGetLastError(); per_cu = 1; }
        grid = cus * 1;
        (void)per_cu;
    }
    if (grid < 0) return;
    unsigned char* ws = (unsigned char*)d_ws;
    hipMemsetAsync(ws + WS_CTL, 0, CTL_ZERO_BYTES, stream);
    Args a{};
    a.x = (const float*)d_in[0]; a.pos = (const int*)d_in[1]; a.g1 = (const float*)d_in[2]; a.w_in = (const float*)d_in[3]; a.b_in = (const float*)d_in[4];
    a.cw = (const float*)d_in[5]; a.cb = (const float*)d_in[6]; a.lg = (const float*)d_in[7]; a.lb = (const float*)d_in[8]; a.qg = (const float*)d_in[9];
    a.kg = (const float*)d_in[10]; a.sinks = (const float*)d_in[11]; a.w_out = (const float*)d_in[12]; a.g2 = (const float*)d_in[13]; a.wq = (const float*)d_in[14];
    a.skeys = (const float*)d_in[15]; a.pu = (const float*)d_in[16]; a.pv = (const float*)d_in[17];
    a.out = (float*)d_out; a.ws = ws;
#if MK_MODE == 1
    a.ph_lo = 0; a.ph_hi = 6;
    void* kargs[] = {&a};
    hipError_t e = hipLaunchCooperativeKernel((const void*)mega_fwd, dim3(grid), dim3(NTHR), kargs, LDS_BYTES, stream);
    if (e != hipSuccess) fprintf(stderr, "kernel_launch: cooperative launch failed: %s (grid %d)\n", hipGetErrorString(e), grid);
#else
    float* ssq = (float*)(ws + WS_SSQ); float* rstd1 = (float*)(ws + WS_RSTD1); float* rope = (float*)(ws + WS_ROPE);
    bf16 *skb = (bf16*)(ws + WS_SKB), *w1t = (bf16*)(ws + WS_W1T), *w2t = (bf16*)(ws + WS_W2T), *w3t = (bf16*)(ws + WS_W3T);
    bf16 *xb = (bf16*)(ws + WS_XB), *proj = (bf16*)(ws + WS_PROJ), *mixed = (bf16*)(ws + WS_MIXED), *x1b = (bf16*)(ws + WS_X1B), *qp = (bf16*)(ws + WS_QP);
    bf16 *ub = (bf16*)(ws + WS_UB), *vb = (bf16*)(ws + WS_VB);
    for (int ph = 0; ph < 6; ++ph) {
        if (!((NAIVE_MASK >> ph) & 1)) { a.ph_lo = ph; a.ph_hi = ph + 1; hipLaunchKernelGGL(mega_fwd, dim3(grid), dim3(NTHR), LDS_BYTES, stream, a); continue; }
        switch (ph) {
        case 0:
            k_prep_x<<<1024, 256, 0, stream>>>(a.x, xb, rstd1);
            k_transpose_w<<<dim3(INC / 32, D / 32), 256, 0, stream>>>(a.w_in, a.g1, w1t, D, INC);
            k_transpose_w<<<dim3(D / 32, D / 32), 256, 0, stream>>>(a.w_out, nullptr, w2t, D, D);
            k_transpose_w<<<dim3(D / 32, D / 32), 256, 0, stream>>>(a.wq, a.g2, w3t, D, D);
            k_convert<<<256, 256, 0, stream>>>(a.skeys, nullptr, skb, (size_t)16 * 128 * 128 / 8, 128);
            k_convert<<<2048, 256, 0, stream>>>(a.pu, a.g2, ub, (size_t)NEXP * D / 8, D);
            k_convert<<<2048, 256, 0, stream>>>(a.pv, nullptr, vb, (size_t)NEXP * D / 8, D);
            k_rope_naive<<<T * 8 / 256, 256, 0, stream>>>(a.pos, rope);
            break;
        case 1: k_gemm_naive<EpiProj><<<dim3(INC / 64, T / 64), 256, 0, stream>>>(xb, w1t, T, INC, D, EpiProj{proj, rstd1, a.b_in}); break;
        case 2: k_conv_naive<<<T, 256, 0, stream>>>(proj, a.cw, a.cb, a.lg, a.lb, mixed);
                k_attn_naive<<<T * NQH / 4, 256, 0, stream>>>(proj, a.pos, a.qg, a.kg, a.sinks, mixed); break;
        case 3: k_gemm_naive<EpiX1><<<dim3(D / 64, T / 64), 256, 0, stream>>>(mixed, w2t, T, D, D, EpiX1{a.x, a.out, x1b});
                k_ssq<<<1024, 256, 0, stream>>>(a.out, ssq); break;
        case 4: k_gemm_naive<EpiQp><<<dim3(D / 64, T / 64), 256, 0, stream>>>(x1b, w3t, T, D, D, EpiQp{qp, ssq}); break;
        case 5: k_peer_naive<<<T / 4, 256, 0, stream>>>(qp, skb, x1b, ssq, ub, vb, a.out); break;
        }
    }
#endif
}
```

```cpp
#include <hip/hip_runtime.h>
#include <hip/hip_cooperative_groups.h>
namespace cg = cooperative_groups;
#include <cstdio>
#include <cstdint>

typedef unsigned short bf16;
typedef unsigned v4u __attribute__((ext_vector_type(4)));
typedef unsigned v2u __attribute__((ext_vector_type(2)));
typedef float f32x4 __attribute__((ext_vector_type(4)));

constexpr int T = 8192, D = 2048, CONVC = 1024, HD = 64, NQH = 16, NKVH = 2, ATT = 1024, KVC = 128;
constexpr int INC = 2 * CONVC + ATT + 2 * KVC;
constexpr int QOFF = 2 * CONVC, KOFF = QOFF + ATT, VOFF = KOFF + KVC;
constexpr int CK = 31, WIN = 128;
constexpr int NKEYS = 128, NEXP = NKEYS * NKEYS, PH = 8, PTOPK = 16;
constexpr float EPS = 1e-6f;

constexpr size_t MiB = 1u << 20;
constexpr size_t WS_CTL = 0, CTL_ZERO_BYTES = 1 * MiB;
constexpr size_t WS_BAR = 16 * 1024;
constexpr size_t WS_SSQ = 64 * 1024;
constexpr size_t WS_RSTD1 = 1 * MiB;
constexpr size_t WS_ROPE = 3 * MiB;
constexpr size_t WS_SKB = 2 * MiB;
constexpr size_t WS_W1T = 4 * MiB;
constexpr size_t WS_W2T = 20 * MiB;
constexpr size_t WS_W3T = 28 * MiB;
constexpr size_t WS_XB = 64 * MiB;
constexpr size_t WS_PROJ = 96 * MiB;
constexpr size_t WS_MIXED = 160 * MiB;
constexpr size_t WS_X1B = 192 * MiB;
constexpr size_t WS_QP = 224 * MiB;
constexpr size_t WS_UB = 256 * MiB;
constexpr size_t WS_VB = 320 * MiB;
constexpr size_t WS_END = 384 * MiB;

__device__ __forceinline__ unsigned f2bf(float f) { unsigned u = __float_as_uint(f); return (u + 0x7fffu + ((u >> 16) & 1u)) >> 16; }
__device__ __forceinline__ unsigned pk2(float lo, float hi) { return f2bf(lo) | (f2bf(hi) << 16); }
__device__ __forceinline__ float bf2f(unsigned b) { return __uint_as_float(b << 16); }
__device__ __forceinline__ float bflo(unsigned w) { return __uint_as_float(w << 16); }
__device__ __forceinline__ float bfhi(unsigned w) { return __uint_as_float(w & 0xffff0000u); }
__device__ __forceinline__ float wave_sum(float v) {
#pragma unroll
    for (int o = 1; o < 64; o <<= 1) v += __shfl_xor(v, o);
    return v;
}
__device__ __forceinline__ float wave_max(float v) {
#pragma unroll
    for (int o = 1; o < 64; o <<= 1) v = fmaxf(v, __shfl_xor(v, o));
    return v;
}
__device__ __forceinline__ int wave_min_i(int v) {
#pragma unroll
    for (int o = 1; o < 64; o <<= 1) { int t = __shfl_xor(v, o); v = t < v ? t : v; }
    return v;
}

__global__ void k_prep_x(const float* __restrict__ x, bf16* __restrict__ xb, float* __restrict__ rstd1) {
    const int lane = threadIdx.x & 63, gw = (blockIdx.x * blockDim.x + threadIdx.x) >> 6, ngw = (gridDim.x * blockDim.x) >> 6;
    for (int row = gw; row < T; row += ngw) {
        const f32x4* xr = (const f32x4*)(x + (size_t)row * D) + lane;
        f32x4 v[8]; float ss = 0.f;
#pragma unroll
        for (int j = 0; j < 8; ++j) { v[j] = xr[64 * j]; ss += v[j].x * v[j].x + v[j].y * v[j].y + v[j].z * v[j].z + v[j].w * v[j].w; }
        ss = wave_sum(ss);
        if (lane == 0) rstd1[row] = rsqrtf(ss * (1.f / D) + EPS);
        v2u* o = (v2u*)(xb + (size_t)row * D) + lane;
#pragma unroll
        for (int j = 0; j < 8; ++j) { v2u w; w.x = pk2(v[j].x, v[j].y); w.y = pk2(v[j].z, v[j].w); o[64 * j] = w; }
    }
}
__global__ void k_transpose_w(const float* __restrict__ W, const float* __restrict__ g, bf16* __restrict__ Wt, int K, int N) {
    __shared__ float tile[32][33];
    const int k0 = blockIdx.y * 32, n0 = blockIdx.x * 32, tx = threadIdx.x & 31, ty = threadIdx.x >> 5;
    for (int i = ty; i < 32; i += 8) { const float gv = g ? g[k0 + i] : 1.f; tile[i][tx] = W[(size_t)(k0 + i) * N + n0 + tx] * gv; }
    __syncthreads();
    for (int i = ty; i < 32; i += 8) Wt[(size_t)(n0 + i) * K + k0 + tx] = (bf16)f2bf(tile[tx][i]);
}
__global__ void k_convert(const float* __restrict__ src, const float* __restrict__ g, bf16* __restrict__ dst, size_t n8, int ncol) {
    for (size_t i = (size_t)blockIdx.x * blockDim.x + threadIdx.x; i < n8; i += (size_t)gridDim.x * blockDim.x) {
        f32x4 a = ((const f32x4*)src)[2 * i], b = ((const f32x4*)src)[2 * i + 1];
        if (g) { const int c = (int)((i * 8) % ncol); const f32x4 ga = *(const f32x4*)(g + c), gb = *(const f32x4*)(g + c + 4); a = a * ga; b = b * gb; }
        v4u w; w.x = pk2(a.x, a.y); w.y = pk2(a.z, a.w); w.z = pk2(b.x, b.y); w.w = pk2(b.z, b.w);
        ((v4u*)dst)[i] = w;
    }
}

struct EpiProj { bf16* proj; const float* rstd1; const float* bias;
    __device__ void operator()(int r, int c, float v) const { proj[(size_t)r * INC + c] = (bf16)f2bf(rstd1[r] * v + bias[c]); } };
struct EpiX1 { const float* x; float* out; bf16* x1b;
    __device__ void operator()(int r, int c, float v) const { const float x1 = x[(size_t)r * D + c] + v; out[(size_t)r * D + c] = x1; x1b[(size_t)r * D + c] = (bf16)f2bf(x1); } };
struct EpiQp { bf16* qp; const float* ssq;
    __device__ void operator()(int r, int c, float v) const { qp[(size_t)r * D + c] = (bf16)f2bf(rsqrtf(ssq[r] * (1.f / D) + EPS) * v); } };
template <class Epi>
__global__ void __launch_bounds__(256) k_gemm_naive(const bf16* __restrict__ A, const bf16* __restrict__ Bt, int M, int N, int K, Epi E) {
    __shared__ float As[32][65], Bs[32][65];
    const int tx = threadIdx.x & 15, ty = threadIdx.x >> 4, m0 = blockIdx.y * 64, n0 = blockIdx.x * 64;
    float acc[4][4] = {};
    for (int k0 = 0; k0 < K; k0 += 32) {
        for (int i = threadIdx.x; i < 64 * 32; i += 256) { const int r = i >> 5, k = i & 31;
            As[k][r] = bf2f(A[(size_t)(m0 + r) * K + k0 + k]); Bs[k][r] = bf2f(Bt[(size_t)(n0 + r) * K + k0 + k]); }
        __syncthreads();
#pragma unroll 8
        for (int k = 0; k < 32; ++k) {
            float a[4], b[4];
#pragma unroll
            for (int i = 0; i < 4; ++i) { a[i] = As[k][ty * 4 + i]; b[i] = Bs[k][tx * 4 + i]; }
#pragma unroll
            for (int i = 0; i < 4; ++i)
#pragma unroll
                for (int j = 0; j < 4; ++j) acc[i][j] += a[i] * b[j];
        }
        __syncthreads();
    }
#pragma unroll
    for (int i = 0; i < 4; ++i)
#pragma unroll
        for (int j = 0; j < 4; ++j) E(m0 + ty * 4 + i, n0 + tx * 4 + j, acc[i][j]);
}

__global__ void __launch_bounds__(256) k_conv_naive(const bf16* __restrict__ proj, const float* __restrict__ cw, const float* __restrict__ cb,
                                                     const float* __restrict__ lg, const float* __restrict__ lb, bf16* __restrict__ mixed) {
    __shared__ float red[2][4];
    const int t = blockIdx.x, c0 = threadIdx.x * 4, lane = threadIdx.x & 63, wv = threadIdx.x >> 6;
    float acc[4];
#pragma unroll
    for (int i = 0; i < 4; ++i) acc[i] = cb[c0 + i];
    for (int j = 0; j < CK; ++j) {
        const int tt = t + j - (CK - 1);
        if (tt < 0) continue;
        const v2u a = *(const v2u*)(proj + (size_t)tt * INC + c0), gt = *(const v2u*)(proj + (size_t)tt * INC + CONVC + c0);
        const float av[4] = {bflo(a.x), bfhi(a.x), bflo(a.y), bfhi(a.y)}, gv[4] = {bflo(gt.x), bfhi(gt.x), bflo(gt.y), bfhi(gt.y)};
#pragma unroll
        for (int i = 0; i < 4; ++i) { const float h = av[i] / (1.f + __expf(-gv[i])); acc[i] += h * cw[j * CONVC + c0 + i]; }
    }
    float s = acc[0] + acc[1] + acc[2] + acc[3];
    s = wave_sum(s); if (lane == 0) red[0][wv] = s; __syncthreads();
    const float mu = (red[0][0] + red[0][1] + red[0][2] + red[0][3]) * (1.f / CONVC);
    float q = 0.f;
#pragma unroll
    for (int i = 0; i < 4; ++i) { const float d = acc[i] - mu; q += d * d; }
    q = wave_sum(q); if (lane == 0) red[1][wv] = q; __syncthreads();
    const float rstd = rsqrtf((red[1][0] + red[1][1] + red[1][2] + red[1][3]) * (1.f / CONVC) + EPS);
    float o[4];
#pragma unroll
    for (int i = 0; i < 4; ++i) { const float y = (acc[i] - mu) * rstd * lg[c0 + i] + lb[c0 + i]; o[i] = y / (1.f + __expf(-y)); }
    v2u w; w.x = pk2(o[0], o[1]); w.y = pk2(o[2], o[3]);
    *(v2u*)(mixed + (size_t)t * D + c0) = w;
}

__global__ void __launch_bounds__(256) k_attn_naive(const bf16* __restrict__ proj, const int* __restrict__ pos, const float* __restrict__ qg, const float* __restrict__ kg,
                                                     const float* __restrict__ sinks, bf16* __restrict__ mixed) {
    __shared__ float qs[4][64];
    const int lane = threadIdx.x & 63, wv = threadIdx.x >> 6, gw = blockIdx.x * 4 + wv;
    const int t = gw >> 4, hq = gw & 15, kvh = hq >> 3;
    {
        float q = bf2f(proj[(size_t)t * INC + QOFF + hq * HD + lane]);
        const float ss = wave_sum(q * q);
        q = q * rsqrtf(ss * (1.f / HD) + EPS) * qg[lane];
        const float pv = __shfl(q, lane < 8 ? lane + 8 : (lane < 16 ? lane - 8 : lane));
        if (lane < 16) { const int i = lane & 7; const float ang = (float)pos[t] * powf(500000.f, -(float)(2 * i) / 16.f); float sn, cs; sincosf(ang, &sn, &cs);
            q = lane < 8 ? q * cs - pv * sn : q * cs + pv * sn; }
        qs[wv][lane] = q;
    }
    __syncthreads();
    float sc[2];
#pragma unroll
    for (int h = 0; h < 2; ++h) {
        const int kp = t - lane - 64 * h;
        float s = -1e30f;
        if (kp >= 0) {
            const bf16* kr = proj + (size_t)kp * INC + KOFF + kvh * HD;
            float kv[64]; float ss = 0.f;
#pragma unroll
            for (int d = 0; d < 64; ++d) { kv[d] = bf2f(kr[d]); ss += kv[d] * kv[d]; }
            const float r = rsqrtf(ss * (1.f / HD) + EPS);
#pragma unroll
            for (int d = 0; d < 64; ++d) kv[d] = kv[d] * r * kg[d];
            const float p = (float)pos[kp];
#pragma unroll
            for (int i = 0; i < 8; ++i) { const float ang = p * powf(500000.f, -(float)(2 * i) / 16.f); float sn, cs; sincosf(ang, &sn, &cs);
                const float r1 = kv[i], r2 = kv[i + 8]; kv[i] = r1 * cs - r2 * sn; kv[i + 8] = r2 * cs + r1 * sn; }
            float dot = 0.f;
#pragma unroll
            for (int d = 0; d < 64; ++d) dot += kv[d] * qs[wv][d];
            s = dot * 0.125f;
        }
        sc[h] = s;
    }
    const float sink = sinks[hq];
    const float m = fmaxf(wave_max(fmaxf(sc[0], sc[1])), sink);
    const float p0 = (t - lane >= 0) ? __expf(sc[0] - m) : 0.f, p1 = (t - lane - 64 >= 0) ? __expf(sc[1] - m) : 0.f;
    const float denom = wave_sum(p0 + p1) + __expf(sink - m);
    float acc = 0.f;
    for (int j = 0; j < WIN; ++j) {
        const float pj = __shfl(j < 64 ? p0 : p1, j & 63);
        const int kp = t - j;
        if (kp >= 0) acc += pj * bf2f(proj[(size_t)kp * INC + VOFF + kvh * HD + lane]);
    }
    mixed[(size_t)t * D + CONVC + hq * HD + lane] = (bf16)f2bf(acc / denom);
}

__global__ void k_ssq(const float* __restrict__ x1, float* __restrict__ ssq) {
    const int lane = threadIdx.x & 63, gw = (blockIdx.x * blockDim.x + threadIdx.x) >> 6, ngw = (gridDim.x * blockDim.x) >> 6;
    for (int row = gw; row < T; row += ngw) {
        const f32x4* xr = (const f32x4*)(x1 + (size_t)row * D) + lane; float ss = 0.f;
#pragma unroll
        for (int j = 0; j < 8; ++j) { const f32x4 v = xr[64 * j]; ss += v.x * v.x + v.y * v.y + v.z * v.z + v.w * v.w; }
        ss = wave_sum(ss); if (lane == 0) ssq[row] = ss;
    }
}

__global__ void __launch_bounds__(256) k_peer_naive(const bf16* __restrict__ qp, const bf16* __restrict__ skb, const bf16* __restrict__ x1b, const float* __restrict__ ssq,
                                                     const bf16* __restrict__ Ub, const bf16* __restrict__ Vb, float* __restrict__ out) {
    __shared__ float q_s[4][256];
    __shared__ float tkv[4][2][16];
    __shared__ int tki[4][2][16];
    __shared__ int sel_e[4][128];
    __shared__ float sel_g[4][128];
    __shared__ float act[4][128];
    const int lane = threadIdx.x & 63, wv = threadIdx.x >> 6, t = blockIdx.x * 4 + wv;
    const float rstd2 = rsqrtf(ssq[t] * (1.f / D) + EPS);
    for (int h = 0; h < PH; ++h) {
        for (int i = lane; i < 256; i += 64) q_s[wv][i] = bf2f(qp[(size_t)t * D + h * 256 + i]);
        __builtin_amdgcn_s_waitcnt(0); __builtin_amdgcn_wave_barrier();
        for (int p = 0; p < 2; ++p) {
            float v0 = 0.f, v1 = 0.f;
            const bf16* k0 = skb + ((size_t)(h * 2 + p) * NKEYS + lane) * 128, * k1 = k0 + 64 * 128;
            for (int c8 = 0; c8 < 16; ++c8) {
                const v4u a = ((const v4u*)k0)[c8], b = ((const v4u*)k1)[c8]; const float* qv = &q_s[wv][p * 128 + c8 * 8];
                v0 += qv[0] * bflo(a.x) + qv[1] * bfhi(a.x) + qv[2] * bflo(a.y) + qv[3] * bfhi(a.y) + qv[4] * bflo(a.z) + qv[5] * bfhi(a.z) + qv[6] * bflo(a.w) + qv[7] * bfhi(a.w);
                v1 += qv[0] * bflo(b.x) + qv[1] * bfhi(b.x) + qv[2] * bflo(b.y) + qv[3] * bfhi(b.y) + qv[4] * bflo(b.z) + qv[5] * bfhi(b.z) + qv[6] * bflo(b.w) + qv[7] * bfhi(b.w);
            }
            float tv = 0.f; int ti = 0;
            for (int r = 0; r < PTOPK; ++r) {
                const float M = wave_max(fmaxf(v0, v1));
                const int cn = (v0 == M) ? lane : ((v1 == M) ? lane + 64 : 9999);
                const int nm = wave_min_i(cn);
                if (lane == r) { tv = M; ti = nm; }
                if (nm == lane) v0 = -3.0e38f;
                if (nm == lane + 64) v1 = -3.0e38f;
            }
            if (lane < 16) { tkv[wv][p][lane] = tv; tki[wv][p][lane] = ti; }
        }
        __builtin_amdgcn_s_waitcnt(0); __builtin_amdgcn_wave_barrier();
        float cs[4];
#pragma unroll
        for (int i = 0; i < 4; ++i) cs[i] = tkv[wv][0][lane >> 2] + tkv[wv][1][(lane & 3) * 4 + i];
        float sv = 0.f; int sf = 0;
        for (int r = 0; r < PTOPK; ++r) {
            const float M = wave_max(fmaxf(fmaxf(cs[0], cs[1]), fmaxf(cs[2], cs[3])));
            int cn = 9999;
#pragma unroll
            for (int i = 3; i >= 0; --i) if (cs[i] == M) cn = (lane >> 2) * 16 + (lane & 3) * 4 + i;
            const int nm = wave_min_i(cn);
            if (lane == r) { sv = M; sf = nm; }
#pragma unroll
            for (int i = 0; i < 4; ++i) if (nm == (lane >> 2) * 16 + (lane & 3) * 4 + i) cs[i] = -3.0e38f;
        }
        const float smax = __shfl(sv, 0);
        const float ge = lane < 16 ? __expf(sv - smax) : 0.f;
        const float gs = wave_sum(ge);
        if (lane < 16) { sel_e[wv][h * 16 + lane] = tki[wv][0][sf >> 4] * NKEYS + tki[wv][1][sf & 15]; sel_g[wv][h * 16 + lane] = ge / gs; }
        __builtin_amdgcn_s_waitcnt(0); __builtin_amdgcn_wave_barrier();
    }
    {
        const v4u* xr = (const v4u*)(x1b + (size_t)t * D) + lane;
        float xv[32];
#pragma unroll
        for (int j = 0; j < 4; ++j) { const v4u w = xr[64 * j]; xv[8 * j + 0] = bflo(w.x); xv[8 * j + 1] = bfhi(w.x); xv[8 * j + 2] = bflo(w.y); xv[8 * j + 3] = bfhi(w.y);
            xv[8 * j + 4] = bflo(w.z); xv[8 * j + 5] = bfhi(w.z); xv[8 * j + 6] = bflo(w.w); xv[8 * j + 7] = bfhi(w.w); }
        for (int k = 0; k < 128; ++k) {
            const v4u* ur = (const v4u*)(Ub + (size_t)sel_e[wv][k] * D) + lane; float dot = 0.f;
#pragma unroll
            for (int j = 0; j < 4; ++j) { const v4u w = ur[64 * j];
                dot += xv[8 * j + 0] * bflo(w.x) + xv[8 * j + 1] * bfhi(w.x) + xv[8 * j + 2] * bflo(w.y) + xv[8 * j + 3] * bfhi(w.y)
                     + xv[8 * j + 4] * bflo(w.z) + xv[8 * j + 5] * bfhi(w.z) + xv[8 * j + 6] * bflo(w.w) + xv[8 * j + 7] * bfhi(w.w); }
            dot = wave_sum(dot);
            const float hh = rstd2 * dot;
            if (lane == 0) act[wv][k] = 0.5f * hh * (1.f + erff(hh * 0.70710678118654752f)) * sel_g[wv][k];
        }
    }
    __builtin_amdgcn_s_waitcnt(0); __builtin_amdgcn_wave_barrier();
    {
        float acc[32];
#pragma unroll
        for (int i = 0; i < 32; ++i) acc[i] = 0.f;
        for (int k = 0; k < 128; ++k) {
            const v4u* vr = (const v4u*)(Vb + (size_t)sel_e[wv][k] * D) + lane; const float a = act[wv][k];
#pragma unroll
            for (int j = 0; j < 4; ++j) { const v4u w = vr[64 * j];
                acc[8 * j + 0] += a * bflo(w.x); acc[8 * j + 1] += a * bfhi(w.x); acc[8 * j + 2] += a * bflo(w.y); acc[8 * j + 3] += a * bfhi(w.y);
                acc[8 * j + 4] += a * bflo(w.z); acc[8 * j + 5] += a * bfhi(w.z); acc[8 * j + 6] += a * bflo(w.w); acc[8 * j + 7] += a * bfhi(w.w); }
        }
        f32x4* orow = (f32x4*)(out + (size_t)t * D);
#pragma unroll
        for (int j = 0; j < 4; ++j) {
            f32x4 a = orow[128 * j + 2 * lane], b = orow[128 * j + 2 * lane + 1];
            a.x += acc[8 * j + 0]; a.y += acc[8 * j + 1]; a.z += acc[8 * j + 2]; a.w += acc[8 * j + 3];
            b.x += acc[8 * j + 4]; b.y += acc[8 * j + 5]; b.z += acc[8 * j + 6]; b.w += acc[8 * j + 7];
            orow[128 * j + 2 * lane] = a; orow[128 * j + 2 * lane + 1] = b;
        }
    }
}


namespace pg8 {
#define PG8_LAS __attribute__((address_space(3)))
typedef unsigned short bf16_t;
typedef short bf16x8 __attribute__((ext_vector_type(8)));
typedef float f32x4 __attribute__((ext_vector_type(4)));
typedef unsigned u32x4 __attribute__((ext_vector_type(4)));
constexpr int BM = 256, BK = 64, HALF = 128, HTB = HALF * BK * 2  , STAGE_BYTES = 8 * HTB, NXCD = 8, WGM = 8;

__host__ __device__ __forceinline__ int lds_byte(int r, int c) { const int st = (r >> 4) * 2 + (c >> 5), rr = r & 15, cc = c & 31, ob = rr * 64 + cc * 2; return st * 1024 + (ob ^ (((ob >> 9) & 1) << 5)); }
__host__ __device__ __forceinline__ void stage_rc(int b, int& R, int& C) { const int st = b / 1024, sb = b % 1024, swz = sb ^ (((sb >> 9) & 1) << 5); R = (st >> 1) * 16 + swz / 64; C = (st & 1) * 32 + (swz % 64) / 2; }
__host__ __device__ __forceinline__ int perm32(int rho) { const int n = rho >> 4, i = rho & 15; return 8 * (i >> 2) + 4 * n + (i & 3); }

struct Unit { int pm, pn; };
struct Gemm { const bf16_t* A; const bf16_t* Bt; int M, N, K; };

struct StaticOrder {
    int nM, nN, nwg, G, c;
    __host__ __device__ void init(int M, int N, int G_, int c_) { nM = M / BM; nN = N / BM; nwg = nM * nN; G = G_; c = c_; }
    __host__ __device__ bool next(int i, Unit& u) const {
        const long L = (long)i * G + c; if (L >= nwg) return false;
        int wgid = (int)L; { const int q = nwg / NXCD, r = nwg % NXCD, xcd = wgid % NXCD, off = wgid / NXCD; wgid = (xcd < r ? xcd * (q + 1) : r * (q + 1) + (xcd - r) * q) + off; }
        const int nig = WGM * nN, gid = wgid / nig, fm = gid * WGM, gsz = (nM - fm) < WGM ? (nM - fm) : WGM;
        u.pm = fm + ((wgid % nig) % gsz); u.pn = (wgid % nig) / gsz; return true;
    }
    __device__ __forceinline__ void a_ready(const Unit&) const {}
    __device__ __forceinline__ void done(const Unit&) const {}
};

__device__ __forceinline__ unsigned cvt_pk_bf16(float lo, float hi) { unsigned r; asm volatile("v_cvt_pk_bf16_f32 %0, %1, %2" : "=v"(r) : "v"(lo), "v"(hi)); return r; }

template <bool RSQ> struct EpiScaleBf16 {
    static constexpr bool PERM = true, AFTER_DRAIN = false;
    bf16_t* O; int ldc; const float* sv; const float* bias;
    __device__ __forceinline__ void operator()(const f32x4 (&acc)[2][2][4][2], const Unit& u, int wr, int wc, int fr, int fq) const {
        const int row0 = u.pm * BM + wr * 64 + fr, col0 = u.pn * BM + wc * 32 + 8 * fq;
        f32x4 bv[2][2];
#pragma unroll
        for (int bj = 0; bj < 2; ++bj)
#pragma unroll
            for (int n = 0; n < 2; ++n) bv[bj][n] = bias ? *(const f32x4*)(bias + col0 + bj * HALF + 4 * n) : (f32x4){0.f, 0.f, 0.f, 0.f};
#pragma unroll
        for (int ai = 0; ai < 2; ++ai)
#pragma unroll
            for (int m = 0; m < 4; ++m) { const int r = row0 + ai * HALF + m * 16; float s = sv[r]; if (RSQ) s = rsqrtf(s * (1.0f / 2048.0f) + 1e-6f);
                bf16_t* rowp = O + (size_t)r * ldc + col0;
#pragma unroll
                for (int bj = 0; bj < 2; ++bj) { const f32x4 v0 = acc[ai][bj][m][0] * s + bv[bj][0], v1 = acc[ai][bj][m][1] * s + bv[bj][1];
                    u32x4 w; w.x = cvt_pk_bf16(v0[0], v0[1]); w.y = cvt_pk_bf16(v0[2], v0[3]); w.z = cvt_pk_bf16(v1[0], v1[1]); w.w = cvt_pk_bf16(v1[2], v1[3]);
                    *(u32x4*)(rowp + bj * HALF) = w; } }
    }
};
struct EpiResid {
    static constexpr bool PERM = true, AFTER_DRAIN = false;
    const float* X; float* out; bf16_t* x1b; float* ssq; int ldc;
    __device__ __forceinline__ void operator()(const f32x4 (&acc)[2][2][4][2], const Unit& u, int wr, int wc, int fr, int fq) const {
        const int row0 = u.pm * BM + wr * 64 + fr, col0 = u.pn * BM + wc * 32 + 8 * fq;
#pragma unroll
        for (int ai = 0; ai < 2; ++ai)
#pragma unroll
            for (int m = 0; m < 4; ++m) { const int r = row0 + ai * HALF + m * 16; const size_t off = (size_t)r * ldc + col0; float q = 0.f;
#pragma unroll
                for (int bj = 0; bj < 2; ++bj) {
                    const f32x4 v0 = *(const f32x4*)(X + off + bj * HALF) + acc[ai][bj][m][0], v1 = *(const f32x4*)(X + off + bj * HALF + 4) + acc[ai][bj][m][1];
                    *(f32x4*)(out + off + bj * HALF) = v0; *(f32x4*)(out + off + bj * HALF + 4) = v1;
                    u32x4 w; w.x = cvt_pk_bf16(v0[0], v0[1]); w.y = cvt_pk_bf16(v0[2], v0[3]); w.z = cvt_pk_bf16(v1[0], v1[1]); w.w = cvt_pk_bf16(v1[2], v1[3]);
                    *(u32x4*)(x1b + off + bj * HALF) = w;
                    q += (v0[0] * v0[0] + v0[1] * v0[1]) + (v0[2] * v0[2] + v0[3] * v0[3]) + (v1[0] * v1[0] + v1[1] * v1[1]) + (v1[2] * v1[2] + v1[3] * v1[3]); }
                q += __shfl_xor(q, 16); q += __shfl_xor(q, 32);
                if (fq == 0) atomicAdd(ssq + r, q);
                asm volatile("" ::: "memory"); }
    }
};
template <class Epi, class Sched, bool ALIGN_EPI = false, bool SP2 = false>
__device__ __forceinline__ void gemm_phase(PG8_LAS unsigned char* lds, const Gemm g, const Sched& S, const Epi& E) {
    const int tid = threadIdx.x, wid = __builtin_amdgcn_readfirstlane(tid >> 6), lane = tid & 63, wr = wid >> 2, wc = wid & 3, fr = lane & 15, fq = lane >> 4;
    const int K = g.K, nt = K / BK;
    unsigned voffA[2], voffB[2];
#pragma unroll
    for (int i = 0; i < 2; ++i) { int R, C; stage_rc(tid * 16 + i * 8192, R, C); const int Rb = Epi::PERM ? ((R & ~31) + perm32(R & 31)) : R;
        voffA[i] = (unsigned)(R * K + C) * 2u; voffB[i] = (unsigned)(Rb * K + C) * 2u; }
    const size_t kstep = (size_t)(BK * 2);
    const size_t hstep = (size_t)HALF * K * 2;
    const size_t tstep = 2 * hstep;
    const unsigned ldsw = (unsigned)wid * 1024u;
    const int aoff = lds_byte(wr * 64 + fr, fq * 8), boff = lds_byte(wc * 32 + fr, fq * 8);
#define PG8_SA(b, h) (((b) * 2 + (h)) * HTB)
#define PG8_SB(b, h) ((4 + (b) * 2 + (h)) * HTB)
#define PG8_STAGE(bufoff, gbase, voff) do { _Pragma("unroll") for (int _i = 0; _i < 2; ++_i) \
        __builtin_amdgcn_global_load_lds((const unsigned*)((const char*)(gbase) + (voff)[_i]), (PG8_LAS unsigned*)(lds + (bufoff) + ldsw + _i * 8192), 16, 0, 0); } while (0)
#define PG8_LDA(dst, b, h) do { _Pragma("unroll") for (int m = 0; m < 4; ++m) _Pragma("unroll") for (int k = 0; k < 2; ++k) dst[m][k] = *(const PG8_LAS bf16x8*)(lds + PG8_SA(b, h) + aoff + m * 2048 + k * 1024); } while (0)
#define PG8_LDB(dst, b, h) do { _Pragma("unroll") for (int n = 0; n < 2; ++n) _Pragma("unroll") for (int k = 0; k < 2; ++k) dst[n][k] = *(const PG8_LAS bf16x8*)(lds + PG8_SB(b, h) + boff + n * 2048 + k * 1024); } while (0)
#define PG8_MMA(ai, bj, At, Bt) do { __builtin_amdgcn_s_setprio(1); _Pragma("unroll") for (int m = 0; m < 4; ++m) _Pragma("unroll") for (int n = 0; n < 2; ++n) _Pragma("unroll") for (int k = 0; k < 2; ++k) \
        acc[ai][bj][m][n] = __builtin_amdgcn_mfma_f32_16x16x32_bf16(Bt[n][k], At[m][k], acc[ai][bj][m][n], 0, 0, 0); __builtin_amdgcn_s_setprio(0); } while (0)
#define PG8_WAIT_V(n) asm volatile("s_waitcnt vmcnt(" #n ")" ::: "memory")
#define PG8_WAIT_L(n) asm volatile("s_waitcnt lgkmcnt(" #n ")" ::: "memory")
#define PG8_BAR __builtin_amdgcn_s_barrier()
#define PG8_SCHED __builtin_amdgcn_sched_barrier(0)
    Unit cur, nxt; int ui = 0;
    if (!S.next(0, cur)) return;
    f32x4 acc[2][2][4][2];
#pragma unroll
    for (int a = 0; a < 2; ++a)
#pragma unroll
        for (int b = 0; b < 2; ++b)
#pragma unroll
            for (int m = 0; m < 4; ++m)
#pragma unroll
                for (int n = 0; n < 2; ++n) acc[a][b][m][n] = (f32x4){0.f, 0.f, 0.f, 0.f};
    bf16x8 At[4][2], B0[2][2], B1[2][2];
    const char* cA = (const char*)g.A + (size_t)cur.pm * tstep; const char* cB = (const char*)g.Bt + (size_t)cur.pn * tstep;
    S.a_ready(cur);
    if constexpr (SP2) {
        PG8_STAGE(PG8_SB(0, 0), cB, voffB); PG8_STAGE(PG8_SB(0, 1), cB + hstep, voffB); PG8_STAGE(PG8_SA(0, 0), cA, voffA); PG8_STAGE(PG8_SA(0, 1), cA + hstep, voffA);
        if (wr == 1) PG8_BAR;
        PG8_WAIT_V(2); PG8_BAR;
        PG8_STAGE(PG8_SB(1, 0), cB + kstep, voffB); PG8_STAGE(PG8_SA(1, 0), cA + kstep, voffA); PG8_STAGE(PG8_SB(1, 1), cB + hstep + kstep, voffB);
        PG8_WAIT_V(6); PG8_BAR;
    } else {
        PG8_STAGE(PG8_SB(0, 0), cB, voffB); PG8_STAGE(PG8_SA(0, 0), cA, voffA); PG8_STAGE(PG8_SB(0, 1), cB + hstep, voffB); PG8_STAGE(PG8_SA(0, 1), cA + hstep, voffA);
        if (wr == 1) PG8_BAR;
        PG8_WAIT_V(4); PG8_BAR;
        PG8_STAGE(PG8_SB(1, 0), cB + kstep, voffB); PG8_STAGE(PG8_SA(1, 0), cA + kstep, voffA); PG8_STAGE(PG8_SB(1, 1), cB + hstep + kstep, voffB);
        PG8_WAIT_V(6); PG8_BAR;
    }
    for (;;) {
        const bool has_next = S.next(ui + 1, nxt);
        const char* nA = has_next ? (const char*)g.A + (size_t)nxt.pm * tstep : cA; const char* nB = has_next ? (const char*)g.Bt + (size_t)nxt.pn * tstep : cB;
        for (int t = 0; t < nt; t += 2) {
            const bool last = (t == nt - 2);
            const char* a1 = cA + (size_t)(t + 1) * kstep;
            const char* a2 = last ? nA : cA + (size_t)(t + 2) * kstep; const char* b2 = last ? nB : cB + (size_t)(t + 2) * kstep;
            const char* a3 = a2 + kstep; const char* b3 = b2 + kstep;
            if (last && has_next) S.a_ready(nxt);
            if constexpr (SP2) {
            PG8_LDB(B0, 0, 0); PG8_LDB(B1, 0, 1); PG8_SCHED; PG8_LDA(At, 0, 0); PG8_STAGE(PG8_SA(1, 1), a1 + hstep, voffA);
            PG8_WAIT_V(8); PG8_WAIT_L(0); PG8_BAR; PG8_MMA(0, 0, At, B0); PG8_MMA(0, 1, At, B1); PG8_BAR; PG8_SCHED;
            PG8_LDA(At, 0, 1); PG8_STAGE(PG8_SB(0, 0), b2, voffB); PG8_STAGE(PG8_SB(0, 1), b2 + hstep, voffB); PG8_STAGE(PG8_SA(0, 0), a2, voffA);
            PG8_WAIT_V(8); PG8_WAIT_L(0); PG8_BAR; PG8_MMA(1, 0, At, B0); PG8_MMA(1, 1, At, B1); PG8_BAR; PG8_SCHED;
            PG8_LDB(B0, 1, 0); PG8_LDB(B1, 1, 1); PG8_SCHED; PG8_LDA(At, 1, 0); PG8_STAGE(PG8_SA(0, 1), a2 + hstep, voffA);
            PG8_WAIT_V(8); PG8_WAIT_L(0); PG8_BAR; PG8_MMA(0, 0, At, B0); PG8_MMA(0, 1, At, B1); PG8_BAR; PG8_SCHED;
            PG8_LDA(At, 1, 1); PG8_STAGE(PG8_SB(1, 0), b3, voffB); PG8_STAGE(PG8_SB(1, 1), b3 + hstep, voffB); PG8_STAGE(PG8_SA(1, 0), a3, voffA);
            PG8_WAIT_V(8); PG8_WAIT_L(0); PG8_BAR; PG8_MMA(1, 0, At, B0); PG8_MMA(1, 1, At, B1); PG8_BAR; PG8_SCHED;
            } else {
            PG8_LDB(B0, 0, 0); PG8_SCHED; PG8_LDA(At, 0, 0); PG8_STAGE(PG8_SA(1, 1), a1 + hstep, voffA);
            PG8_WAIT_L(8); PG8_BAR; PG8_WAIT_L(0); PG8_MMA(0, 0, At, B0); PG8_BAR; PG8_SCHED;
            PG8_LDB(B1, 0, 1); PG8_STAGE(PG8_SB(0, 0), b2, voffB);
            PG8_BAR; PG8_WAIT_L(0); PG8_MMA(0, 1, At, B1); PG8_BAR;
            PG8_LDA(At, 0, 1); PG8_STAGE(PG8_SA(0, 0), a2, voffA);
            PG8_BAR; PG8_WAIT_L(0); PG8_MMA(1, 0, At, B0); PG8_BAR; PG8_SCHED;
            PG8_STAGE(PG8_SB(0, 1), b2 + hstep, voffB);
            PG8_WAIT_V(6); PG8_BAR; PG8_MMA(1, 1, At, B1); PG8_BAR;
            PG8_LDB(B0, 1, 0); PG8_SCHED; PG8_LDA(At, 1, 0); PG8_STAGE(PG8_SA(0, 1), a2 + hstep, voffA);
            PG8_WAIT_L(8); PG8_BAR; PG8_WAIT_L(0); PG8_MMA(0, 0, At, B0); PG8_BAR; PG8_SCHED;
            PG8_LDB(B1, 1, 1); PG8_STAGE(PG8_SB(1, 0), b3, voffB);
            PG8_BAR; PG8_WAIT_L(0); PG8_MMA(0, 1, At, B1); PG8_BAR;
            PG8_LDA(At, 1, 1); PG8_STAGE(PG8_SA(1, 0), a3, voffA);
            PG8_BAR; PG8_WAIT_L(0); PG8_MMA(1, 0, At, B0); PG8_BAR; PG8_SCHED;
            PG8_STAGE(PG8_SB(1, 1), b3 + hstep, voffB);
            PG8_WAIT_V(6); PG8_BAR; PG8_MMA(1, 1, At, B1); PG8_BAR;
            }
        }
        if constexpr (ALIGN_EPI) { if (wr == 0) PG8_BAR; }
        if constexpr (!Epi::AFTER_DRAIN) { E(acc, cur, wr, wc, fr, fq); S.done(cur); }
        if (!has_next) break;
#pragma unroll
        for (int a = 0; a < 2; ++a)
#pragma unroll
            for (int b = 0; b < 2; ++b)
#pragma unroll
                for (int m = 0; m < 4; ++m)
#pragma unroll
                    for (int n = 0; n < 2; ++n) acc[a][b][m][n] = (f32x4){0.f, 0.f, 0.f, 0.f};
        cur = nxt; cA = nA; cB = nB; ++ui;
        if constexpr (ALIGN_EPI) { if (wr == 1) PG8_BAR; }
    }
    PG8_WAIT_V(0);
    if constexpr (!ALIGN_EPI) { if (wr == 0) PG8_BAR; }
    PG8_BAR;
    if constexpr (Epi::AFTER_DRAIN) { E.fused(acc, cur, wr, wc, fr, fq, lds, wid, lane); S.done(cur); }
#undef PG8_SA
#undef PG8_SB
#undef PG8_STAGE
#undef PG8_LDA
#undef PG8_LDB
#undef PG8_MMA
#undef PG8_WAIT_V
#undef PG8_WAIT_L
#undef PG8_BAR
#undef PG8_SCHED
}
}

#ifndef REP_P0
#define REP_P0 1
#endif
#ifndef REP_P1
#define REP_P1 1
#endif
#ifndef REP_P2
#define REP_P2 1
#endif
#ifndef REP_CONV
#define REP_CONV 1
#endif
#ifndef REP_ATTN
#define REP_ATTN 1
#endif
#ifndef REP_P4
#define REP_P4 1
#endif
#ifndef REP_P5A
#define REP_P5A 1
#endif
#ifndef REP_P5U
#define REP_P5U 1
#endif
#ifndef REP_P5V
#define REP_P5V 1
#endif
#ifndef PG8_SP2
#define PG8_SP2 true
#endif
#ifndef PG8_ALIGN
#define PG8_ALIGN true
#endif

constexpr float VSCALE = 128.f;
constexpr float USCALE = 2048.f;
constexpr int NWAVES = 8, NTHR = 512;
constexpr int LDS_BYTES = 160 * 1024;
#define LAS __attribute__((address_space(3)))
typedef short bf16x8 __attribute__((ext_vector_type(8)));
typedef float f32x16 __attribute__((ext_vector_type(16)));
typedef float f32x2 __attribute__((ext_vector_type(2)));
#define LDS_WAIT() asm volatile("s_waitcnt lgkmcnt(0)" ::: "memory")

struct Args {
    const float* x; const int* pos; const float* g1; const float* w_in; const float* b_in; const float* cw; const float* cb; const float* lg; const float* lb;
    const float* qg; const float* kg; const float* sinks; const float* w_out; const float* g2; const float* wq; const float* skeys; const float* pu; const float* pv;
    float* out; unsigned char* ws; int ph_lo, ph_hi;
};

__device__ __forceinline__ void p0_transpose_item(const float* W, const float* g, int K, int N, bf16* WT, LAS float* scr, int item, int lane) {
    const int nblk = N / 32, kb = item / nblk, nb = item % nblk, k0 = 64 * kb, n0 = 32 * nb;
#pragma unroll 8
    for (int i = 0; i < 32; ++i) { const int kk = 2 * i + (lane >> 5); const float gv = g ? g[k0 + kk] : 1.f; scr[kk * 33 + (lane & 31)] = W[(size_t)(k0 + kk) * N + n0 + (lane & 31)] * gv; }
    LDS_WAIT(); asm volatile("" ::: "memory");
    const int c = lane & 7;
#pragma unroll
    for (int j = 0; j < 4; ++j) { const int n = (lane >> 3) + 8 * j; const LAS float* s = scr + (8 * c) * 33 + n;
        v4u o; o.x = pk2(s[0 * 33], s[1 * 33]); o.y = pk2(s[2 * 33], s[3 * 33]); o.z = pk2(s[4 * 33], s[5 * 33]); o.w = pk2(s[6 * 33], s[7 * 33]);
        *(v4u*)(WT + (size_t)(n0 + n) * K + k0 + 8 * c) = o; }
    LDS_WAIT(); asm volatile("" ::: "memory");
}
__device__ __forceinline__ void p0_convert(const float* src, const float* g, bf16* dst, size_t n8, int ncol, size_t gtid, size_t nthr) {
    for (size_t i = gtid; i < n8; i += nthr) {
        f32x4 a = ((const f32x4*)src)[2 * i], b = ((const f32x4*)src)[2 * i + 1];
        if (g) { const int c = (int)((i * 8) % ncol); const f32x4 ga = *(const f32x4*)(g + c), gb = *(const f32x4*)(g + c + 4); a = a * ga; b = b * gb; }
        v4u w; w.x = pk2(a.x, a.y); w.y = pk2(a.z, a.w); w.z = pk2(b.x, b.y); w.w = pk2(b.z, b.w);
        ((v4u*)dst)[i] = w;
    }
}
__device__ __forceinline__ void p0_convert_fp8(const float* src, unsigned char* dst, size_t n16, float scale, size_t gtid, size_t nthr) {
    for (size_t i = gtid; i < n16; i += nthr) {
        v4u w;
#pragma unroll
        for (int q = 0; q < 4; ++q) { const f32x4 a = ((const f32x4*)src)[4 * i + q] * scale;
            int d = __builtin_amdgcn_cvt_pk_fp8_f32(a.x, a.y, 0, false); d = __builtin_amdgcn_cvt_pk_fp8_f32(a.z, a.w, d, true); w[q] = (unsigned)d; }
        ((v4u*)dst)[i] = w;
    }
}
__device__ __forceinline__ void p0_convert_fp8g(const float* src, const float* g, unsigned char* dst, size_t n16, float scale, size_t gtid, size_t nthr) {
    for (size_t i = gtid; i < n16; i += nthr) {
        v4u w; const int c0 = (int)((i * 16) % D);
#pragma unroll
        for (int q = 0; q < 4; ++q) { const f32x4 a = ((const f32x4*)src)[4 * i + q] * *(const f32x4*)(g + c0 + 4 * q) * scale;
            int d = __builtin_amdgcn_cvt_pk_fp8_f32(a.x, a.y, 0, false); d = __builtin_amdgcn_cvt_pk_fp8_f32(a.z, a.w, d, true); w[q] = (unsigned)d; }
        ((v4u*)dst)[i] = w;
    }
}
__device__ __forceinline__ void p0_prologue(const Args& A, LAS unsigned char* lds, int vcu, int G, int tid) {
    const int lane = tid & 63, wave = tid >> 6;
    unsigned char* ws = A.ws;
    LAS float* scr = (LAS float*)(lds + wave * 16384);
    const int gw = vcu * NWAVES + wave, NGW = G * NWAVES;
    constexpr int I_1 = (D / 64) * (INC / 32), I_2 = (D / 64) * (D / 32);
    for (int it = gw; it < I_1 + 2 * I_2; it += NGW) {
        int r = it;
        if (r < I_1) { p0_transpose_item(A.w_in, A.g1, D, INC, (bf16*)(ws + WS_W1T), scr, r, lane); continue; } r -= I_1;
        if (r < I_2) { p0_transpose_item(A.w_out, nullptr, D, D, (bf16*)(ws + WS_W2T), scr, r, lane); continue; } r -= I_2;
        p0_transpose_item(A.wq, A.g2, D, D, (bf16*)(ws + WS_W3T), scr, r, lane);
    }
    {
        bf16* xb = (bf16*)(ws + WS_XB); float* rstd1 = (float*)(ws + WS_RSTD1);
        for (int row = gw; row < T; row += NGW) {
            const f32x4* xr = (const f32x4*)(A.x + (size_t)row * D) + lane;
            f32x4 v[8]; float ss = 0.f;
#pragma unroll
            for (int j = 0; j < 8; ++j) { v[j] = xr[64 * j]; ss += v[j].x * v[j].x + v[j].y * v[j].y + v[j].z * v[j].z + v[j].w * v[j].w; }
            ss = wave_sum(ss);
            if (lane == 0) rstd1[row] = rsqrtf(ss * (1.f / D) + EPS);
            v2u* o = (v2u*)(xb + (size_t)row * D) + lane;
#pragma unroll
            for (int j = 0; j < 8; ++j) { v2u w; w.x = pk2(v[j].x, v[j].y); w.y = pk2(v[j].z, v[j].w); o[64 * j] = w; }
        }
    }
    const size_t gtid = (size_t)vcu * NTHR + tid, nthr = (size_t)G * NTHR;
    {
        float* rope = (float*)(ws + WS_ROPE);
        for (size_t i = gtid; i < (size_t)T * 8; i += nthr) { const int t = (int)(i >> 3), f = (int)(i & 7);
            const float ang = (float)A.pos[t] * powf(500000.f, -(float)(2 * f) / 16.f); float sn, cs; sincosf(ang, &sn, &cs);
            rope[t * 16 + f] = cs; rope[t * 16 + 8 + f] = sn; }
    }
    p0_convert(A.skeys, nullptr, (bf16*)(ws + WS_SKB), (size_t)16 * 128 * 128 / 8, 128, gtid, nthr);
    p0_convert_fp8g(A.pu, A.g2, ws + WS_UB, (size_t)NEXP * D / 16, USCALE, gtid, nthr);
    p0_convert_fp8(A.pv, ws + WS_VB, (size_t)NEXP * D / 16, VSCALE, gtid, nthr);
}

__device__ __forceinline__ void conv_unit(const Args& A, LAS unsigned char* lds, int t0, int tid) {
    const bf16* proj = (const bf16*)(A.ws + WS_PROJ); bf16* mixed = (bf16*)(A.ws + WS_MIXED);
    const int lane = tid & 63, wave = tid >> 6;
    LAS bf16* H = (LAS bf16*)lds;
    for (int it = tid; it < 62 * 128; it += NTHR) {
        const int row = it >> 7, ch = (it & 127) * 8, tt = t0 - 30 + row;
        v4u w = {0u, 0u, 0u, 0u};
        if (tt >= 0) {
            const v4u a = *(const v4u*)(proj + (size_t)tt * INC + ch), g = *(const v4u*)(proj + (size_t)tt * INC + CONVC + ch);
            const unsigned aw[4] = {a.x, a.y, a.z, a.w}, gw_[4] = {g.x, g.y, g.z, g.w}; unsigned ow[4];
#pragma unroll
            for (int q = 0; q < 4; ++q) { const float h0 = bflo(aw[q]) / (1.f + __expf(-bflo(gw_[q]))), h1 = bfhi(aw[q]) / (1.f + __expf(-bfhi(gw_[q]))); ow[q] = pk2(h0, h1); }
            w.x = ow[0]; w.y = ow[1]; w.z = ow[2]; w.w = ow[3];
        }
        *(LAS v4u*)(H + row * 1024 + ch) = w;
    }
    __syncthreads();
    LAS float* Cf = (LAS float*)(lds + 62 * 1024 * 2);
    float w0[CK], w1[CK];
#pragma unroll
    for (int j = 0; j < CK; ++j) { const f32x2 wv = *(const f32x2*)(A.cw + j * CONVC + 2 * tid); w0[j] = wv.x; w1[j] = wv.y; }
    const f32x2 bv = *(const f32x2*)(A.cb + 2 * tid);
#pragma unroll 1
    for (int c = 0; c < 4; ++c) {
        float a0[8], a1[8];
#pragma unroll
        for (int tt = 0; tt < 8; ++tt) { a0[tt] = bv.x; a1[tt] = bv.y; }
        const LAS bf16* Hc = H + (8 * c) * 1024 + 2 * tid;
#pragma unroll
        for (int i = 0; i < 38; ++i) {
            const unsigned hw = *(const LAS unsigned*)(Hc + i * 1024); const float h0 = bflo(hw), h1 = bfhi(hw);
#pragma unroll
            for (int tt = 0; tt < 8; ++tt) { const int j = i - tt; if (j >= 0 && j < CK) { a0[tt] += h0 * w0[j]; a1[tt] += h1 * w1[j]; } }
        }
#pragma unroll
        for (int tt = 0; tt < 8; ++tt) *(LAS f32x2*)(Cf + tt * 1024 + 2 * tid) = (f32x2){a0[tt], a1[tt]};
        __syncthreads();
        {
            const int tt = wave;
            f32x4 v[4]; float s = 0.f;
#pragma unroll
            for (int j = 0; j < 4; ++j) { v[j] = *(const LAS f32x4*)(Cf + tt * 1024 + 4 * lane + 256 * j); s += (v[j].x + v[j].y) + (v[j].z + v[j].w); }
            const float mu = wave_sum(s) * (1.f / CONVC); float s2 = 0.f;
#pragma unroll
            for (int j = 0; j < 4; ++j) { v[j] = v[j] - mu; s2 += (v[j].x * v[j].x + v[j].y * v[j].y) + (v[j].z * v[j].z + v[j].w * v[j].w); }
            const float rstd = rsqrtf(wave_sum(s2) * (1.f / CONVC) + EPS);
#pragma unroll
            for (int j = 0; j < 4; ++j) {
                const int ch = 4 * lane + 256 * j; const f32x4 gg = *(const f32x4*)(A.lg + ch), bb = *(const f32x4*)(A.lb + ch);
                f32x4 y = v[j] * rstd * gg + bb;
                y.x = y.x / (1.f + __expf(-y.x)); y.y = y.y / (1.f + __expf(-y.y)); y.z = y.z / (1.f + __expf(-y.z)); y.w = y.w / (1.f + __expf(-y.w));
                v2u w; w.x = pk2(y.x, y.y); w.y = pk2(y.z, y.w);
                *(v2u*)(mixed + (size_t)(t0 + 8 * c + tt) * D + ch) = w;
            }
        }
        __syncthreads();
    }
}

__device__ __forceinline__ void attn_unit(const Args& A, LAS unsigned char* lds, int qb, int kvh, int gh, int tid) {
    const bf16* proj = (const bf16*)(A.ws + WS_PROJ); bf16* mixed = (bf16*)(A.ws + WS_MIXED); const float* rope = (const float*)(A.ws + WS_ROPE);
    constexpr int KST = 72, VST = 260;
    LAS bf16* Kn = (LAS bf16*)lds;
    LAS bf16* Vt = (LAS bf16*)(lds + 256 * KST * 2);
    const int lane = tid & 63, wave = tid >> 6;
    const int kbase = (qb - 1) * 128;
    {
        const int key = tid >> 1, half = tid & 1, kp = kbase + key;
        float v[32]; unsigned vw[16];
        if (kp >= 0) {
            const v4u* kr = (const v4u*)(proj + (size_t)kp * INC + KOFF + kvh * HD + 32 * half);
            const v4u* vr = (const v4u*)(proj + (size_t)kp * INC + VOFF + kvh * HD + 32 * half);
#pragma unroll
            for (int j = 0; j < 4; ++j) { const v4u w = kr[j]; v[8 * j + 0] = bflo(w.x); v[8 * j + 1] = bfhi(w.x); v[8 * j + 2] = bflo(w.y); v[8 * j + 3] = bfhi(w.y);
                v[8 * j + 4] = bflo(w.z); v[8 * j + 5] = bfhi(w.z); v[8 * j + 6] = bflo(w.w); v[8 * j + 7] = bfhi(w.w);
                const v4u u = vr[j]; vw[4 * j + 0] = u.x; vw[4 * j + 1] = u.y; vw[4 * j + 2] = u.z; vw[4 * j + 3] = u.w; }
        } else {
#pragma unroll
            for (int i = 0; i < 32; ++i) v[i] = 0.f;
#pragma unroll
            for (int i = 0; i < 16; ++i) vw[i] = 0u;
        }
        float ss = 0.f;
#pragma unroll
        for (int i = 0; i < 32; ++i) ss += v[i] * v[i];
        ss += __shfl_xor(ss, 1);
        const float r = rsqrtf(ss * (1.f / HD) + EPS);
#pragma unroll
        for (int i = 0; i < 32; ++i) v[i] = v[i] * r * A.kg[32 * half + i];
        if (half == 0 && kp >= 0) {
#pragma unroll
            for (int i = 0; i < 8; ++i) { const float cs = rope[kp * 16 + i], sn = rope[kp * 16 + 8 + i]; const float r1 = v[i], r2 = v[i + 8]; v[i] = r1 * cs - r2 * sn; v[i + 8] = r2 * cs + r1 * sn; }
        }
#pragma unroll
        for (int j = 0; j < 4; ++j) { v4u w; w.x = pk2(v[8 * j + 0], v[8 * j + 1]); w.y = pk2(v[8 * j + 2], v[8 * j + 3]); w.z = pk2(v[8 * j + 4], v[8 * j + 5]); w.w = pk2(v[8 * j + 6], v[8 * j + 7]);
            *(LAS v4u*)(Kn + key * KST + 32 * half + 8 * j) = w; }
#pragma unroll
        for (int i = 0; i < 16; ++i) { Vt[(32 * half + 2 * i) * VST + key] = (bf16)(vw[i] & 0xffffu); Vt[(32 * half + 2 * i + 1) * VST + key] = (bf16)(vw[i] >> 16); }
    }
    __syncthreads();
    const int hq = kvh * 8 + gh * 4 + (wave >> 1);
    const float sink = A.sinks[hq];
    const int h = lane >> 5, lq = lane & 31;
#pragma unroll 1
    for (int si = 0; si < 2; ++si) {
        const int s = (wave & 1) * 2 + si;
        const int qtok = qb * 128 + 32 * s + lq;
        bf16x8 qf[4];
        {
            float qv[4][8]; float ss = 0.f;
#pragma unroll
            for (int ks = 0; ks < 4; ++ks) { const v4u w = *(const v4u*)(proj + (size_t)qtok * INC + QOFF + hq * HD + 16 * ks + 8 * h);
                qv[ks][0] = bflo(w.x); qv[ks][1] = bfhi(w.x); qv[ks][2] = bflo(w.y); qv[ks][3] = bfhi(w.y); qv[ks][4] = bflo(w.z); qv[ks][5] = bfhi(w.z); qv[ks][6] = bflo(w.w); qv[ks][7] = bfhi(w.w);
#pragma unroll
                for (int j = 0; j < 8; ++j) ss += qv[ks][j] * qv[ks][j]; }
            ss += __shfl_xor(ss, 32);
            const float r = rsqrtf(ss * (1.f / HD) + EPS) * 0.125f;
#pragma unroll
            for (int ks = 0; ks < 4; ++ks)
#pragma unroll
                for (int j = 0; j < 8; ++j) qv[ks][j] = qv[ks][j] * r * A.qg[16 * ks + 8 * h + j];
#pragma unroll
            for (int j = 0; j < 8; ++j) { const float pv = __shfl_xor(qv[0][j], 32); const float cs = rope[qtok * 16 + j], sn = rope[qtok * 16 + 8 + j];
                qv[0][j] = h == 0 ? qv[0][j] * cs - pv * sn : qv[0][j] * cs + pv * sn; }
#pragma unroll
            for (int ks = 0; ks < 4; ++ks) { v4u w; w.x = pk2(qv[ks][0], qv[ks][1]); w.y = pk2(qv[ks][2], qv[ks][3]); w.z = pk2(qv[ks][4], qv[ks][5]); w.w = pk2(qv[ks][6], qv[ks][7]);
                qf[ks] = __builtin_bit_cast(bf16x8, w); }
        }
        f32x16 S[5];
#pragma unroll
        for (int k5 = 0; k5 < 5; ++k5) {
            f32x16 c;
#pragma unroll
            for (int i = 0; i < 16; ++i) c[i] = 0.f;
#pragma unroll
            for (int ks = 0; ks < 4; ++ks) { const bf16x8 a = *(const LAS bf16x8*)(Kn + (32 * (s + k5) + lq) * KST + 16 * ks + 8 * h);
                c = __builtin_amdgcn_mfma_f32_32x32x16_bf16(a, qf[ks], c, 0, 0, 0); }
            S[k5] = c;
        }
        float m = sink;
#pragma unroll
        for (int k5 = 0; k5 < 5; ++k5)
#pragma unroll
            for (int i = 0; i < 16; ++i) {
                const int keyb = 32 * (s + k5) + (i & 3) + 8 * (i >> 2) + 4 * h, diff = 128 + 32 * s + lq - keyb;
                const bool valid = diff >= 0 && diff < WIN && (qb > 0 || keyb >= 128);
                const float sv = valid ? S[k5][i] : -1e30f; S[k5][i] = sv; m = fmaxf(m, sv);
            }
        m = fmaxf(m, __shfl_xor(m, 32));
        float l = 0.f;
#pragma unroll
        for (int k5 = 0; k5 < 5; ++k5)
#pragma unroll
            for (int i = 0; i < 16; ++i) { const float p = __expf(S[k5][i] - m); S[k5][i] = p; l += p; }
        l += __shfl_xor(l, 32);
        l += __expf(sink - m);
        f32x16 O0, O1;
#pragma unroll
        for (int i = 0; i < 16; ++i) { O0[i] = 0.f; O1[i] = 0.f; }
#pragma unroll
        for (int k5 = 0; k5 < 5; ++k5)
#pragma unroll
            for (int s2 = 0; s2 < 2; ++s2) {
                v4u pw; pw.x = pk2(S[k5][8 * s2 + 0], S[k5][8 * s2 + 1]); pw.y = pk2(S[k5][8 * s2 + 2], S[k5][8 * s2 + 3]);
                pw.z = pk2(S[k5][8 * s2 + 4], S[k5][8 * s2 + 5]); pw.w = pk2(S[k5][8 * s2 + 6], S[k5][8 * s2 + 7]);
                const bf16x8 pf = __builtin_bit_cast(bf16x8, pw);
                const int kk = 32 * (s + k5) + 16 * s2 + 4 * h;
                { const v2u lo = *(const LAS v2u*)(Vt + lq * VST + kk), hi = *(const LAS v2u*)(Vt + lq * VST + kk + 8);
                  v4u aw; aw.x = lo.x; aw.y = lo.y; aw.z = hi.x; aw.w = hi.y;
                  O0 = __builtin_amdgcn_mfma_f32_32x32x16_bf16(__builtin_bit_cast(bf16x8, aw), pf, O0, 0, 0, 0); }
                { const v2u lo = *(const LAS v2u*)(Vt + (32 + lq) * VST + kk), hi = *(const LAS v2u*)(Vt + (32 + lq) * VST + kk + 8);
                  v4u aw; aw.x = lo.x; aw.y = lo.y; aw.z = hi.x; aw.w = hi.y;
                  O1 = __builtin_amdgcn_mfma_f32_32x32x16_bf16(__builtin_bit_cast(bf16x8, aw), pf, O1, 0, 0, 0); }
            }
        const float inv = 1.f / l;
        bf16* orow = mixed + (size_t)qtok * D + CONVC + hq * HD;
#pragma unroll
        for (int g = 0; g < 4; ++g) {
            v2u w0; w0.x = pk2(O0[4 * g + 0] * inv, O0[4 * g + 1] * inv); w0.y = pk2(O0[4 * g + 2] * inv, O0[4 * g + 3] * inv);
            *(v2u*)(orow + 8 * g + 4 * h) = w0;
            v2u w1; w1.x = pk2(O1[4 * g + 0] * inv, O1[4 * g + 1] * inv); w1.y = pk2(O1[4 * g + 2] * inv, O1[4 * g + 3] * inv);
            *(v2u*)(orow + 32 + 8 * g + 4 * h) = w1;
        }
    }
    __syncthreads();
}

typedef __attribute__((address_space(1))) unsigned gu32;
#define XB_TMO      128
#define XB_XCNT(j)  (256  + 64 * (j))
#define XB_XSUB(j)  (1280 + 64 * (j))
#define XB_XGEN(j)  (2304 + 64 * (j))
#define XB_TOP      3328
#define XB_TOPGEN   3392
#define XCD_BAR_WORDS 3456
#define XB_SPIN_CAP (1u << 18)
__device__ __forceinline__ unsigned xb_ld(unsigned* p)              { return __hip_atomic_load(p, __ATOMIC_RELAXED, __HIP_MEMORY_SCOPE_AGENT); }
__device__ __forceinline__ unsigned xb_add(unsigned* p, unsigned v) { return __hip_atomic_fetch_add(p, v, __ATOMIC_RELAXED, __HIP_MEMORY_SCOPE_AGENT); }
__device__ __forceinline__ unsigned xb_xcc_id() { return (unsigned)__builtin_amdgcn_s_getreg((3 << 11) | 20) & 0xFu; }
#define XB_SPIN(cond, bar) do { unsigned _sp = 0; while (cond) { __builtin_amdgcn_s_sleep(1); \
    if ((++_sp & 255u) == 0u) { if (xb_ld(&(bar)[XB_TMO])) break; if (_sp > XB_SPIN_CAP) { atomicAdd(&(bar)[XB_TMO], 1u); break; } } } } while (0)
struct XcdBarrier { unsigned* bar; unsigned x; volatile LAS unsigned* st; };
__device__ __forceinline__ XcdBarrier xcd_barrier_post(unsigned* bar, volatile LAS unsigned* st) {
    XcdBarrier b; b.bar = bar; b.x = xb_xcc_id(); b.st = st;
    if (threadIdx.x == 0) (void)xb_add(&bar[XB_XCNT(b.x)], 1u);
    return b;
}
__device__ __forceinline__ void xcd_barrier_complete(unsigned* bar, unsigned x, unsigned& nloc, unsigned& nx) {
    const unsigned G = gridDim.x * gridDim.y * gridDim.z;
    unsigned sum, cnt, mine, sp = 0u;
    for (;;) {
        sum = 0u; cnt = 0u; mine = 0u;
#pragma unroll
        for (unsigned j = 0; j < 16; ++j) { const unsigned c = xb_ld(&bar[XB_XCNT(j)]); sum += c; cnt += (c > 0u) ? 1u : 0u; mine = (j == x) ? c : mine; }
        if (sum == G) break;
        __builtin_amdgcn_s_sleep(1);
        if ((++sp & 255u) == 0u) { if (xb_ld(&bar[XB_TMO])) break; if (sp > XB_SPIN_CAP) { atomicAdd(&bar[XB_TMO], 1u); break; } }
    }
    nloc = mine > 0u ? mine : 1u; nx = cnt > 0u ? cnt : 1u;
}
__device__ __forceinline__ void xcd_barrier(const XcdBarrier& b) {
    asm volatile("s_waitcnt vmcnt(0)" ::: "memory");
    __syncthreads();
    if (threadIdx.x == 0) {
        unsigned* bar = b.bar;
        __builtin_amdgcn_s_waitcnt(0);
        unsigned nloc = b.st[0], nx = b.st[1];
        if (nloc == 0u) { xcd_barrier_complete(bar, b.x, nloc, nx); b.st[0] = nloc; b.st[1] = nx; }
        const unsigned old = xb_add(&bar[XB_XSUB(b.x)], 1u);
        const unsigned gen = old / nloc;
        if (old + 1u == (gen + 1u) * nloc) {
            __builtin_amdgcn_fence(__ATOMIC_RELEASE, "agent");
            asm volatile("s_waitcnt vmcnt(0)" ::: "memory");
            const unsigned og = xb_add(&bar[XB_TOP], 1u);
            const unsigned tg = og / nx;
            if (og + 1u == (tg + 1u) * nx) xb_add(&bar[XB_TOPGEN], 1u);
            else XB_SPIN(xb_ld(&bar[XB_TOPGEN]) == tg, bar);
            __builtin_amdgcn_fence(__ATOMIC_ACQUIRE, "agent");
            xb_add(&bar[XB_XGEN(b.x)], 1u);
            asm volatile("s_waitcnt vmcnt(0)" ::: "memory");
        } else {
            XB_SPIN(xb_ld(&bar[XB_XGEN(b.x)]) == gen, bar);
            __builtin_amdgcn_fence(__ATOMIC_ACQUIRE, "agent");
            asm volatile("s_waitcnt vmcnt(0)" ::: "memory");
        }
    }
    __syncthreads();
}
#ifndef USE_XCD_BAR
#define USE_XCD_BAR 1
#endif


__device__ __forceinline__ unsigned mono_key(float f) { const unsigned u = __float_as_uint(f); return u ^ ((unsigned)((int)u >> 31) | 0x80000000u); }
__device__ __forceinline__ float mono_val(unsigned k) { const unsigned u = (k & 0x80000000u) ? (k ^ 0x80000000u) : ~k; return __uint_as_float(u); }
__host__ __device__ constexpr int cand_a(int c) { return c < 16 ? 0 : c < 24 ? 1 : c < 29 ? 2 : c < 33 ? 3 : c < 36 ? 4 : c < 38 ? 5 : c < 40 ? 6 : c < 42 ? 7 : c - 34; }
__host__ __device__ constexpr int cand_b(int c) { return c < 16 ? c : c < 24 ? c - 16 : c < 29 ? c - 24 : c < 33 ? c - 29 : c < 36 ? c - 33 : c < 38 ? c - 36 : c < 40 ? c - 38 : c < 42 ? c - 40 : 0; }

typedef __bf16 bf16x2 __attribute__((ext_vector_type(2)));
__device__ __forceinline__ float dot2bf(unsigned w, unsigned x, float acc) { return __builtin_amdgcn_fdot2_f32_bf16(__builtin_bit_cast(bf16x2, w), __builtin_bit_cast(bf16x2, x), acc, false); }
template <int JC> __device__ __forceinline__ float dotn(const unsigned (&x)[4 * JC], const v4u (&u)[JC]) {
    float a0 = 0.f, a1 = 0.f, a2 = 0.f, a3 = 0.f;
#pragma unroll
    for (int j = 0; j < JC; ++j) { a0 = dot2bf(u[j].x, x[4 * j + 0], a0); a1 = dot2bf(u[j].y, x[4 * j + 1], a1); a2 = dot2bf(u[j].z, x[4 * j + 2], a2); a3 = dot2bf(u[j].w, x[4 * j + 3], a3); }
    return (a0 + a1) + (a2 + a3);
}
template <int JC> __device__ __forceinline__ void fman(float (&acc)[8 * JC], float a, const v4u (&v)[JC]) {
#pragma unroll
    for (int j = 0; j < JC; ++j) { const v4u w = v[j];
        acc[8 * j + 0] += a * bflo(w.x); acc[8 * j + 1] += a * bfhi(w.x); acc[8 * j + 2] += a * bflo(w.y); acc[8 * j + 3] += a * bfhi(w.y);
        acc[8 * j + 4] += a * bflo(w.z); acc[8 * j + 5] += a * bfhi(w.z); acc[8 * j + 6] += a * bflo(w.w); acc[8 * j + 7] += a * bfhi(w.w); }
}
__device__ __forceinline__ float row_sum16(float v) {
    v += __builtin_bit_cast(float, __builtin_amdgcn_update_dpp(0, __builtin_bit_cast(int, v), 0x128, 0xF, 0xF, true));
    v += __builtin_bit_cast(float, __builtin_amdgcn_update_dpp(0, __builtin_bit_cast(int, v), 0x124, 0xF, 0xF, true));
    v += __builtin_bit_cast(float, __builtin_amdgcn_update_dpp(0, __builtin_bit_cast(int, v), 0x122, 0xF, 0xF, true));
    v += __builtin_bit_cast(float, __builtin_amdgcn_update_dpp(0, __builtin_bit_cast(int, v), 0x121, 0xF, 0xF, true));
    return v;
}
#ifndef EPT
#define EPT 2
#endif
#ifndef NPU
#define NPU 4
#endif
#ifndef NPV
#define NPV 4
#endif

#ifndef PASS_BAR
#define PASS_BAR 0
#endif
__device__ __forceinline__ void peer_tile(const Args& A, LAS unsigned char* lds, int t0, int tid, const XcdBarrier& xbar) {
    const bf16* qp = (const bf16*)(A.ws + WS_QP); const bf16* skb = (const bf16*)(A.ws + WS_SKB); const bf16* x1b = (const bf16*)(A.ws + WS_X1B);
    const bf16* Ub = (const bf16*)(A.ws + WS_UB); const bf16* Vb = (const bf16*)(A.ws + WS_VB); const float* ssq = (const float*)(A.ws + WS_SSQ);
    LAS unsigned* TK = (LAS unsigned*)lds;
    LAS int* SE = (LAS int*)(lds + 32768);
    LAS float* SG = (LAS float*)(lds + 49152);
    LAS float* ACT = (LAS float*)(lds + 65536);
    const int lane = tid & 63, wave = tid >> 6, h = lane >> 5, lq = lane & 31;
#ifndef DBG_NO_S1
#pragma unroll 1
    for (int repA = 0; repA < REP_P5A; ++repA) {
#pragma unroll 1
    for (int hp2 = 0; hp2 < 2; ++hp2) {
        const int hp = 2 * wave + hp2;
        bf16x8 qf[8];
#pragma unroll
        for (int ks = 0; ks < 8; ++ks) qf[ks] = *(const bf16x8*)(qp + (size_t)(t0 + lq) * D + hp * 128 + 16 * ks + 8 * h);
        unsigned key[64];
#pragma unroll
        for (int nt = 0; nt < 4; ++nt) {
            f32x16 c;
#pragma unroll
            for (int i = 0; i < 16; ++i) c[i] = 0.f;
#pragma unroll
            for (int ks = 0; ks < 8; ++ks) { const bf16x8 a = *(const bf16x8*)(skb + (size_t)(hp * 128 + 32 * nt + lq) * 128 + 16 * ks + 8 * h);
                c = __builtin_amdgcn_mfma_f32_32x32x16_bf16(a, qf[ks], c, 0, 0, 0); }
#pragma unroll
            for (int i = 0; i < 16; ++i) { const int n = 32 * nt + (i & 3) + 8 * (i >> 2) + 4 * h; key[16 * nt + i] = (mono_key(c[i]) & ~127u) | (unsigned)(127 - n); }
        }
        unsigned cprev = 0xFFFFFFFFu;
#pragma unroll 1
        for (int r = 0; r < PTOPK; ++r) {
            unsigned m = cprev - key[0];
#pragma unroll
            for (int i = 1; i < 64; ++i) { const unsigned d = cprev - key[i]; m = m < d ? m : d; }
            const unsigned pm = (unsigned)__shfl_xor((int)m, 32);
            m = m < pm ? m : pm;
            const unsigned M = cprev - m;
            if (h == 0) TK[((lq * 16) + hp) * 16 + r] = M;
            cprev = M - 1u;
        }
    }
    __syncthreads();
    {
        const int ca = cand_a(lane < 50 ? lane : 0), cb_ = cand_b(lane < 50 ? lane : 0), myflat = ca * 16 + cb_;
#pragma unroll 1
        for (int i = 0; i < 32; ++i) {
            const int p = wave * 32 + i, t = p >> 3, hd = p & 7;
            const unsigned k1 = TK[(t * 16 + 2 * hd) * 16 + ca], k2 = TK[(t * 16 + 2 * hd + 1) * 16 + cb_];
            const float s = lane < 50 ? mono_val(k1 & ~127u) + mono_val(k2 & ~127u) : -3.0e38f;
            const unsigned ik = lane < 50 ? ((mono_key(s) & ~255u) | (unsigned)(255 - myflat)) : 0u;
            int rank = 0;
#pragma unroll
            for (int c = 0; c < 50; ++c) rank += ((unsigned)__builtin_amdgcn_readlane((int)ik, c) > ik) ? 1 : 0;
            const bool sel = lane < 50 && rank < PTOPK;
            const float smax = __uint_as_float((unsigned)__builtin_amdgcn_readlane((int)__float_as_uint(s), 0));
            const float ge = sel ? __expf(s - smax) : 0.f;
            const float gs = wave_sum(ge);
            if (sel) { SE[t * 128 + hd * 16 + rank] = (int)(127u - (k1 & 127u)) * NKEYS + (int)(127u - (k2 & 127u)); SG[t * 128 + hd * 16 + rank] = ge / gs; }
        }
    }
    __syncthreads();
    }
#endif
    {
        const int g = lane >> 4, l16 = lane & 15, tl = wave * 4 + g, t = t0 + tl;
        LAS unsigned* ORD = (LAS unsigned*)(lds + 81920);
        const LAS int* SEt = SE + tl * 128; LAS float* ACTt = ACT + tl * 128;
        {
            unsigned key[8]; int rank[8];
#pragma unroll
            for (int j = 0; j < 8; ++j) { key[j] = (((unsigned)SEt[j * 16 + l16] & (unsigned)(NEXP - 1)) << 7) | (unsigned)(j * 16 + l16); rank[j] = 0; }
#pragma unroll 4
            for (int m = 0; m < 128; ++m) { const unsigned km = (((unsigned)SEt[m] & (unsigned)(NEXP - 1)) << 7) | (unsigned)m;
#pragma unroll
                for (int j = 0; j < 8; ++j) rank[j] += km < key[j] ? 1 : 0; }
#pragma unroll
            for (int j = 0; j < 8; ++j) ORD[tl * 128 + rank[j]] = key[j];
            LDS_WAIT(); __builtin_amdgcn_wave_barrier();
        }
        const LAS unsigned* ORDt = ORD + tl * 128;
#ifndef DBG_NO_U
        {
            constexpr int NCH = 8 / NPU;
            const unsigned char* U8 = (const unsigned char*)Ub;
            const float rs = rsqrtf(ssq[t] * (1.f / D) + EPS) * (1.f / USCALE);
#pragma unroll 1
            for (int ps = 0; ps < NPU * REP_P5U; ++ps) {
                const int pp = ps % NPU; const int cofs = pp * (D / NPU) + l16 * 16;
                if (PASS_BAR) xcd_barrier(xbar);
                float xf[16 * NCH];
                { const bf16* xr = x1b + (size_t)t * D + cofs;
#pragma unroll
                  for (int j = 0; j < NCH; ++j)
#pragma unroll
                    for (int hh = 0; hh < 2; ++hh) { const v4u w = *(const v4u*)(xr + 256 * j + 8 * hh);
                        xf[16 * j + 8 * hh + 0] = bflo(w.x); xf[16 * j + 8 * hh + 1] = bfhi(w.x); xf[16 * j + 8 * hh + 2] = bflo(w.y); xf[16 * j + 8 * hh + 3] = bfhi(w.y);
                        xf[16 * j + 8 * hh + 4] = bflo(w.z); xf[16 * j + 8 * hh + 5] = bfhi(w.z); xf[16 * j + 8 * hh + 6] = bflo(w.w); xf[16 * j + 8 * hh + 7] = bfhi(w.w); } }
#pragma unroll 1
                for (int i = 0; i < 128; i += EPT) {
                    unsigned en[EPT]; v4u u[EPT][NCH];
#pragma unroll
                    for (int c = 0; c < EPT; ++c) { en[c] = ORDt[i + c]; const unsigned char* up = U8 + (size_t)(en[c] >> 7) * D + cofs;
#pragma unroll
                        for (int j = 0; j < NCH; ++j) u[c][j] = *(const v4u*)(up + 256 * j); }
#pragma unroll
                    for (int c = 0; c < EPT; ++c) {
                        float d0 = 0.f, d1 = 0.f, d2 = 0.f, d3 = 0.f;
#pragma unroll
                        for (int j = 0; j < NCH; ++j)
#pragma unroll
                            for (int d = 0; d < 4; ++d) { const f32x2 lo = __builtin_amdgcn_cvt_pk_f32_fp8((int)u[c][j][d], false), hi = __builtin_amdgcn_cvt_pk_f32_fp8((int)u[c][j][d], true);
                                d0 += xf[16 * j + 4 * d + 0] * lo.x; d1 += xf[16 * j + 4 * d + 1] * lo.y; d2 += xf[16 * j + 4 * d + 2] * hi.x; d3 += xf[16 * j + 4 * d + 3] * hi.y; }
                        const float dd = row_sum16((d0 + d1) + (d2 + d3));
                        if (l16 == 0) { const int k = (int)(en[c] & 127u); ACTt[k] = (pp == 0 ? 0.f : ACTt[k]) + rs * dd; } }
                }
                LDS_WAIT(); __builtin_amdgcn_wave_barrier();
            }
#pragma unroll
            for (int j = 0; j < 8; ++j) { const int ix = j * 16 + l16; const float hh = ACTt[ix];
                ACTt[ix] = 0.5f * hh * (1.f + erff(hh * 0.70710678118654752f)) * SG[tl * 128 + ix] * (1.f / VSCALE); }
            LDS_WAIT(); __builtin_amdgcn_wave_barrier();
        }
#endif
#ifndef DBG_NO_V
        {
            constexpr int NCH = 8 / NPV;
            const unsigned char* V8 = (const unsigned char*)Vb;
#pragma unroll 1
            for (int ps = 0; ps < NPV * REP_P5V; ++ps) {
                const int pp = ps % NPV; const int cofs = pp * (D / NPV) + l16 * 16;
                if (PASS_BAR) xcd_barrier(xbar);
                float acc[16 * NCH];
#pragma unroll
                for (int i = 0; i < 16 * NCH; ++i) acc[i] = 0.f;
#pragma unroll 1
                for (int i = 0; i < 128; i += EPT) {
                    unsigned en[EPT]; v4u v[EPT][NCH];
#pragma unroll
                    for (int c = 0; c < EPT; ++c) { en[c] = ORDt[i + c]; const unsigned char* vp = V8 + (size_t)(en[c] >> 7) * D + cofs;
#pragma unroll
                        for (int j = 0; j < NCH; ++j) v[c][j] = *(const v4u*)(vp + 256 * j); }
#pragma unroll
                    for (int c = 0; c < EPT; ++c) { const float a = ACTt[en[c] & 127u];
#pragma unroll
                        for (int j = 0; j < NCH; ++j)
#pragma unroll
                            for (int d = 0; d < 4; ++d) { const f32x2 lo = __builtin_amdgcn_cvt_pk_f32_fp8((int)v[c][j][d], false), hi = __builtin_amdgcn_cvt_pk_f32_fp8((int)v[c][j][d], true);
                                acc[16 * j + 4 * d + 0] += a * lo.x; acc[16 * j + 4 * d + 1] += a * lo.y; acc[16 * j + 4 * d + 2] += a * hi.x; acc[16 * j + 4 * d + 3] += a * hi.y; } }
                }
                if (ps < NPV) {
                    float* orow = A.out + (size_t)t * D + cofs;
#pragma unroll
                    for (int j = 0; j < NCH; ++j)
#pragma unroll
                        for (int d = 0; d < 4; ++d) { f32x4 o = *(f32x4*)(orow + 256 * j + 4 * d);
                            o.x += acc[16 * j + 4 * d + 0]; o.y += acc[16 * j + 4 * d + 1]; o.z += acc[16 * j + 4 * d + 2]; o.w += acc[16 * j + 4 * d + 3];
                            *(f32x4*)(orow + 256 * j + 4 * d) = o; }
                }
            }
        }
#endif
    }
    __syncthreads();
}


__global__ void __launch_bounds__(NTHR, 2) mega_fwd(Args args) {
    extern __shared__ __attribute__((aligned(16))) unsigned char lds_raw[];
    LAS unsigned char* lds = (LAS unsigned char*)lds_raw;
    const int tid = threadIdx.x, G = gridDim.x, bx = blockIdx.x;
    const int vcu = (G % 8 == 0) ? (bx % 8) * (G / 8) + bx / 8 : bx;
    unsigned char* ws = args.ws;
    const int lo = args.ph_lo, hi = args.ph_hi;
    volatile LAS unsigned* bst = (volatile LAS unsigned*)(lds + LDS_BYTES - 16);
    if (tid < 4) bst[tid] = 0u;
    __syncthreads();
    XcdBarrier xbar = xcd_barrier_post((unsigned*)(ws + WS_BAR), bst);
#if USE_XCD_BAR
#define SEAM_SYNC() xcd_barrier(xbar)
#else
#define SEAM_SYNC() cg::this_grid().sync()
#endif
#ifndef PH_MASK
#define PH_MASK 63
#endif
#define IN(k) (((PH_MASK >> (k)) & 1) && lo <= (k) && (k) < hi)
#define BOTH(k) (IN(k) && IN((k) + 1))
    if (IN(0)) { for (int rep = 0; rep < REP_P0; ++rep) { p0_prologue(args, lds, vcu, G, tid); __syncthreads(); } if (BOTH(0)) SEAM_SYNC(); }
    if (IN(1)) {
        pg8::Gemm g{(const bf16*)(ws + WS_XB), (const bf16*)(ws + WS_W1T), T, INC, D}; pg8::StaticOrder S; S.init(T, INC, G, bx);
        pg8::EpiScaleBf16<false> E{(bf16*)(ws + WS_PROJ), INC, (const float*)(ws + WS_RSTD1), args.b_in};
        for (int rep = 0; rep < REP_P1; ++rep) pg8::gemm_phase<pg8::EpiScaleBf16<false>, pg8::StaticOrder, PG8_ALIGN, PG8_SP2>(lds, g, S, E);
        if (BOTH(1)) SEAM_SYNC();
    }
    if (IN(2)) {
        for (int rep = 0; rep < REP_P2; ++rep) {
#ifndef NO_CONV
        for (int r2 = 0; r2 < REP_CONV; ++r2) for (int u = vcu; u < 256; u += G) conv_unit(args, lds, 32 * u, tid);
#endif
#ifndef NO_ATTN
        for (int r2 = 0; r2 < REP_ATTN; ++r2) for (int u = vcu; u < 256; u += G) attn_unit(args, lds, u >> 2, (u >> 1) & 1, u & 1, tid);
#endif
        }
        if (BOTH(2)) SEAM_SYNC();
    }
    if (IN(3)) {
        pg8::Gemm g{(const bf16*)(ws + WS_MIXED), (const bf16*)(ws + WS_W2T), T, D, D}; pg8::StaticOrder S; S.init(T, D, G, bx);
        pg8::EpiResid E{args.x, args.out, (bf16*)(ws + WS_X1B), (float*)(ws + WS_SSQ), D};
        pg8::gemm_phase<pg8::EpiResid, pg8::StaticOrder, PG8_ALIGN, PG8_SP2>(lds, g, S, E);
        if (BOTH(3)) SEAM_SYNC();
    }
    if (IN(4)) {
        pg8::Gemm g{(const bf16*)(ws + WS_X1B), (const bf16*)(ws + WS_W3T), T, D, D}; pg8::StaticOrder S; S.init(T, D, G, bx);
        pg8::EpiScaleBf16<true> E{(bf16*)(ws + WS_QP), D, (const float*)(ws + WS_SSQ), nullptr};
        for (int rep = 0; rep < REP_P4; ++rep) pg8::gemm_phase<pg8::EpiScaleBf16<true>, pg8::StaticOrder, PG8_ALIGN, PG8_SP2>(lds, g, S, E);
        if (BOTH(4)) SEAM_SYNC();
    }
    if (IN(5)) {
        for (int u = vcu; u < T / 32; u += G) peer_tile(args, lds, 32 * u, tid, xbar);
    }
#undef IN
#undef BOTH
}

__global__ void k_rope_naive(const int* __restrict__ pos, float* __restrict__ rope) {
    const int i = blockIdx.x * blockDim.x + threadIdx.x; if (i >= T * 8) return;
    const int t = i >> 3, f = i & 7; const float ang = (float)pos[t] * powf(500000.f, -(float)(2 * f) / 16.f); float sn, cs; sincosf(ang, &sn, &cs);
    rope[t * 16 + f] = cs; rope[t * 16 + 8 + f] = sn;
}

#ifndef MK_MODE
#define MK_MODE 1
#endif
#ifndef NAIVE_MASK
#define NAIVE_MASK 0
#endif
extern "C" void kernel_launch(void* const* d_in, const int* in_sizes, int n_in, void* d_out, int out_size, void* d_ws, size_t ws_size, hipStream_t stream) {
    static int grid = 0;
    if (grid == 0) {
        if (n_in != 18 || in_sizes[0] != T * D || out_size != T * D || ws_size < WS_END) {
            fprintf(stderr, "kernel_launch: unexpected shapes: n_in %d in0 %d out %d ws %zu (need %zu)\n", n_in, n_in > 0 ? in_sizes[0] : -1, out_size, ws_size, (size_t)WS_END); grid = -1; return; }
        int dev = 0, cus = 0, per_cu = 0;
        if (hipGetDevice(&dev) != hipSuccess || hipDeviceGetAttribute(&cus, hipDeviceAttributeMultiprocessorCount, dev) != hipSuccess) { fprintf(stderr, "kernel_launch: device query failed\n"); grid = -1; return; }
        if (hipFuncSetAttribute((const void*)mega_fwd, hipFuncAttributeMaxDynamicSharedMemorySize, LDS_BYTES) != hipSuccess) { fprintf(stderr, "kernel_launch: hipFuncSetAttribute failed\n"); grid = -1; return; }
        if (hipOccupancyMaxActiveBlocksPerMultiprocessor(&per_cu, (const void*)mega_fwd, NTHR, LDS_BYTES) != hipSuccess || per_cu < 1) {
            fprintf(stderr, "kernel_launch: occupancy query says %d blocks per CU\n", per_cu); (void)hipGetLastError(); per_cu = 1; }
        grid = cus * 1;
        (void)per_cu;
    }
    if (grid < 0) return;
    unsigned char* ws = (unsigned char*)d_ws;
    hipMemsetAsync(ws + WS_CTL, 0, CTL_ZERO_BYTES, stream);
    Args a{};
    a.x = (const float*)d_in[0]; a.pos = (const int*)d_in[1]; a.g1 = (const float*)d_in[2]; a.w_in = (const float*)d_in[3]; a.b_in = (const float*)d_in[4];
    a.cw = (const float*)d_in[5]; a.cb = (const float*)d_in[6]; a.lg = (const float*)d_in[7]; a.lb = (const float*)d_in[8]; a.qg = (const float*)d_in[9];
    a.kg = (const float*)d_in[10]; a.sinks = (const float*)d_in[11]; a.w_out = (const float*)d_in[12]; a.g2 = (const float*)d_in[13]; a.wq = (const float*)d_in[14];
    a.skeys = (const float*)d_in[15]; a.pu = (const float*)d_in[16]; a.pv = (const float*)d_in[17];
    a.out = (float*)d_out; a.ws = ws;
#if MK_MODE == 1
    a.ph_lo = 0; a.ph_hi = 6;
    void* kargs[] = {&a};
    hipError_t e = hipLaunchCooperativeKernel((const void*)mega_fwd, dim3(grid), dim3(NTHR), kargs, LDS_BYTES, stream);
    if (e != hipSuccess) fprintf(stderr, "kernel_launch: cooperative launch failed: %s (grid %d)\n", hipGetErrorString(e), grid);
#else
    float* ssq = (float*)(ws + WS_SSQ); float* rstd1 = (float*)(ws + WS_RSTD1); float* rope = (float*)(ws + WS_ROPE);
    bf16 *skb = (bf16*)(ws + WS_SKB), *w1t = (bf16*)(ws + WS_W1T), *w2t = (bf16*)(ws + WS_W2T), *w3t = (bf16*)(ws + WS_W3T);
    bf16 *xb = (bf16*)(ws + WS_XB), *proj = (bf16*)(ws + WS_PROJ), *mixed = (bf16*)(ws + WS_MIXED), *x1b = (bf16*)(ws + WS_X1B), *qp = (bf16*)(ws + WS_QP);
    bf16 *ub = (bf16*)(ws + WS_UB), *vb = (bf16*)(ws + WS_VB);
    for (int ph = 0; ph < 6; ++ph) {
        if (!((NAIVE_MASK >> ph) & 1)) { a.ph_lo = ph; a.ph_hi = ph + 1; hipLaunchKernelGGL(mega_fwd, dim3(grid), dim3(NTHR), LDS_BYTES, stream, a); continue; }
        switch (ph) {
        case 0:
            k_prep_x<<<1024, 256, 0, stream>>>(a.x, xb, rstd1);
            k_transpose_w<<<dim3(INC / 32, D / 32), 256, 0, stream>>>(a.w_in, a.g1, w1t, D, INC);
            k_transpose_w<<<dim3(D / 32, D / 32), 256, 0, stream>>>(a.w_out, nullptr, w2t, D, D);
            k_transpose_w<<<dim3(D / 32, D / 32), 256, 0, stream>>>(a.wq, a.g2, w3t, D, D);
            k_convert<<<256, 256, 0, stream>>>(a.skeys, nullptr, skb, (size_t)16 * 128 * 128 / 8, 128);
            k_convert<<<2048, 256, 0, stream>>>(a.pu, a.g2, ub, (size_t)NEXP * D / 8, D);
            k_convert<<<2048, 256, 0, stream>>>(a.pv, nullptr, vb, (size_t)NEXP * D / 8, D);
            k_rope_naive<<<T * 8 / 256, 256, 0, stream>>>(a.pos, rope);
            break;
        case 1: k_gemm_naive<EpiProj><<<dim3(INC / 64, T / 64), 256, 0, stream>>>(xb, w1t, T, INC, D, EpiProj{proj, rstd1, a.b_in}); break;
        case 2: k_conv_naive<<<T, 256, 0, stream>>>(proj, a.cw, a.cb, a.lg, a.lb, mixed);
                k_attn_naive<<<T * NQH / 4, 256, 0, stream>>>(proj, a.pos, a.qg, a.kg, a.sinks, mixed); break;
        case 3: k_gemm_naive<EpiX1><<<dim3(D / 64, T / 64), 256, 0, stream>>>(mixed, w2t, T, D, D, EpiX1{a.x, a.out, x1b});
                k_ssq<<<1024, 256, 0, stream>>>(a.out, ssq); break;
        case 4: k_gemm_naive<EpiQp><<<dim3(D / 64, T / 64), 256, 0, stream>>>(x1b, w3t, T, D, D, EpiQp{qp, ssq}); break;
        case 5: k_peer_naive<<<T / 4, 256, 0, stream>>>(qp, skb, x1b, ssq, ub, vb, a.out); break;
        }
    }
#endif
}
```

```cpp
#include <hip/hip_runtime.h>
#include <hip/hip_cooperative_groups.h>
namespace cg = cooperative_groups;
#include <cstdio>
#include <cstdint>

typedef unsigned short bf16;
typedef unsigned v4u __attribute__((ext_vector_type(4)));
typedef unsigned v2u __attribute__((ext_vector_type(2)));
typedef float f32x4 __attribute__((ext_vector_type(4)));

constexpr int T = 8192, D = 2048, CONVC = 1024, HD = 64, NQH = 16, NKVH = 2, ATT = 1024, KVC = 128;
constexpr int INC = 2 * CONVC + ATT + 2 * KVC;
constexpr int QOFF = 2 * CONVC, KOFF = QOFF + ATT, VOFF = KOFF + KVC;
constexpr int CK = 31, WIN = 128;
constexpr int NKEYS = 128, NEXP = NKEYS * NKEYS, PH = 8, PTOPK = 16;
constexpr float EPS = 1e-6f;

constexpr size_t MiB = 1u << 20;
constexpr size_t WS_CTL = 0, CTL_ZERO_BYTES = 1 * MiB;
constexpr size_t WS_BAR = 16 * 1024;
constexpr size_t WS_SSQ = 64 * 1024;
constexpr size_t WS_RSTD1 = 1 * MiB;
constexpr size_t WS_ROPE = 3 * MiB;
constexpr size_t WS_SKB = 2 * MiB;
constexpr size_t WS_W1T = 4 * MiB;
constexpr size_t WS_W2T = 20 * MiB;
constexpr size_t WS_W3T = 28 * MiB;
constexpr size_t WS_XB = 64 * MiB;
constexpr size_t WS_PROJ = 96 * MiB;
constexpr size_t WS_MIXED = 160 * MiB;
constexpr size_t WS_X1B = 192 * MiB;
constexpr size_t WS_QP = 224 * MiB;
constexpr size_t WS_UB = 256 * MiB;
constexpr size_t WS_VB = 320 * MiB;
constexpr size_t WS_END = 384 * MiB;

__device__ __forceinline__ unsigned f2bf(float f) { unsigned u = __float_as_uint(f); return (u + 0x7fffu + ((u >> 16) & 1u)) >> 16; }
__device__ __forceinline__ unsigned pk2(float lo, float hi) { return f2bf(lo) | (f2bf(hi) << 16); }
__device__ __forceinline__ float bf2f(unsigned b) { return __uint_as_float(b << 16); }
__device__ __forceinline__ float bflo(unsigned w) { return __uint_as_float(w << 16); }
__device__ __forceinline__ float bfhi(unsigned w) { return __uint_as_float(w & 0xffff0000u); }
__device__ __forceinline__ float wave_sum(float v) {
#pragma unroll
    for (int o = 1; o < 64; o <<= 1) v += __shfl_xor(v, o);
    return v;
}
__device__ __forceinline__ float wave_max(float v) {
#pragma unroll
    for (int o = 1; o < 64; o <<= 1) v = fmaxf(v, __shfl_xor(v, o));
    return v;
}
__device__ __forceinline__ int wave_min_i(int v) {
#pragma unroll
    for (int o = 1; o < 64; o <<= 1) { int t = __shfl_xor(v, o); v = t < v ? t : v; }
    return v;
}

__global__ void k_prep_x(const float* __restrict__ x, bf16* __restrict__ xb, float* __restrict__ rstd1) {
    const int lane = threadIdx.x & 63, gw = (blockIdx.x * blockDim.x + threadIdx.x) >> 6, ngw = (gridDim.x * blockDim.x) >> 6;
    for (int row = gw; row < T; row += ngw) {
        const f32x4* xr = (const f32x4*)(x + (size_t)row * D) + lane;
        f32x4 v[8]; float ss = 0.f;
#pragma unroll
        for (int j = 0; j < 8; ++j) { v[j] = xr[64 * j]; ss += v[j].x * v[j].x + v[j].y * v[j].y + v[j].z * v[j].z + v[j].w * v[j].w; }
        ss = wave_sum(ss);
        if (lane == 0) rstd1[row] = rsqrtf(ss * (1.f / D) + EPS);
        v2u* o = (v2u*)(xb + (size_t)row * D) + lane;
#pragma unroll
        for (int j = 0; j < 8; ++j) { v2u w; w.x = pk2(v[j].x, v[j].y); w.y = pk2(v[j].z, v[j].w); o[64 * j] = w; }
    }
}
__global__ void k_transpose_w(const float* __restrict__ W, const float* __restrict__ g, bf16* __restrict__ Wt, int K, int N) {
    __shared__ float tile[32][33];
    const int k0 = blockIdx.y * 32, n0 = blockIdx.x * 32, tx = threadIdx.x & 31, ty = threadIdx.x >> 5;
    for (int i = ty; i < 32; i += 8) { const float gv = g ? g[k0 + i] : 1.f; tile[i][tx] = W[(size_t)(k0 + i) * N + n0 + tx] * gv; }
    __syncthreads();
    for (int i = ty; i < 32; i += 8) Wt[(size_t)(n0 + i) * K + k0 + tx] = (bf16)f2bf(tile[tx][i]);
}
__global__ void k_convert(const float* __restrict__ src, const float* __restrict__ g, bf16* __restrict__ dst, size_t n8, int ncol) {
    for (size_t i = (size_t)blockIdx.x * blockDim.x + threadIdx.x; i < n8; i += (size_t)gridDim.x * blockDim.x) {
        f32x4 a = ((const f32x4*)src)[2 * i], b = ((const f32x4*)src)[2 * i + 1];
        if (g) { const int c = (int)((i * 8) % ncol); const f32x4 ga = *(const f32x4*)(g + c), gb = *(const f32x4*)(g + c + 4); a = a * ga; b = b * gb; }
        v4u w; w.x = pk2(a.x, a.y); w.y = pk2(a.z, a.w); w.z = pk2(b.x, b.y); w.w = pk2(b.z, b.w);
        ((v4u*)dst)[i] = w;
    }
}

struct EpiProj { bf16* proj; const float* rstd1; const float* bias;
    __device__ void operator()(int r, int c, float v) const { proj[(size_t)r * INC + c] = (bf16)f2bf(rstd1[r] * v + bias[c]); } };
struct EpiX1 { const float* x; float* out; bf16* x1b;
    __device__ void operator()(int r, int c, float v) const { const float x1 = x[(size_t)r * D + c] + v; out[(size_t)r * D + c] = x1; x1b[(size_t)r * D + c] = (bf16)f2bf(x1); } };
struct EpiQp { bf16* qp; const float* ssq;
    __device__ void operator()(int r, int c, float v) const { qp[(size_t)r * D + c] = (bf16)f2bf(rsqrtf(ssq[r] * (1.f / D) + EPS) * v); } };
template <class Epi>
__global__ void __launch_bounds__(256) k_gemm_naive(const bf16* __restrict__ A, const bf16* __restrict__ Bt, int M, int N, int K, Epi E) {
    __shared__ float As[32][65], Bs[32][65];
    const int tx = threadIdx.x & 15, ty = threadIdx.x >> 4, m0 = blockIdx.y * 64, n0 = blockIdx.x * 64;
    float acc[4][4] = {};
    for (int k0 = 0; k0 < K; k0 += 32) {
        for (int i = threadIdx.x; i < 64 * 32; i += 256) { const int r = i >> 5, k = i & 31;
            As[k][r] = bf2f(A[(size_t)(m0 + r) * K + k0 + k]); Bs[k][r] = bf2f(Bt[(size_t)(n0 + r) * K + k0 + k]); }
        __syncthreads();
#pragma unroll 8
        for (int k = 0; k < 32; ++k) {
            float a[4], b[4];
#pragma unroll
            for (int i = 0; i < 4; ++i) { a[i] = As[k][ty * 4 + i]; b[i] = Bs[k][tx * 4 + i]; }
#pragma unroll
            for (int i = 0; i < 4; ++i)
#pragma unroll
                for (int j = 0; j < 4; ++j) acc[i][j] += a[i] * b[j];
        }
        __syncthreads();
    }
#pragma unroll
    for (int i = 0; i < 4; ++i)
#pragma unroll
        for (int j = 0; j < 4; ++j) E(m0 + ty * 4 + i, n0 + tx * 4 + j, acc[i][j]);
}

__global__ void __launch_bounds__(256) k_conv_naive(const bf16* __restrict__ proj, const float* __restrict__ cw, const float* __restrict__ cb,
                                                     const float* __restrict__ lg, const float* __restrict__ lb, bf16* __restrict__ mixed) {
    __shared__ float red[2][4];
    const int t = blockIdx.x, c0 = threadIdx.x * 4, lane = threadIdx.x & 63, wv = threadIdx.x >> 6;
    float acc[4];
#pragma unroll
    for (int i = 0; i < 4; ++i) acc[i] = cb[c0 + i];
    for (int j = 0; j < CK; ++j) {
        const int tt = t + j - (CK - 1);
        if (tt < 0) continue;
        const v2u a = *(const v2u*)(proj + (size_t)tt * INC + c0), gt = *(const v2u*)(proj + (size_t)tt * INC + CONVC + c0);
        const float av[4] = {bflo(a.x), bfhi(a.x), bflo(a.y), bfhi(a.y)}, gv[4] = {bflo(gt.x), bfhi(gt.x), bflo(gt.y), bfhi(gt.y)};
#pragma unroll
        for (int i = 0; i < 4; ++i) { const float h = av[i] / (1.f + __expf(-gv[i])); acc[i] += h * cw[j * CONVC + c0 + i]; }
    }
    float s = acc[0] + acc[1] + acc[2] + acc[3];
    s = wave_sum(s); if (lane == 0) red[0][wv] = s; __syncthreads();
    const float mu = (red[0][0] + red[0][1] + red[0][2] + red[0][3]) * (1.f / CONVC);
    float q = 0.f;
#pragma unroll
    for (int i = 0; i < 4; ++i) { const float d = acc[i] - mu; q += d * d; }
    q = wave_sum(q); if (lane == 0) red[1][wv] = q; __syncthreads();
    const float rstd = rsqrtf((red[1][0] + red[1][1] + red[1][2] + red[1][3]) * (1.f / CONVC) + EPS);
    float o[4];
#pragma unroll
    for (int i = 0; i < 4; ++i) { const float y = (acc[i] - mu) * rstd * lg[c0 + i] + lb[c0 + i]; o[i] = y / (1.f + __expf(-y)); }
    v2u w; w.x = pk2(o[0], o[1]); w.y = pk2(o[2], o[3]);
    *(v2u*)(mixed + (size_t)t * D + c0) = w;
}

__global__ void __launch_bounds__(256) k_attn_naive(const bf16* __restrict__ proj, const int* __restrict__ pos, const float* __restrict__ qg, const float* __restrict__ kg,
                                                     const float* __restrict__ sinks, bf16* __restrict__ mixed) {
    __shared__ float qs[4][64];
    const int lane = threadIdx.x & 63, wv = threadIdx.x >> 6, gw = blockIdx.x * 4 + wv;
    const int t = gw >> 4, hq = gw & 15, kvh = hq >> 3;
    {
        float q = bf2f(proj[(size_t)t * INC + QOFF + hq * HD + lane]);
        const float ss = wave_sum(q * q);
        q = q * rsqrtf(ss * (1.f / HD) + EPS) * qg[lane];
        const float pv = __shfl(q, lane < 8 ? lane + 8 : (lane < 16 ? lane - 8 : lane));
        if (lane < 16) { const int i = lane & 7; const float ang = (float)pos[t] * powf(500000.f, -(float)(2 * i) / 16.f); float sn, cs; sincosf(ang, &sn, &cs);
            q = lane < 8 ? q * cs - pv * sn : q * cs + pv * sn; }
        qs[wv][lane] = q;
    }
    __syncthreads();
    float sc[2];
#pragma unroll
    for (int h = 0; h < 2; ++h) {
        const int kp = t - lane - 64 * h;
        float s = -1e30f;
        if (kp >= 0) {
            const bf16* kr = proj + (size_t)kp * INC + KOFF + kvh * HD;
            float kv[64]; float ss = 0.f;
#pragma unroll
            for (int d = 0; d < 64; ++d) { kv[d] = bf2f(kr[d]); ss += kv[d] * kv[d]; }
            const float r = rsqrtf(ss * (1.f / HD) + EPS);
#pragma unroll
            for (int d = 0; d < 64; ++d) kv[d] = kv[d] * r * kg[d];
            const float p = (float)pos[kp];
#pragma unroll
            for (int i = 0; i < 8; ++i) { const float ang = p * powf(500000.f, -(float)(2 * i) / 16.f); float sn, cs; sincosf(ang, &sn, &cs);
                const float r1 = kv[i], r2 = kv[i + 8]; kv[i] = r1 * cs - r2 * sn; kv[i + 8] = r2 * cs + r1 * sn; }
            float dot = 0.f;
#pragma unroll
            for (int d = 0; d < 64; ++d) dot += kv[d] * qs[wv][d];
            s = dot * 0.125f;
        }
        sc[h] = s;
    }
    const float sink = sinks[hq];
    const float m = fmaxf(wave_max(fmaxf(sc[0], sc[1])), sink);
    const float p0 = (t - lane >= 0) ? __expf(sc[0] - m) : 0.f, p1 = (t - lane - 64 >= 0) ? __expf(sc[1] - m) : 0.f;
    const float denom = wave_sum(p0 + p1) + __expf(sink - m);
    float acc = 0.f;
    for (int j = 0; j < WIN; ++j) {
        const float pj = __shfl(j < 64 ? p0 : p1, j & 63);
        const int kp = t - j;
        if (kp >= 0) acc += pj * bf2f(proj[(size_t)kp * INC + VOFF + kvh * HD + lane]);
    }
    mixed[(size_t)t * D + CONVC + hq * HD + lane] = (bf16)f2bf(acc / denom);
}

__global__ void k_ssq(const float* __restrict__ x1, float* __restrict__ ssq) {
    const int lane = threadIdx.x & 63, gw = (blockIdx.x * blockDim.x + threadIdx.x) >> 6, ngw = (gridDim.x * blockDim.x) >> 6;
    for (int row = gw; row < T; row += ngw) {
        const f32x4* xr = (const f32x4*)(x1 + (size_t)row * D) + lane; float ss = 0.f;
#pragma unroll
        for (int j = 0; j < 8; ++j) { const f32x4 v = xr[64 * j]; ss += v.x * v.x + v.y * v.y + v.z * v.z + v.w * v.w; }
        ss = wave_sum(ss); if (lane == 0) ssq[row] = ss;
    }
}

__global__ void __launch_bounds__(256) k_peer_naive(const bf16* __restrict__ qp, const bf16* __restrict__ skb, const bf16* __restrict__ x1b, const float* __restrict__ ssq,
                                                     const bf16* __restrict__ Ub, const bf16* __restrict__ Vb, float* __restrict__ out) {
    __shared__ float q_s[4][256];
    __shared__ float tkv[4][2][16];
    __shared__ int tki[4][2][16];
    __shared__ int sel_e[4][128];
    __shared__ float sel_g[4][128];
    __shared__ float act[4][128];
    const int lane = threadIdx.x & 63, wv = threadIdx.x >> 6, t = blockIdx.x * 4 + wv;
    const float rstd2 = rsqrtf(ssq[t] * (1.f / D) + EPS);
    for (int h = 0; h < PH; ++h) {
        for (int i = lane; i < 256; i += 64) q_s[wv][i] = bf2f(qp[(size_t)t * D + h * 256 + i]);
        __builtin_amdgcn_s_waitcnt(0); __builtin_amdgcn_wave_barrier();
        for (int p = 0; p < 2; ++p) {
            float v0 = 0.f, v1 = 0.f;
            const bf16* k0 = skb + ((size_t)(h * 2 + p) * NKEYS + lane) * 128, * k1 = k0 + 64 * 128;
            for (int c8 = 0; c8 < 16; ++c8) {
                const v4u a = ((const v4u*)k0)[c8], b = ((const v4u*)k1)[c8]; const float* qv = &q_s[wv][p * 128 + c8 * 8];
                v0 += qv[0] * bflo(a.x) + qv[1] * bfhi(a.x) + qv[2] * bflo(a.y) + qv[3] * bfhi(a.y) + qv[4] * bflo(a.z) + qv[5] * bfhi(a.z) + qv[6] * bflo(a.w) + qv[7] * bfhi(a.w);
                v1 += qv[0] * bflo(b.x) + qv[1] * bfhi(b.x) + qv[2] * bflo(b.y) + qv[3] * bfhi(b.y) + qv[4] * bflo(b.z) + qv[5] * bfhi(b.z) + qv[6] * bflo(b.w) + qv[7] * bfhi(b.w);
            }
            float tv = 0.f; int ti = 0;
            for (int r = 0; r < PTOPK; ++r) {
                const float M = wave_max(fmaxf(v0, v1));
                const int cn = (v0 == M) ? lane : ((v1 == M) ? lane + 64 : 9999);
                const int nm = wave_min_i(cn);
                if (lane == r) { tv = M; ti = nm; }
                if (nm == lane) v0 = -3.0e38f;
                if (nm == lane + 64) v1 = -3.0e38f;
            }
            if (lane < 16) { tkv[wv][p][lane] = tv; tki[wv][p][lane] = ti; }
        }
        __builtin_amdgcn_s_waitcnt(0); __builtin_amdgcn_wave_barrier();
        float cs[4];
#pragma unroll
        for (int i = 0; i < 4; ++i) cs[i] = tkv[wv][0][lane >> 2] + tkv[wv][1][(lane & 3) * 4 + i];
        float sv = 0.f; int sf = 0;
        for (int r = 0; r < PTOPK; ++r) {
            const float M = wave_max(fmaxf(fmaxf(cs[0], cs[1]), fmaxf(cs[2], cs[3])));
            int cn = 9999;
#pragma unroll
            for (int i = 3; i >= 0; --i) if (cs[i] == M) cn = (lane >> 2) * 16 + (lane & 3) * 4 + i;
            const int nm = wave_min_i(cn);
            if (lane == r) { sv = M; sf = nm; }
#pragma unroll
            for (int i = 0; i < 4; ++i) if (nm == (lane >> 2) * 16 + (lane & 3) * 4 + i) cs[i] = -3.0e38f;
        }
        const float smax = __shfl(sv, 0);
        const float ge = lane < 16 ? __expf(sv - smax) : 0.f;
        const float gs = wave_sum(ge);
        if (lane < 16) { sel_e[wv][h * 16 + lane] = tki[wv][0][sf >> 4] * NKEYS + tki[wv][1][sf & 15]; sel_g[wv][h * 16 + lane] = ge / gs; }
        __builtin_amdgcn_s_waitcnt(0); __builtin_amdgcn_wave_barrier();
    }
    {
        const v4u* xr = (const v4u*)(x1b + (size_t)t * D) + lane;
        float xv[32];
#pragma unroll
        for (int j = 0; j < 4; ++j) { const v4u w = xr[64 * j]; xv[8 * j + 0] = bflo(w.x); xv[8 * j + 1] = bfhi(w.x); xv[8 * j + 2] = bflo(w.y); xv[8 * j + 3] = bfhi(w.y);
            xv[8 * j + 4] = bflo(w.z); xv[8 * j + 5] = bfhi(w.z); xv[8 * j + 6] = bflo(w.w); xv[8 * j + 7] = bfhi(w.w); }
        for (int k = 0; k < 128; ++k) {
            const v4u* ur = (const v4u*)(Ub + (size_t)sel_e[wv][k] * D) + lane; float dot = 0.f;
#pragma unroll
            for (int j = 0; j < 4; ++j) { const v4u w = ur[64 * j];
                dot += xv[8 * j + 0] * bflo(w.x) + xv[8 * j + 1] * bfhi(w.x) + xv[8 * j + 2] * bflo(w.y) + xv[8 * j + 3] * bfhi(w.y)
                     + xv[8 * j + 4] * bflo(w.z) + xv[8 * j + 5] * bfhi(w.z) + xv[8 * j + 6] * bflo(w.w) + xv[8 * j + 7] * bfhi(w.w); }
            dot = wave_sum(dot);
            const float hh = rstd2 * dot;
            if (lane == 0) act[wv][k] = 0.5f * hh * (1.f + erff(hh * 0.70710678118654752f)) * sel_g[wv][k];
        }
    }
    __builtin_amdgcn_s_waitcnt(0); __builtin_amdgcn_wave_barrier();
    {
        float acc[32];
#pragma unroll
        for (int i = 0; i < 32; ++i) acc[i] = 0.f;
        for (int k = 0; k < 128; ++k) {
            const v4u* vr = (const v4u*)(Vb + (size_t)sel_e[wv][k] * D) + lane; const float a = act[wv][k];
#pragma unroll
            for (int j = 0; j < 4; ++j) { const v4u w = vr[64 * j];
                acc[8 * j + 0] += a * bflo(w.x); acc[8 * j + 1] += a * bfhi(w.x); acc[8 * j + 2] += a * bflo(w.y); acc[8 * j + 3] += a * bfhi(w.y);
                acc[8 * j + 4] += a * bflo(w.z); acc[8 * j + 5] += a * bfhi(w.z); acc[8 * j + 6] += a * bflo(w.w); acc[8 * j + 7] += a * bfhi(w.w); }
        }
        f32x4* orow = (f32x4*)(out + (size_t)t * D);
#pragma unroll
        for (int j = 0; j < 4; ++j) {
            f32x4 a = orow[128 * j + 2 * lane], b = orow[128 * j + 2 * lane + 1];
            a.x += acc[8 * j + 0]; a.y += acc[8 * j + 1]; a.z += acc[8 * j + 2]; a.w += acc[8 * j + 3];
            b.x += acc[8 * j + 4]; b.y += acc[8 * j + 5]; b.z += acc[8 * j + 6]; b.w += acc[8 * j + 7];
            orow[128 * j + 2 * lane] = a; orow[128 * j + 2 * lane + 1] = b;
        }
    }
}


namespace pg8 {
#define PG8_LAS __attribute__((address_space(3)))
typedef unsigned short bf16_t;
typedef short bf16x8 __attribute__((ext_vector_type(8)));
typedef float f32x4 __attribute__((ext_vector_type(4)));
typedef unsigned u32x4 __attribute__((ext_vector_type(4)));
constexpr int BM = 256, BK = 64, HALF = 128, HTB = HALF * BK * 2  , STAGE_BYTES = 8 * HTB, NXCD = 8, WGM = 8;

__host__ __device__ __forceinline__ int lds_byte(int r, int c) { const int st = (r >> 4) * 2 + (c >> 5), rr = r & 15, cc = c & 31, ob = rr * 64 + cc * 2; return st * 1024 + (ob ^ (((ob >> 9) & 1) << 5)); }
__host__ __device__ __forceinline__ void stage_rc(int b, int& R, int& C) { const int st = b / 1024, sb = b % 1024, swz = sb ^ (((sb >> 9) & 1) << 5); R = (st >> 1) * 16 + swz / 64; C = (st & 1) * 32 + (swz % 64) / 2; }
__host__ __device__ __forceinline__ int perm32(int rho) { const int n = rho >> 4, i = rho & 15; return 8 * (i >> 2) + 4 * n + (i & 3); }

struct Unit { int pm, pn; };
struct Gemm { const bf16_t* A; const bf16_t* Bt; int M, N, K; };

struct StaticOrder {
    int nM, nN, nwg, G, c;
    __host__ __device__ void init(int M, int N, int G_, int c_) { nM = M / BM; nN = N / BM; nwg = nM * nN; G = G_; c = c_; }
    __host__ __device__ bool next(int i, Unit& u) const {
        const long L = (long)i * G + c; if (L >= nwg) return false;
        int wgid = (int)L; { const int q = nwg / NXCD, r = nwg % NXCD, xcd = wgid % NXCD, off = wgid / NXCD; wgid = (xcd < r ? xcd * (q + 1) : r * (q + 1) + (xcd - r) * q) + off; }
        const int nig = WGM * nN, gid = wgid / nig, fm = gid * WGM, gsz = (nM - fm) < WGM ? (nM - fm) : WGM;
        u.pm = fm + ((wgid % nig) % gsz); u.pn = (wgid % nig) / gsz; return true;
    }
    __device__ __forceinline__ void a_ready(const Unit&) const {}
    __device__ __forceinline__ void done(const Unit&) const {}
};
#ifndef EPI_WT
#define EPI_WT 0
#endif

__device__ __forceinline__ unsigned cvt_pk_bf16(float lo, float hi) { unsigned r; asm volatile("v_cvt_pk_bf16_f32 %0, %1, %2" : "=v"(r) : "v"(lo), "v"(hi)); return r; }

__device__ __forceinline__ void st16_wt(void* p, const u32x4 v) {
#if EPI_WT
    asm volatile("global_store_dwordx4 %0, %1, off sc1\n\ts_nop 1" :: "v"(p), "v"(v) : "memory");
#else
    *(u32x4*)p = v;
#endif
}
template <bool RSQ> struct EpiScaleBf16 {
    static constexpr bool PERM = true, AFTER_DRAIN = false;
    bf16_t* O; int ldc; const float* sv; const float* bias;
    __device__ __forceinline__ void operator()(const f32x4 (&acc)[2][2][4][2], const Unit& u, int wr, int wc, int fr, int fq) const {
        const int row0 = u.pm * BM + wr * 64 + fr, col0 = u.pn * BM + wc * 32 + 8 * fq;
        f32x4 bv[2][2];
#pragma unroll
        for (int bj = 0; bj < 2; ++bj)
#pragma unroll
            for (int n = 0; n < 2; ++n) bv[bj][n] = bias ? *(const f32x4*)(bias + col0 + bj * HALF + 4 * n) : (f32x4){0.f, 0.f, 0.f, 0.f};
#pragma unroll
        for (int ai = 0; ai < 2; ++ai)
#pragma unroll
            for (int m = 0; m < 4; ++m) { const int r = row0 + ai * HALF + m * 16; float s = sv[r]; if (RSQ) s = rsqrtf(s * (1.0f / 2048.0f) + 1e-6f);
                bf16_t* rowp = O + (size_t)r * ldc + col0;
#pragma unroll
                for (int bj = 0; bj < 2; ++bj) { const f32x4 v0 = acc[ai][bj][m][0] * s + bv[bj][0], v1 = acc[ai][bj][m][1] * s + bv[bj][1];
                    u32x4 w; w.x = cvt_pk_bf16(v0[0], v0[1]); w.y = cvt_pk_bf16(v0[2], v0[3]); w.z = cvt_pk_bf16(v1[0], v1[1]); w.w = cvt_pk_bf16(v1[2], v1[3]);
                    st16_wt(rowp + bj * HALF, w); } }
    }
};
struct EpiResid {
    static constexpr bool PERM = true, AFTER_DRAIN = false;
    const bf16_t* XB; float* out; bf16_t* x1b; float* ssq; int ldc;
    __device__ __forceinline__ void operator()(const f32x4 (&acc)[2][2][4][2], const Unit& u, int wr, int wc, int fr, int fq) const {
        const int row0 = u.pm * BM + wr * 64 + fr, col0 = u.pn * BM + wc * 32 + 8 * fq;
#pragma unroll
        for (int ai = 0; ai < 2; ++ai)
#pragma unroll
            for (int m = 0; m < 4; ++m) { const int r = row0 + ai * HALF + m * 16; const size_t off = (size_t)r * ldc + col0; float q = 0.f;
#pragma unroll
                for (int bj = 0; bj < 2; ++bj) {
                    const u32x4 xw = *(const u32x4*)(XB + off + bj * HALF);
                    const f32x4 v0 = (f32x4){__uint_as_float(xw.x << 16), __uint_as_float(xw.x & 0xffff0000u), __uint_as_float(xw.y << 16), __uint_as_float(xw.y & 0xffff0000u)} + acc[ai][bj][m][0],
                                v1 = (f32x4){__uint_as_float(xw.z << 16), __uint_as_float(xw.z & 0xffff0000u), __uint_as_float(xw.w << 16), __uint_as_float(xw.w & 0xffff0000u)} + acc[ai][bj][m][1];
                    if (out) { *(f32x4*)(out + off + bj * HALF) = v0; *(f32x4*)(out + off + bj * HALF + 4) = v1; }
                    u32x4 w; w.x = cvt_pk_bf16(v0[0], v0[1]); w.y = cvt_pk_bf16(v0[2], v0[3]); w.z = cvt_pk_bf16(v1[0], v1[1]); w.w = cvt_pk_bf16(v1[2], v1[3]);
                    st16_wt(x1b + off + bj * HALF, w);
                    q += (v0[0] * v0[0] + v0[1] * v0[1]) + (v0[2] * v0[2] + v0[3] * v0[3]) + (v1[0] * v1[0] + v1[1] * v1[1]) + (v1[2] * v1[2] + v1[3] * v1[3]); }
                q += __shfl_xor(q, 16); q += __shfl_xor(q, 32);
                if (fq == 0) atomicAdd(ssq + r, q);
                asm volatile("" ::: "memory"); }
    }
};

struct EpiProjGlu {
    static constexpr bool PERM = true, AFTER_DRAIN = false;
    bf16_t* hg; bf16_t* qkv; const float* rstd; const float* bias;
    __device__ __forceinline__ void operator()(const f32x4 (&acc)[2][2][4][2], const Unit& u, int wr, int wc, int fr, int fq) const {
        const int row0 = u.pm * BM + wr * 64 + fr, cl = wc * 32 + 8 * fq;
        if (u.pn < 8) {
            f32x4 ba[2], bg[2];
#pragma unroll
            for (int n = 0; n < 2; ++n) { ba[n] = *(const f32x4*)(bias + 128 * u.pn + cl + 4 * n); bg[n] = *(const f32x4*)(bias + 1024 + 128 * u.pn + cl + 4 * n); }
#pragma unroll
            for (int ai = 0; ai < 2; ++ai)
#pragma unroll
                for (int m = 0; m < 4; ++m) { const int r = row0 + ai * HALF + m * 16; const float s = rstd[r]; float h[8];
#pragma unroll
                    for (int n = 0; n < 2; ++n) { const f32x4 a = acc[ai][0][m][n] * s + ba[n], g = acc[ai][1][m][n] * s + bg[n];
#pragma unroll
                        for (int j = 0; j < 4; ++j) h[4 * n + j] = a[j] / (1.0f + __expf(-g[j])); }
                    u32x4 w; w.x = cvt_pk_bf16(h[0], h[1]); w.y = cvt_pk_bf16(h[2], h[3]); w.z = cvt_pk_bf16(h[4], h[5]); w.w = cvt_pk_bf16(h[6], h[7]);
                    *(u32x4*)(hg + (size_t)r * 1024 + 128 * u.pn + cl) = w; }
        } else {
            const int c0 = 256 * (u.pn - 8) + cl;
            f32x4 bv[2][2];
#pragma unroll
            for (int bj = 0; bj < 2; ++bj)
#pragma unroll
                for (int n = 0; n < 2; ++n) bv[bj][n] = *(const f32x4*)(bias + 2048 + c0 + bj * HALF + 4 * n);
#pragma unroll
            for (int ai = 0; ai < 2; ++ai)
#pragma unroll
                for (int m = 0; m < 4; ++m) { const int r = row0 + ai * HALF + m * 16; const float s = rstd[r]; bf16_t* rowp = qkv + (size_t)r * 1280 + c0;
#pragma unroll
                    for (int bj = 0; bj < 2; ++bj) { const f32x4 v0 = acc[ai][bj][m][0] * s + bv[bj][0], v1 = acc[ai][bj][m][1] * s + bv[bj][1];
                        u32x4 w; w.x = cvt_pk_bf16(v0[0], v0[1]); w.y = cvt_pk_bf16(v0[2], v0[3]); w.z = cvt_pk_bf16(v1[0], v1[1]); w.w = cvt_pk_bf16(v1[2], v1[3]);
                        *(u32x4*)(rowp + bj * HALF) = w; } }
        }
    }
};
template <class Epi, class Sched, bool ALIGN_EPI = false, bool SP2 = false>
__device__ __forceinline__ void gemm_phase(PG8_LAS unsigned char* lds, const Gemm g, const Sched& S, const Epi& E) {
    const int tid = threadIdx.x, wid = __builtin_amdgcn_readfirstlane(tid >> 6), lane = tid & 63, wr = wid >> 2, wc = wid & 3, fr = lane & 15, fq = lane >> 4;
    const int K = g.K, nt = K / BK;
    unsigned voffA[2], voffB[2];
#pragma unroll
    for (int i = 0; i < 2; ++i) { int R, C; stage_rc(tid * 16 + i * 8192, R, C); const int Rb = Epi::PERM ? ((R & ~31) + perm32(R & 31)) : R;
        voffA[i] = (unsigned)(R * K + C) * 2u; voffB[i] = (unsigned)(Rb * K + C) * 2u; }
    const size_t kstep = (size_t)(BK * 2);
    const size_t hstep = (size_t)HALF * K * 2;
    const size_t tstep = 2 * hstep;
    const unsigned ldsw = (unsigned)wid * 1024u;
    const int aoff = lds_byte(wr * 64 + fr, fq * 8), boff = lds_byte(wc * 32 + fr, fq * 8);
#define PG8_SA(b, h) (((b) * 2 + (h)) * HTB)
#define PG8_SB(b, h) ((4 + (b) * 2 + (h)) * HTB)
#define PG8_STAGE(bufoff, gbase, voff) do { _Pragma("unroll") for (int _i = 0; _i < 2; ++_i) \
        __builtin_amdgcn_global_load_lds((const unsigned*)((const char*)(gbase) + (voff)[_i]), (PG8_LAS unsigned*)(lds + (bufoff) + ldsw + _i * 8192), 16, 0, 0); } while (0)
#define PG8_LDA(dst, b, h) do { _Pragma("unroll") for (int m = 0; m < 4; ++m) _Pragma("unroll") for (int k = 0; k < 2; ++k) dst[m][k] = *(const PG8_LAS bf16x8*)(lds + PG8_SA(b, h) + aoff + m * 2048 + k * 1024); } while (0)
#define PG8_LDB(dst, b, h) do { _Pragma("unroll") for (int n = 0; n < 2; ++n) _Pragma("unroll") for (int k = 0; k < 2; ++k) dst[n][k] = *(const PG8_LAS bf16x8*)(lds + PG8_SB(b, h) + boff + n * 2048 + k * 1024); } while (0)
#define PG8_MMA(ai, bj, At, Bt) do { __builtin_amdgcn_s_setprio(1); _Pragma("unroll") for (int m = 0; m < 4; ++m) _Pragma("unroll") for (int n = 0; n < 2; ++n) _Pragma("unroll") for (int k = 0; k < 2; ++k) \
        acc[ai][bj][m][n] = __builtin_amdgcn_mfma_f32_16x16x32_bf16(Bt[n][k], At[m][k], acc[ai][bj][m][n], 0, 0, 0); __builtin_amdgcn_s_setprio(0); } while (0)
#define PG8_WAIT_V(n) asm volatile("s_waitcnt vmcnt(" #n ")" ::: "memory")
#define PG8_WAIT_L(n) asm volatile("s_waitcnt lgkmcnt(" #n ")" ::: "memory")
#define PG8_BAR __builtin_amdgcn_s_barrier()
#define PG8_SCHED __builtin_amdgcn_sched_barrier(0)
    Unit cur, nxt; int ui = 0;
    if (!S.next(0, cur)) return;
    f32x4 acc[2][2][4][2];
#pragma unroll
    for (int a = 0; a < 2; ++a)
#pragma unroll
        for (int b = 0; b < 2; ++b)
#pragma unroll
            for (int m = 0; m < 4; ++m)
#pragma unroll
                for (int n = 0; n < 2; ++n) acc[a][b][m][n] = (f32x4){0.f, 0.f, 0.f, 0.f};
    bf16x8 At[4][2], B0[2][2], B1[2][2];
    const char* cA = (const char*)g.A + (size_t)cur.pm * tstep; const char* cB = (const char*)g.Bt + (size_t)cur.pn * tstep;
    S.a_ready(cur);
    if constexpr (SP2) {
        PG8_STAGE(PG8_SB(0, 0), cB, voffB); PG8_STAGE(PG8_SB(0, 1), cB + hstep, voffB); PG8_STAGE(PG8_SA(0, 0), cA, voffA); PG8_STAGE(PG8_SA(0, 1), cA + hstep, voffA);
        if (wr == 1) PG8_BAR;
        PG8_WAIT_V(2); PG8_BAR;
        PG8_STAGE(PG8_SB(1, 0), cB + kstep, voffB); PG8_STAGE(PG8_SA(1, 0), cA + kstep, voffA); PG8_STAGE(PG8_SB(1, 1), cB + hstep + kstep, voffB);
        PG8_WAIT_V(6); PG8_BAR;
    } else {
        PG8_STAGE(PG8_SB(0, 0), cB, voffB); PG8_STAGE(PG8_SA(0, 0), cA, voffA); PG8_STAGE(PG8_SB(0, 1), cB + hstep, voffB); PG8_STAGE(PG8_SA(0, 1), cA + hstep, voffA);
        if (wr == 1) PG8_BAR;
        PG8_WAIT_V(4); PG8_BAR;
        PG8_STAGE(PG8_SB(1, 0), cB + kstep, voffB); PG8_STAGE(PG8_SA(1, 0), cA + kstep, voffA); PG8_STAGE(PG8_SB(1, 1), cB + hstep + kstep, voffB);
        PG8_WAIT_V(6); PG8_BAR;
    }
    for (;;) {
        const bool has_next = S.next(ui + 1, nxt);
        const char* nA = has_next ? (const char*)g.A + (size_t)nxt.pm * tstep : cA; const char* nB = has_next ? (const char*)g.Bt + (size_t)nxt.pn * tstep : cB;
        for (int t = 0; t < nt; t += 2) {
            const bool last = (t == nt - 2);
            const char* a1 = cA + (size_t)(t + 1) * kstep;
            const char* a2 = last ? nA : cA + (size_t)(t + 2) * kstep; const char* b2 = last ? nB : cB + (size_t)(t + 2) * kstep;
            const char* a3 = a2 + kstep; const char* b3 = b2 + kstep;
            if (last && has_next) S.a_ready(nxt);
            if constexpr (SP2) {
            PG8_LDB(B0, 0, 0); PG8_LDB(B1, 0, 1); PG8_SCHED; PG8_LDA(At, 0, 0); PG8_STAGE(PG8_SA(1, 1), a1 + hstep, voffA);
            PG8_WAIT_V(8); PG8_WAIT_L(0); PG8_BAR; PG8_MMA(0, 0, At, B0); PG8_MMA(0, 1, At, B1); PG8_BAR; PG8_SCHED;
            PG8_LDA(At, 0, 1); PG8_STAGE(PG8_SB(0, 0), b2, voffB); PG8_STAGE(PG8_SB(0, 1), b2 + hstep, voffB); PG8_STAGE(PG8_SA(0, 0), a2, voffA);
            PG8_WAIT_V(8); PG8_WAIT_L(0); PG8_BAR; PG8_MMA(1, 0, At, B0); PG8_MMA(1, 1, At, B1); PG8_BAR; PG8_SCHED;
            PG8_LDB(B0, 1, 0); PG8_LDB(B1, 1, 1); PG8_SCHED; PG8_LDA(At, 1, 0); PG8_STAGE(PG8_SA(0, 1), a2 + hstep, voffA);
            PG8_WAIT_V(8); PG8_WAIT_L(0); PG8_BAR; PG8_MMA(0, 0, At, B0); PG8_MMA(0, 1, At, B1); PG8_BAR; PG8_SCHED;
            PG8_LDA(At, 1, 1); PG8_STAGE(PG8_SB(1, 0), b3, voffB); PG8_STAGE(PG8_SB(1, 1), b3 + hstep, voffB); PG8_STAGE(PG8_SA(1, 0), a3, voffA);
            PG8_WAIT_V(8); PG8_WAIT_L(0); PG8_BAR; PG8_MMA(1, 0, At, B0); PG8_MMA(1, 1, At, B1); PG8_BAR; PG8_SCHED;
            } else {
            PG8_LDB(B0, 0, 0); PG8_SCHED; PG8_LDA(At, 0, 0); PG8_STAGE(PG8_SA(1, 1), a1 + hstep, voffA);
            PG8_WAIT_L(8); PG8_BAR; PG8_WAIT_L(0); PG8_MMA(0, 0, At, B0); PG8_BAR; PG8_SCHED;
            PG8_LDB(B1, 0, 1); PG8_STAGE(PG8_SB(0, 0), b2, voffB);
            PG8_BAR; PG8_WAIT_L(0); PG8_MMA(0, 1, At, B1); PG8_BAR;
            PG8_LDA(At, 0, 1); PG8_STAGE(PG8_SA(0, 0), a2, voffA);
            PG8_BAR; PG8_WAIT_L(0); PG8_MMA(1, 0, At, B0); PG8_BAR; PG8_SCHED;
            PG8_STAGE(PG8_SB(0, 1), b2 + hstep, voffB);
            PG8_WAIT_V(6); PG8_BAR; PG8_MMA(1, 1, At, B1); PG8_BAR;
            PG8_LDB(B0, 1, 0); PG8_SCHED; PG8_LDA(At, 1, 0); PG8_STAGE(PG8_SA(0, 1), a2 + hstep, voffA);
            PG8_WAIT_L(8); PG8_BAR; PG8_WAIT_L(0); PG8_MMA(0, 0, At, B0); PG8_BAR; PG8_SCHED;
            PG8_LDB(B1, 1, 1); PG8_STAGE(PG8_SB(1, 0), b3, voffB);
            PG8_BAR; PG8_WAIT_L(0); PG8_MMA(0, 1, At, B1); PG8_BAR;
            PG8_LDA(At, 1, 1); PG8_STAGE(PG8_SA(1, 0), a3, voffA);
            PG8_BAR; PG8_WAIT_L(0); PG8_MMA(1, 0, At, B0); PG8_BAR; PG8_SCHED;
            PG8_STAGE(PG8_SB(1, 1), b3 + hstep, voffB);
            PG8_WAIT_V(6); PG8_BAR; PG8_MMA(1, 1, At, B1); PG8_BAR;
            }
        }
        if constexpr (ALIGN_EPI) { if (wr == 0) PG8_BAR; }
        if constexpr (!Epi::AFTER_DRAIN) { E(acc, cur, wr, wc, fr, fq); S.done(cur); }
        if (!has_next) break;
#pragma unroll
        for (int a = 0; a < 2; ++a)
#pragma unroll
            for (int b = 0; b < 2; ++b)
#pragma unroll
                for (int m = 0; m < 4; ++m)
#pragma unroll
                    for (int n = 0; n < 2; ++n) acc[a][b][m][n] = (f32x4){0.f, 0.f, 0.f, 0.f};
        cur = nxt; cA = nA; cB = nB; ++ui;
        if constexpr (ALIGN_EPI) { if (wr == 1) PG8_BAR; }
    }
    PG8_WAIT_V(0);
    if constexpr (!ALIGN_EPI) { if (wr == 0) PG8_BAR; }
    PG8_BAR;
    if constexpr (Epi::AFTER_DRAIN) { E.fused(acc, cur, wr, wc, fr, fq, lds, wid, lane); S.done(cur); }
#undef PG8_SA
#undef PG8_SB
#undef PG8_STAGE
#undef PG8_LDA
#undef PG8_LDB
#undef PG8_MMA
#undef PG8_WAIT_V
#undef PG8_WAIT_L
#undef PG8_BAR
#undef PG8_SCHED
}
}

#ifndef REP_P0
#define REP_P0 1
#endif
#ifndef REP_P1
#define REP_P1 1
#endif
#ifndef REP_P2
#define REP_P2 1
#endif
#ifndef REP_CONV
#define REP_CONV 1
#endif
#ifndef REP_ATTN
#define REP_ATTN 1
#endif
#ifndef REP_P4
#define REP_P4 1
#endif
#ifndef REP_P5A
#define REP_P5A 1
#endif
#ifndef REP_P5U
#define REP_P5U 1
#endif
#ifndef REP_P5V
#define REP_P5V 1
#endif
#ifndef PG8_SP2
#define PG8_SP2 true
#endif
#ifndef PG8_ALIGN
#define PG8_ALIGN true
#endif

#ifndef RESID_BF16
#define RESID_BF16 1
#endif
#ifndef TAB_R0
#define TAB_R0 10240
#endif
constexpr float VSCALE = 128.f;
constexpr float USCALE = 2048.f;
constexpr int NWAVES = 8, NTHR = 512;
constexpr int LDS_BYTES = 160 * 1024;
#define LAS __attribute__((address_space(3)))
typedef short bf16x8 __attribute__((ext_vector_type(8)));
typedef float f32x16 __attribute__((ext_vector_type(16)));
typedef float f32x2 __attribute__((ext_vector_type(2)));
#define LDS_WAIT() asm volatile("s_waitcnt lgkmcnt(0)" ::: "memory")

struct Args {
    const float* x; const int* pos; const float* g1; const float* w_in; const float* b_in; const float* cw; const float* cb; const float* lg; const float* lb;
    const float* qg; const float* kg; const float* sinks; const float* w_out; const float* g2; const float* wq; const float* skeys; const float* pu; const float* pv;
    float* out; unsigned char* ws; int ph_lo, ph_hi;
};

__device__ __forceinline__ int w1_row(int n) { return n < 1024 ? 256 * (n >> 7) + (n & 127) : n < 2048 ? 256 * ((n - 1024) >> 7) + 128 + (n & 127) : n; }
template <bool GLU_PERM = false>
__device__ __forceinline__ void p0_transpose_item(const float* W, const float* g, int K, int N, bf16* WT, LAS float* scr, int item, int lane) {
    const int nblk = N / 32, kb = item / nblk, nb = item % nblk, k0 = 64 * kb, n0 = 32 * nb;
    f32x4 wv[8];
#pragma unroll
    for (int i = 0; i < 8; ++i) wv[i] = __builtin_nontemporal_load((const f32x4*)(W + (size_t)(k0 + 8 * i + (lane >> 3)) * N + n0 + 4 * (lane & 7)));
#pragma unroll
    for (int i = 0; i < 8; ++i) { const int kk = 8 * i + (lane >> 3); const float gv = g ? g[k0 + kk] : 1.f; LAS float* s = scr + kk * 33 + 4 * (lane & 7);
        s[0] = wv[i].x * gv; s[1] = wv[i].y * gv; s[2] = wv[i].z * gv; s[3] = wv[i].w * gv; }
    LDS_WAIT(); asm volatile("" ::: "memory");
    const int c = lane & 7;
#pragma unroll
    for (int j = 0; j < 4; ++j) { const int n = (lane >> 3) + 8 * j; const LAS float* s = scr + (8 * c) * 33 + n;
        v4u o; o.x = pk2(s[0 * 33], s[1 * 33]); o.y = pk2(s[2 * 33], s[3 * 33]); o.z = pk2(s[4 * 33], s[5 * 33]); o.w = pk2(s[6 * 33], s[7 * 33]);
        *(v4u*)(WT + (size_t)(GLU_PERM ? w1_row(n0 + n) : n0 + n) * K + k0 + 8 * c) = o; }
    LDS_WAIT(); asm volatile("" ::: "memory");
}
__device__ __forceinline__ void p0_convert(const float* src, const float* g, bf16* dst, size_t n8, int ncol, size_t gtid, size_t nthr) {
    for (size_t i = gtid; i < n8; i += nthr) {
        f32x4 a = ((const f32x4*)src)[2 * i], b = ((const f32x4*)src)[2 * i + 1];
        if (g) { const int c = (int)((i * 8) % ncol); const f32x4 ga = *(const f32x4*)(g + c), gb = *(const f32x4*)(g + c + 4); a = a * ga; b = b * gb; }
        v4u w; w.x = pk2(a.x, a.y); w.y = pk2(a.z, a.w); w.z = pk2(b.x, b.y); w.w = pk2(b.z, b.w);
        ((v4u*)dst)[i] = w;
    }
}
__device__ __forceinline__ void p0_convert_fp8g(const float* src, const float* g, unsigned char* dst, size_t n16, float scale, size_t gtid, size_t nthr) {
    for (size_t i0 = gtid; i0 < n16; i0 += 4 * nthr) {
        f32x4 a[4][4];
#pragma unroll
        for (int u = 0; u < 4; ++u) { const size_t i = i0 + u * nthr; if (i < n16) {
#pragma unroll
            for (int q = 0; q < 4; ++q) a[u][q] = ((const f32x4*)src)[4 * i + q]; } }
#pragma unroll
        for (int u = 0; u < 4; ++u) { const size_t i = i0 + u * nthr; if (i < n16) {
            v4u w; const int c0 = (int)((i * 16) % D);
#pragma unroll
            for (int q = 0; q < 4; ++q) { f32x4 v = a[u][q] * scale; if (g) v = v * *(const f32x4*)(g + c0 + 4 * q);
                int d = __builtin_amdgcn_cvt_pk_fp8_f32(v.x, v.y, 0, false); d = __builtin_amdgcn_cvt_pk_fp8_f32(v.z, v.w, d, true); w[q] = (unsigned)d; }
            ((v4u*)dst)[i] = w; } }
    }
}
__device__ __forceinline__ void p0_convert_fp8(const float* src, unsigned char* dst, size_t n16, float scale, size_t gtid, size_t nthr) { p0_convert_fp8g(src, nullptr, dst, n16, scale, gtid, nthr); }
constexpr size_t WS_Q0 = 32 * 1024, WS_Q1 = 40 * 1024;
__device__ __forceinline__ int q_pull(unsigned* q, int lane) {
    unsigned v = 0u; if (lane == 0) v = __hip_atomic_fetch_add(q, 1u, __ATOMIC_RELAXED, __HIP_MEMORY_SCOPE_AGENT);
    return __builtin_amdgcn_readfirstlane((int)v);
}
__device__ __forceinline__ void p0_table_rows2(const float* src, const float* g, unsigned char* dst, int row, float scale, int lane) {
    const size_t ib = (size_t)row * (D / 16);
    f32x4 a[4][4];
#pragma unroll
    for (int u = 0; u < 4; ++u)
#pragma unroll
        for (int q = 0; q < 4; ++q) a[u][q] = __builtin_nontemporal_load((const f32x4*)src + 4 * (ib + u * 64 + lane) + q);
#pragma unroll
    for (int u = 0; u < 4; ++u) { const size_t i = ib + u * 64 + lane; const int c0 = (int)((i * 16) % D); v4u w;
#pragma unroll
        for (int q = 0; q < 4; ++q) { f32x4 v = a[u][q] * scale; if (g) v = v * *(const f32x4*)(g + c0 + 4 * q);
            int d = __builtin_amdgcn_cvt_pk_fp8_f32(v.x, v.y, 0, false); d = __builtin_amdgcn_cvt_pk_fp8_f32(v.z, v.w, d, true); w[q] = (unsigned)d; }
        ((v4u*)dst)[(i & 127) / 32 * (size_t)(NEXP * 32) + (i >> 7) * 32 + (i & 31)] = w; }
}
constexpr int C_X = T / 2, C_W1 = (D / 64) * (INC / 32) / 4, C_W2 = (D / 64) * (D / 32) / 4, C_ROPE = T * 8 / 1024, C_SK = 16 * 128 * 128 / 8 / 512, C_TAB = TAB_R0 / 2;
constexpr int B_W1 = C_X, B_W2 = B_W1 + C_W1, B_W3 = B_W2 + C_W2, B_ROPE = B_W3 + C_W2, B_SK = B_ROPE + C_ROPE, B_TU = B_SK + C_SK, B_TV = B_TU + C_TAB, N_P0 = B_TV + C_TAB;
__device__ __forceinline__ void p0_chunk(const Args& A, LAS float* scr, int c, int lane) {
    unsigned char* ws = A.ws;
    if (c < B_W1) {
        bf16* xb = (bf16*)(ws + WS_XB); float* rstd1 = (float*)(ws + WS_RSTD1);
        const int row = 2 * c, row2 = row + 1;
        const f32x4* xr = (const f32x4*)(A.x + (size_t)row * D) + lane; const f32x4* xr2 = (const f32x4*)(A.x + (size_t)row2 * D) + lane;
        f32x4 v[8], w[8]; float ss = 0.f, ss2 = 0.f;
#pragma unroll
        for (int j = 0; j < 8; ++j) { v[j] = __builtin_nontemporal_load(xr + 64 * j); w[j] = __builtin_nontemporal_load(xr2 + 64 * j); }
#pragma unroll
        for (int j = 0; j < 8; ++j) { ss += v[j].x * v[j].x + v[j].y * v[j].y + v[j].z * v[j].z + v[j].w * v[j].w; ss2 += w[j].x * w[j].x + w[j].y * w[j].y + w[j].z * w[j].z + w[j].w * w[j].w; }
        ss = wave_sum(ss); ss2 = wave_sum(ss2);
        if (lane == 0) { rstd1[row] = rsqrtf(ss * (1.f / D) + EPS); rstd1[row2] = rsqrtf(ss2 * (1.f / D) + EPS); }
        v2u* o = (v2u*)(xb + (size_t)row * D) + lane; v2u* o2 = (v2u*)(xb + (size_t)row2 * D) + lane;
#pragma unroll
        for (int j = 0; j < 8; ++j) { v2u q; q.x = pk2(v[j].x, v[j].y); q.y = pk2(v[j].z, v[j].w); o[64 * j] = q; v2u r; r.x = pk2(w[j].x, w[j].y); r.y = pk2(w[j].z, w[j].w); o2[64 * j] = r; }
    } else if (c < B_W2) {
        for (int i = 0; i < 4; ++i) p0_transpose_item<true>(A.w_in, A.g1, D, INC, (bf16*)(ws + WS_W1T), scr, 4 * (c - B_W1) + i, lane);
    } else if (c < B_W3) {
        for (int i = 0; i < 4; ++i) p0_transpose_item(A.w_out, nullptr, D, D, (bf16*)(ws + WS_W2T), scr, 4 * (c - B_W2) + i, lane);
    } else if (c < B_ROPE) {
        for (int i = 0; i < 4; ++i) p0_transpose_item(A.wq, A.g2, D, D, (bf16*)(ws + WS_W3T), scr, 4 * (c - B_W3) + i, lane);
    } else if (c < B_SK) {
        float* rope = (float*)(ws + WS_ROPE);
        for (int j = 0; j < 16; ++j) { const int i = (c - B_ROPE) * 1024 + j * 64 + lane, t = i >> 3, f = i & 7;
            const float ang = (float)A.pos[t] * powf(500000.f, -(float)(2 * f) / 16.f); float sn, cs; sincosf(ang, &sn, &cs);
            rope[t * 16 + f] = cs; rope[t * 16 + 8 + f] = sn; }
    } else if (c < B_TU) {
        p0_convert(A.skeys, nullptr, (bf16*)(ws + WS_SKB), (size_t)(c - B_SK + 1) * 512, 128, (size_t)(c - B_SK) * 512 + lane, 64);
    } else if (c < B_TV) {
        p0_table_rows2(A.pu, A.g2, ws + WS_UB, 2 * (c - B_TU), USCALE, lane);
    } else {
        p0_table_rows2(A.pv, nullptr, ws + WS_VB, 2 * (c - B_TV), VSCALE, lane);
    }
}
__device__ __forceinline__ void p0_prologue(const Args& A, LAS unsigned char* lds, int bx, int tid) {
    const int lane = tid & 63, wave = tid >> 6, shard = bx & 7;
    LAS float* scr = (LAS float*)(lds + wave * 16384);
    unsigned* q = (unsigned*)(A.ws + WS_Q0) + 64 * shard;
    int nxt = q_pull(q, lane);
    for (;;) { const int c = 8 * nxt + shard; if (c >= N_P0) break; nxt = q_pull(q, lane); p0_chunk(A, scr, c, lane); }
}
constexpr int N_P1 = NEXP - TAB_R0;
__device__ __forceinline__ void p1_table_queue(const Args& A, int bx, int tid) {
    const int lane = tid & 63, shard = bx & 7;
    unsigned* q = (unsigned*)(A.ws + WS_Q1) + 64 * shard;
    int nxt = q_pull(q, lane);
    for (;;) { const int c = 8 * nxt + shard; if (c >= N_P1) break; nxt = q_pull(q, lane);
        if (c < N_P1 / 2) p0_table_rows2(A.pu, A.g2, A.ws + WS_UB, TAB_R0 + 2 * c, USCALE, lane);
        else p0_table_rows2(A.pv, nullptr, A.ws + WS_VB, TAB_R0 + 2 * (c - N_P1 / 2), VSCALE, lane); }
}

__device__ __forceinline__ void conv_unit(const Args& A, LAS unsigned char* lds, int t0, int tid) {
    const bf16* proj = (const bf16*)(A.ws + WS_PROJ); bf16* mixed = (bf16*)(A.ws + WS_MIXED);
    const int lane = tid & 63, wave = tid >> 6;
    LAS bf16* H = (LAS bf16*)lds;
#pragma unroll 1
    for (int b = 0; b < 2; ++b) {
        v4u hv[8];
#pragma unroll
        for (int q = 0; q < 8; ++q) { const int it = tid + NTHR * (8 * b + q); const int row = it >> 7, ch = (it & 127) * 8, tt = t0 - 30 + row;
            hv[q] = (v4u){0u, 0u, 0u, 0u};
            if (it < 62 * 128 && tt >= 0) hv[q] = *(const v4u*)(proj + (size_t)tt * 1024 + ch); }
#pragma unroll
        for (int q = 0; q < 8; ++q) { const int it = tid + NTHR * (8 * b + q); const int row = it >> 7, ch = (it & 127) * 8;
            if (it < 62 * 128) *(LAS v4u*)(H + row * 1024 + ch) = hv[q]; }
    }
    __syncthreads();
    LAS float* Cf = (LAS float*)(lds + 62 * 1024 * 2);
    float w0[CK], w1[CK];
#pragma unroll
    for (int j = 0; j < CK; ++j) { const f32x2 wv = *(const f32x2*)(A.cw + j * CONVC + 2 * tid); w0[j] = wv.x; w1[j] = wv.y; }
    const f32x2 bv = *(const f32x2*)(A.cb + 2 * tid);
    f32x4 lgv[4], lbv[4];
#pragma unroll
    for (int j = 0; j < 4; ++j) { lgv[j] = *(const f32x4*)(A.lg + 4 * lane + 256 * j); lbv[j] = *(const f32x4*)(A.lb + 4 * lane + 256 * j); }
#pragma unroll 1
    for (int c = 0; c < 4; ++c) {
        float a0[8], a1[8];
#pragma unroll
        for (int tt = 0; tt < 8; ++tt) { a0[tt] = bv.x; a1[tt] = bv.y; }
        const LAS bf16* Hc = H + (8 * c) * 1024 + 2 * tid;
#pragma unroll
        for (int i = 0; i < 38; ++i) {
            const unsigned hw = *(const LAS unsigned*)(Hc + i * 1024); const float h0 = bflo(hw), h1 = bfhi(hw);
#pragma unroll
            for (int tt = 0; tt < 8; ++tt) { const int j = i - tt; if (j >= 0 && j < CK) { a0[tt] += h0 * w0[j]; a1[tt] += h1 * w1[j]; } }
        }
#pragma unroll
        for (int tt = 0; tt < 8; ++tt) *(LAS f32x2*)(Cf + tt * 1024 + 2 * tid) = (f32x2){a0[tt], a1[tt]};
        __syncthreads();
        {
            const int tt = wave;
            f32x4 v[4]; float s = 0.f;
#pragma unroll
            for (int j = 0; j < 4; ++j) { v[j] = *(const LAS f32x4*)(Cf + tt * 1024 + 4 * lane + 256 * j); s += (v[j].x + v[j].y) + (v[j].z + v[j].w); }
            const float mu = wave_sum(s) * (1.f / CONVC); float s2 = 0.f;
#pragma unroll
            for (int j = 0; j < 4; ++j) { v[j] = v[j] - mu; s2 += (v[j].x * v[j].x + v[j].y * v[j].y) + (v[j].z * v[j].z + v[j].w * v[j].w); }
            const float rstd = rsqrtf(wave_sum(s2) * (1.f / CONVC) + EPS);
#pragma unroll
            for (int j = 0; j < 4; ++j) {
                const int ch = 4 * lane + 256 * j; const f32x4 gg = lgv[j], bb = lbv[j];
                f32x4 y = v[j] * rstd * gg + bb;
                y.x = y.x / (1.f + __expf(-y.x)); y.y = y.y / (1.f + __expf(-y.y)); y.z = y.z / (1.f + __expf(-y.z)); y.w = y.w / (1.f + __expf(-y.w));
                v2u w; w.x = pk2(y.x, y.y); w.y = pk2(y.z, y.w);
                *(v2u*)(mixed + (size_t)(t0 + 8 * c + tt) * D + ch) = w;
            }
        }
        __syncthreads();
    }
}

__device__ __forceinline__ void attn_unit(const Args& A, LAS unsigned char* lds, int qb, int kvh, int gh, int tid) {
    const bf16* proj = (const bf16*)(A.ws + WS_PROJ) + (size_t)T * 1024; bf16* mixed = (bf16*)(A.ws + WS_MIXED); const float* rope = (const float*)(A.ws + WS_ROPE);
    constexpr int KST = 72, VST = 260, QP = 1280, QO = 0, KO = 1024, VO = 1152;
    LAS bf16* Kn = (LAS bf16*)lds;
    LAS bf16* Vt = (LAS bf16*)(lds + 256 * KST * 2);
    const int lane = tid & 63, wave = tid >> 6;
    const int kbase = (qb - 1) * 128;
    v4u qraw[2][4];
#pragma unroll
    for (int si = 0; si < 2; ++si)
#pragma unroll
        for (int ks = 0; ks < 4; ++ks)
            qraw[si][ks] = *(const v4u*)(proj + (size_t)(qb * 128 + 32 * ((wave & 1) * 2 + si) + (lane & 31)) * QP + QO + (kvh * 8 + gh * 4 + (wave >> 1)) * HD + 16 * ks + 8 * (lane >> 5));
    {
        const int key = tid >> 1, half = tid & 1, kp = kbase + key;
        float v[32]; unsigned vw[16];
        if (kp >= 0) {
            const v4u* kr = (const v4u*)(proj + (size_t)kp * QP + KO + kvh * HD + 32 * half);
            const v4u* vr = (const v4u*)(proj + (size_t)kp * QP + VO + kvh * HD + 32 * half);
#pragma unroll
            for (int j = 0; j < 4; ++j) { const v4u w = kr[j]; v[8 * j + 0] = bflo(w.x); v[8 * j + 1] = bfhi(w.x); v[8 * j + 2] = bflo(w.y); v[8 * j + 3] = bfhi(w.y);
                v[8 * j + 4] = bflo(w.z); v[8 * j + 5] = bfhi(w.z); v[8 * j + 6] = bflo(w.w); v[8 * j + 7] = bfhi(w.w);
                const v4u u = vr[j]; vw[4 * j + 0] = u.x; vw[4 * j + 1] = u.y; vw[4 * j + 2] = u.z; vw[4 * j + 3] = u.w; }
        } else {
#pragma unroll
            for (int i = 0; i < 32; ++i) v[i] = 0.f;
#pragma unroll
            for (int i = 0; i < 16; ++i) vw[i] = 0u;
        }
        float ss = 0.f;
#pragma unroll
        for (int i = 0; i < 32; ++i) ss += v[i] * v[i];
        ss += __shfl_xor(ss, 1);
        const float r = rsqrtf(ss * (1.f / HD) + EPS);
#pragma unroll
        for (int i = 0; i < 32; ++i) v[i] = v[i] * r * A.kg[32 * half + i];
        if (half == 0 && kp >= 0) {
#pragma unroll
            for (int i = 0; i < 8; ++i) { const float cs = rope[kp * 16 + i], sn = rope[kp * 16 + 8 + i]; const float r1 = v[i], r2 = v[i + 8]; v[i] = r1 * cs - r2 * sn; v[i + 8] = r2 * cs + r1 * sn; }
        }
#pragma unroll
        for (int j = 0; j < 4; ++j) { v4u w; w.x = pk2(v[8 * j + 0], v[8 * j + 1]); w.y = pk2(v[8 * j + 2], v[8 * j + 3]); w.z = pk2(v[8 * j + 4], v[8 * j + 5]); w.w = pk2(v[8 * j + 6], v[8 * j + 7]);
            *(LAS v4u*)(Kn + key * KST + 32 * half + 8 * j) = w; }
#pragma unroll
        for (int i = 0; i < 16; ++i) { Vt[(32 * half + 2 * i) * VST + key] = (bf16)(vw[i] & 0xffffu); Vt[(32 * half + 2 * i + 1) * VST + key] = (bf16)(vw[i] >> 16); }
    }
    __syncthreads();
    const int hq = kvh * 8 + gh * 4 + (wave >> 1);
    const float sink = A.sinks[hq];
    const int h = lane >> 5, lq = lane & 31;
#pragma unroll 1
    for (int si = 0; si < 2; ++si) {
        const int s = (wave & 1) * 2 + si;
        const int qtok = qb * 128 + 32 * s + lq;
        bf16x8 qf[4];
        {
            float qv[4][8]; float ss = 0.f;
#pragma unroll
            for (int ks = 0; ks < 4; ++ks) { const v4u w = si == 0 ? qraw[0][ks] : qraw[1][ks];
                qv[ks][0] = bflo(w.x); qv[ks][1] = bfhi(w.x); qv[ks][2] = bflo(w.y); qv[ks][3] = bfhi(w.y); qv[ks][4] = bflo(w.z); qv[ks][5] = bfhi(w.z); qv[ks][6] = bflo(w.w); qv[ks][7] = bfhi(w.w);
#pragma unroll
                for (int j = 0; j < 8; ++j) ss += qv[ks][j] * qv[ks][j]; }
            ss += __shfl_xor(ss, 32);
            const float r = rsqrtf(ss * (1.f / HD) + EPS) * 0.125f;
#pragma unroll
            for (int ks = 0; ks < 4; ++ks)
#pragma unroll
                for (int j = 0; j < 8; ++j) qv[ks][j] = qv[ks][j] * r * A.qg[16 * ks + 8 * h + j];
#pragma unroll
            for (int j = 0; j < 8; ++j) { const float pv = __shfl_xor(qv[0][j], 32); const float cs = rope[qtok * 16 + j], sn = rope[qtok * 16 + 8 + j];
                qv[0][j] = h == 0 ? qv[0][j] * cs - pv * sn : qv[0][j] * cs + pv * sn; }
#pragma unroll
            for (int ks = 0; ks < 4; ++ks) { v4u w; w.x = pk2(qv[ks][0], qv[ks][1]); w.y = pk2(qv[ks][2], qv[ks][3]); w.z = pk2(qv[ks][4], qv[ks][5]); w.w = pk2(qv[ks][6], qv[ks][7]);
                qf[ks] = __builtin_bit_cast(bf16x8, w); }
        }
        f32x16 S[5];
#pragma unroll
        for (int k5 = 0; k5 < 5; ++k5) {
            f32x16 c;
#pragma unroll
            for (int i = 0; i < 16; ++i) c[i] = 0.f;
#pragma unroll
            for (int ks = 0; ks < 4; ++ks) { const bf16x8 a = *(const LAS bf16x8*)(Kn + (32 * (s + k5) + lq) * KST + 16 * ks + 8 * h);
                c = __builtin_amdgcn_mfma_f32_32x32x16_bf16(a, qf[ks], c, 0, 0, 0); }
            S[k5] = c;
        }
        float m = sink;
#pragma unroll
        for (int k5 = 0; k5 < 5; ++k5)
#pragma unroll
            for (int i = 0; i < 16; ++i) {
                const int keyb = 32 * (s + k5) + (i & 3) + 8 * (i >> 2) + 4 * h, diff = 128 + 32 * s + lq - keyb;
                const bool valid = diff >= 0 && diff < WIN && (qb > 0 || keyb >= 128);
                const float sv = valid ? S[k5][i] : -1e30f; S[k5][i] = sv; m = fmaxf(m, sv);
            }
        m = fmaxf(m, __shfl_xor(m, 32));
        float l = 0.f;
#pragma unroll
        for (int k5 = 0; k5 < 5; ++k5)
#pragma unroll
            for (int i = 0; i < 16; ++i) { const float p = __expf(S[k5][i] - m); S[k5][i] = p; l += p; }
        l += __shfl_xor(l, 32);
        l += __expf(sink - m);
        f32x16 O0, O1;
#pragma unroll
        for (int i = 0; i < 16; ++i) { O0[i] = 0.f; O1[i] = 0.f; }
#pragma unroll
        for (int k5 = 0; k5 < 5; ++k5)
#pragma unroll
            for (int s2 = 0; s2 < 2; ++s2) {
                v4u pw; pw.x = pk2(S[k5][8 * s2 + 0], S[k5][8 * s2 + 1]); pw.y = pk2(S[k5][8 * s2 + 2], S[k5][8 * s2 + 3]);
                pw.z = pk2(S[k5][8 * s2 + 4], S[k5][8 * s2 + 5]); pw.w = pk2(S[k5][8 * s2 + 6], S[k5][8 * s2 + 7]);
                const bf16x8 pf = __builtin_bit_cast(bf16x8, pw);
                const int kk = 32 * (s + k5) + 16 * s2 + 4 * h;
                { const v2u lo = *(const LAS v2u*)(Vt + lq * VST + kk), hi = *(const LAS v2u*)(Vt + lq * VST + kk + 8);
                  v4u aw; aw.x = lo.x; aw.y = lo.y; aw.z = hi.x; aw.w = hi.y;
                  O0 = __builtin_amdgcn_mfma_f32_32x32x16_bf16(__builtin_bit_cast(bf16x8, aw), pf, O0, 0, 0, 0); }
                { const v2u lo = *(const LAS v2u*)(Vt + (32 + lq) * VST + kk), hi = *(const LAS v2u*)(Vt + (32 + lq) * VST + kk + 8);
                  v4u aw; aw.x = lo.x; aw.y = lo.y; aw.z = hi.x; aw.w = hi.y;
                  O1 = __builtin_amdgcn_mfma_f32_32x32x16_bf16(__builtin_bit_cast(bf16x8, aw), pf, O1, 0, 0, 0); }
            }
        const float inv = 1.f / l;
        bf16* orow = mixed + (size_t)qtok * D + CONVC + hq * HD;
#pragma unroll
        for (int g = 0; g < 4; ++g) {
            v2u w0; w0.x = pk2(O0[4 * g + 0] * inv, O0[4 * g + 1] * inv); w0.y = pk2(O0[4 * g + 2] * inv, O0[4 * g + 3] * inv);
            *(v2u*)(orow + 8 * g + 4 * h) = w0;
            v2u w1; w1.x = pk2(O1[4 * g + 0] * inv, O1[4 * g + 1] * inv); w1.y = pk2(O1[4 * g + 2] * inv, O1[4 * g + 3] * inv);
            *(v2u*)(orow + 32 + 8 * g + 4 * h) = w1;
        }
    }
    __syncthreads();
}

typedef __attribute__((address_space(1))) unsigned gu32;
#define XB_TMO      128
#define XB_XCNT(j)  (256  + 64 * (j))
#define XB_XSUB(j)  (1280 + 64 * (j))
#define XB_XGEN(j)  (2304 + 64 * (j))
#define XB_TOP      3328
#define XB_TOPGEN   3392
#define XCD_BAR_WORDS 3456
#define XB_SPIN_CAP (1u << 18)
__device__ __forceinline__ unsigned xb_ld(unsigned* p)              { return __hip_atomic_load(p, __ATOMIC_RELAXED, __HIP_MEMORY_SCOPE_AGENT); }
__device__ __forceinline__ unsigned xb_add(unsigned* p, unsigned v) { return __hip_atomic_fetch_add(p, v, __ATOMIC_RELAXED, __HIP_MEMORY_SCOPE_AGENT); }
__device__ __forceinline__ unsigned xb_xcc_id() { return (unsigned)__builtin_amdgcn_s_getreg((3 << 11) | 20) & 0xFu; }
#define XB_SPIN(cond, bar) do { unsigned _sp = 0; while (cond) { __builtin_amdgcn_s_sleep(1); \
    if ((++_sp & 255u) == 0u) { if (xb_ld(&(bar)[XB_TMO])) break; if (_sp > XB_SPIN_CAP) { atomicAdd(&(bar)[XB_TMO], 1u); break; } } } } while (0)
struct XcdBarrier { unsigned* bar; unsigned x; volatile LAS unsigned* st; };
__device__ __forceinline__ XcdBarrier xcd_barrier_post(unsigned* bar, volatile LAS unsigned* st) {
    XcdBarrier b; b.bar = bar; b.x = xb_xcc_id(); b.st = st;
    if (threadIdx.x == 0) (void)xb_add(&bar[XB_XCNT(b.x)], 1u);
    return b;
}
__device__ __forceinline__ void xcd_barrier_complete(unsigned* bar, unsigned x, unsigned& nloc, unsigned& nx) {
    const unsigned G = gridDim.x * gridDim.y * gridDim.z;
    unsigned sum, cnt, mine, sp = 0u;
    for (;;) {
        sum = 0u; cnt = 0u; mine = 0u;
#pragma unroll
        for (unsigned j = 0; j < 16; ++j) { const unsigned c = xb_ld(&bar[XB_XCNT(j)]); sum += c; cnt += (c > 0u) ? 1u : 0u; mine = (j == x) ? c : mine; }
        if (sum == G) break;
        __builtin_amdgcn_s_sleep(1);
        if ((++sp & 255u) == 0u) { if (xb_ld(&bar[XB_TMO])) break; if (sp > XB_SPIN_CAP) { atomicAdd(&bar[XB_TMO], 1u); break; } }
    }
    nloc = mine > 0u ? mine : 1u; nx = cnt > 0u ? cnt : 1u;
}
__device__ __forceinline__ void xcd_barrier(const XcdBarrier& b) {
    asm volatile("s_waitcnt vmcnt(0)" ::: "memory");
    __syncthreads();
    if (threadIdx.x == 0) {
        unsigned* bar = b.bar;
        __builtin_amdgcn_s_waitcnt(0);
        unsigned nloc = b.st[0], nx = b.st[1];
        if (nloc == 0u) { xcd_barrier_complete(bar, b.x, nloc, nx); b.st[0] = nloc; b.st[1] = nx; }
        const unsigned old = xb_add(&bar[XB_XSUB(b.x)], 1u);
        const unsigned gen = old / nloc;
        if (old + 1u == (gen + 1u) * nloc) {
            __builtin_amdgcn_fence(__ATOMIC_RELEASE, "agent");
            asm volatile("s_waitcnt vmcnt(0)" ::: "memory");
            const unsigned og = xb_add(&bar[XB_TOP], 1u);
            const unsigned tg = og / nx;
            if (og + 1u == (tg + 1u) * nx) xb_add(&bar[XB_TOPGEN], 1u);
            else XB_SPIN(xb_ld(&bar[XB_TOPGEN]) == tg, bar);
            __builtin_amdgcn_fence(__ATOMIC_ACQUIRE, "agent");
            xb_add(&bar[XB_XGEN(b.x)], 1u);
            asm volatile("s_waitcnt vmcnt(0)" ::: "memory");
        } else {
            XB_SPIN(xb_ld(&bar[XB_XGEN(b.x)]) == gen, bar);
            __builtin_amdgcn_fence(__ATOMIC_ACQUIRE, "agent");
            asm volatile("s_waitcnt vmcnt(0)" ::: "memory");
        }
    }
    __syncthreads();
}
#ifndef USE_XCD_BAR
#define USE_XCD_BAR 1
#endif


__device__ __forceinline__ unsigned mono_key(float f) { const unsigned u = __float_as_uint(f); return u ^ ((unsigned)((int)u >> 31) | 0x80000000u); }
__device__ __forceinline__ float mono_val(unsigned k) { const unsigned u = (k & 0x80000000u) ? (k ^ 0x80000000u) : ~k; return __uint_as_float(u); }
__host__ __device__ constexpr int cand_a(int c) { return c < 16 ? 0 : c < 24 ? 1 : c < 29 ? 2 : c < 33 ? 3 : c < 36 ? 4 : c < 38 ? 5 : c < 40 ? 6 : c < 42 ? 7 : c - 34; }
__host__ __device__ constexpr int cand_b(int c) { return c < 16 ? c : c < 24 ? c - 16 : c < 29 ? c - 24 : c < 33 ? c - 29 : c < 36 ? c - 33 : c < 38 ? c - 36 : c < 40 ? c - 38 : c < 42 ? c - 40 : 0; }

typedef __bf16 bf16x2 __attribute__((ext_vector_type(2)));
__device__ __forceinline__ float dot2bf(unsigned w, unsigned x, float acc) { return __builtin_amdgcn_fdot2_f32_bf16(__builtin_bit_cast(bf16x2, w), __builtin_bit_cast(bf16x2, x), acc, false); }
template <int JC> __device__ __forceinline__ float dotn(const unsigned (&x)[4 * JC], const v4u (&u)[JC]) {
    float a0 = 0.f, a1 = 0.f, a2 = 0.f, a3 = 0.f;
#pragma unroll
    for (int j = 0; j < JC; ++j) { a0 = dot2bf(u[j].x, x[4 * j + 0], a0); a1 = dot2bf(u[j].y, x[4 * j + 1], a1); a2 = dot2bf(u[j].z, x[4 * j + 2], a2); a3 = dot2bf(u[j].w, x[4 * j + 3], a3); }
    return (a0 + a1) + (a2 + a3);
}
template <int JC> __device__ __forceinline__ void fman(float (&acc)[8 * JC], float a, const v4u (&v)[JC]) {
#pragma unroll
    for (int j = 0; j < JC; ++j) { const v4u w = v[j];
        acc[8 * j + 0] += a * bflo(w.x); acc[8 * j + 1] += a * bfhi(w.x); acc[8 * j + 2] += a * bflo(w.y); acc[8 * j + 3] += a * bfhi(w.y);
        acc[8 * j + 4] += a * bflo(w.z); acc[8 * j + 5] += a * bfhi(w.z); acc[8 * j + 6] += a * bflo(w.w); acc[8 * j + 7] += a * bfhi(w.w); }
}
__device__ __forceinline__ float row_sum16(float v) {
    v += __builtin_bit_cast(float, __builtin_amdgcn_update_dpp(0, __builtin_bit_cast(int, v), 0x128, 0xF, 0xF, true));
    v += __builtin_bit_cast(float, __builtin_amdgcn_update_dpp(0, __builtin_bit_cast(int, v), 0x124, 0xF, 0xF, true));
    v += __builtin_bit_cast(float, __builtin_amdgcn_update_dpp(0, __builtin_bit_cast(int, v), 0x122, 0xF, 0xF, true));
    v += __builtin_bit_cast(float, __builtin_amdgcn_update_dpp(0, __builtin_bit_cast(int, v), 0x121, 0xF, 0xF, true));
    return v;
}
#ifndef EPTU
#define EPTU 4
#endif
#ifndef EPTV
#define EPTV 2
#endif
#ifndef NPU
#define NPU 4
#endif
#ifndef NPV
#define NPV 4
#endif

#ifndef PASS_BAR
#define PASS_BAR 0
#endif
__device__ __forceinline__ void peer_tile(const Args& A, LAS unsigned char* lds, int t0, int tid, const XcdBarrier& xbar) {
    const bf16* qp = (const bf16*)(A.ws + WS_QP); const bf16* skb = (const bf16*)(A.ws + WS_SKB); const bf16* x1b = (const bf16*)(A.ws + WS_X1B);
    const bf16* Ub = (const bf16*)(A.ws + WS_UB); const bf16* Vb = (const bf16*)(A.ws + WS_VB); const float* ssq = (const float*)(A.ws + WS_SSQ);
    LAS unsigned* TK = (LAS unsigned*)lds;
    LAS int* SE = (LAS int*)(lds + 32768);
    LAS float* SG = (LAS float*)(lds + 49152);
    LAS float* ACT = (LAS float*)(lds + 65536);
    const int lane = tid & 63, wave = tid >> 6, h = lane >> 5, lq = lane & 31;
#ifndef PROBE_SUB
#define PROBE_SUB -1
#endif
    unsigned long long sst[6]; int nss = 0;
#define SSTAMP() do { if (PROBE_SUB >= 0) { __syncthreads(); sst[nss] = __builtin_amdgcn_s_memrealtime(); } ++nss; } while (0)
    SSTAMP();
#ifndef DBG_NO_S1
#pragma unroll 1
    for (int repA = 0; repA < REP_P5A; ++repA) {
#pragma unroll 1
    for (int hp2 = 0; hp2 < 2; ++hp2) {
        const int hp = 2 * wave + hp2;
        LAS bf16* KT = (LAS bf16*)(lds + 32768) + wave * (32 * 136);
        const int srow = lane >> 4, scol = (lane & 15) * 8;
        v4u gq[8];
#pragma unroll
        for (int i = 0; i < 8; ++i) gq[i] = *(const v4u*)(qp + (size_t)(t0 + 4 * i + srow) * D + hp * 128 + scol);
#pragma unroll
        for (int i = 0; i < 8; ++i) *(LAS v4u*)(KT + (4 * i + srow) * 136 + scol) = gq[i];
        bf16x8 qf[8];
#pragma unroll
        for (int ks = 0; ks < 8; ++ks) qf[ks] = *(const LAS bf16x8*)(KT + lq * 136 + 16 * ks + 8 * h);
        unsigned key[64];
        v4u gk[8];
#pragma unroll
        for (int i = 0; i < 8; ++i) gk[i] = *(const v4u*)(skb + (size_t)(hp * 128 + 4 * i + srow) * 128 + scol);
#pragma unroll
        for (int nt = 0; nt < 4; ++nt) {
            LDS_WAIT();
#pragma unroll
            for (int i = 0; i < 8; ++i) *(LAS v4u*)(KT + (4 * i + srow) * 136 + scol) = gk[i];
            if (nt < 3) {
#pragma unroll
                for (int i = 0; i < 8; ++i) gk[i] = *(const v4u*)(skb + (size_t)(hp * 128 + 32 * (nt + 1) + 4 * i + srow) * 128 + scol);
            }
            f32x16 c;
#pragma unroll
            for (int i = 0; i < 16; ++i) c[i] = 0.f;
#pragma unroll
            for (int ks = 0; ks < 8; ++ks) { const bf16x8 a = *(const LAS bf16x8*)(KT + lq * 136 + 16 * ks + 8 * h);
                c = __builtin_amdgcn_mfma_f32_32x32x16_bf16(a, qf[ks], c, 0, 0, 0); }
#pragma unroll
            for (int i = 0; i < 16; ++i) { const int n = 32 * nt + (i & 3) + 8 * (i >> 2) + 4 * h; key[16 * nt + i] = (mono_key(c[i]) & ~127u) | (unsigned)(127 - n); }
        }
#ifndef REP_RND
#define REP_RND 1
#endif
#pragma unroll 1
        for (int rr = 0; rr < REP_RND; ++rr) {
        unsigned cprev = 0xFFFFFFFFu;
#pragma unroll 1
        for (int r = 0; r < PTOPK; ++r) {
            unsigned m = cprev - key[0];
#pragma unroll
            for (int i = 1; i < 64; ++i) { const unsigned d = cprev - key[i]; m = m < d ? m : d; }
            const unsigned pm = (unsigned)__shfl_xor((int)m, 32);
            m = m < pm ? m : pm;
            const unsigned M = cprev - m;
            if (h == 0) TK[((lq * 16) + hp) * 16 + r] = M;
            cprev = M - 1u;
        }
        }
    }
    __syncthreads();
    SSTAMP();
    if (lane < 32) {
        const int p = wave * 32 + lane, t = p >> 3, hd = p & 7;
        const LAS unsigned* K1 = TK + (t * 16 + 2 * hd) * 16; const LAS unsigned* K2 = K1 + 16;
        const float v20 = mono_val(K2[0] & ~127u);
        unsigned ik[16], fl[16];
#pragma unroll
        for (int a = 0; a < 16; ++a) ik[a] = (mono_key(mono_val(K1[a] & ~127u) + v20) & ~255u) | (unsigned)(255 - a * 16);
#pragma unroll
        for (int r = 0; r < 16; ++r) {
            unsigned M = ik[0];
#pragma unroll
            for (int a = 1; a < 16; ++a) M = M > ik[a] ? M : ik[a];
            const unsigned flat = 255u - (M & 255u); fl[r] = flat;
            const unsigned as = flat >> 4, pn = (flat & 15u) + 1u, pc = pn < 16u ? pn : 15u;
            const float sn = mono_val(K1[as] & ~127u) + mono_val(K2[pc] & ~127u);
            const unsigned nk = pn < 16u ? ((mono_key(sn) & ~255u) | (255u - (as * 16u + pn))) : 0u;
#pragma unroll
            for (int a = 0; a < 16; ++a) ik[a] = (as == (unsigned)a) ? nk : ik[a];
        }
        float sv[16]; int ev[16];
#pragma unroll
        for (int r = 0; r < 16; ++r) { const unsigned k1 = K1[fl[r] >> 4], k2 = K2[fl[r] & 15u];
            sv[r] = mono_val(k1 & ~127u) + mono_val(k2 & ~127u); ev[r] = (int)(127u - (k1 & 127u)) * NKEYS + (int)(127u - (k2 & 127u)); }
        const float smax = sv[0]; float gs = 0.f;
#pragma unroll
        for (int r = 0; r < 16; ++r) { sv[r] = __expf(sv[r] - smax); gs += sv[r]; }
        const float ginv = 1.f / gs;
#pragma unroll
        for (int r = 0; r < 16; ++r) { SE[t * 128 + hd * 16 + r] = ev[r]; SG[t * 128 + hd * 16 + r] = sv[r] * ginv; }
    }
    __syncthreads();
    }
#endif
    SSTAMP();
    {
        const int g = lane >> 4, l16 = lane & 15, tl = wave * 4 + g, t = t0 + tl;
        LAS unsigned* ORD = (LAS unsigned*)(lds + 81920);
        const LAS int* SEt = SE + tl * 128; LAS float* ACTt = ACT + tl * 128;
        {
            unsigned key[8]; int rank[8];
#pragma unroll
            for (int j = 0; j < 8; ++j) { key[j] = (((unsigned)SEt[j * 16 + l16] & (unsigned)(NEXP - 1)) << 7) | (unsigned)(j * 16 + l16); rank[j] = 0; }
#pragma unroll 4
            for (int m = 0; m < 128; ++m) { const unsigned km = (((unsigned)SEt[m] & (unsigned)(NEXP - 1)) << 7) | (unsigned)m;
#pragma unroll
                for (int j = 0; j < 8; ++j) rank[j] += km < key[j] ? 1 : 0; }
#pragma unroll
            for (int j = 0; j < 8; ++j) { ORD[tl * 128 + rank[j]] = key[j] << 2; ACTt[j * 16 + l16] = 0.f; }
            LDS_WAIT(); __builtin_amdgcn_wave_barrier();
        }
        const LAS unsigned* ORDt = ORD + tl * 128;
        SSTAMP();
#ifndef DBG_NO_U
        {
            constexpr int NCH = 8 / NPU;
            const unsigned char* U8 = (const unsigned char*)Ub;
            const float rs = rsqrtf(ssq[t] * (1.f / D) + EPS) * (1.f / USCALE);
#pragma unroll 1
            for (int ps = 0; ps < NPU; ++ps) {
                const int pp = ps % NPU; const int cofs = pp * (D / NPU) + l16 * 16; const int tofs = pp * (NEXP * 512) + l16 * 16;
                if (PASS_BAR) xcd_barrier(xbar);
                f32x2 xf2[8 * NCH];
                { const bf16* xr = x1b + (size_t)t * D + cofs;
#pragma unroll
                  for (int j = 0; j < NCH; ++j)
#pragma unroll
                    for (int hh = 0; hh < 2; ++hh) { const v4u w = *(const v4u*)(xr + 256 * j + 8 * hh);
                        xf2[8 * j + 4 * hh + 0] = (f32x2){bflo(w.x), bfhi(w.x)}; xf2[8 * j + 4 * hh + 1] = (f32x2){bflo(w.y), bfhi(w.y)};
                        xf2[8 * j + 4 * hh + 2] = (f32x2){bflo(w.z), bfhi(w.z)}; xf2[8 * j + 4 * hh + 3] = (f32x2){bflo(w.w), bfhi(w.w)}; } }
#define U_LOAD(EN, UU, I0) do { _Pragma("unroll") for (int c = 0; c < EPTU; ++c) { EN[c] = ORDt[(I0) + c]; const unsigned char* up = U8 + ((EN[c] & ~511u) + (unsigned)tofs); \
                    _Pragma("unroll") for (int j = 0; j < NCH; ++j) UU[c][j] = *(const v4u*)(up + 256 * j); } } while (0)
#define U_COMP(EN, UU) do { float tot = 0.f; unsigned ent = 0u; _Pragma("unroll") for (int c = 0; c < EPTU; ++c) { f32x2 p0 = {0.f, 0.f}, p1 = {0.f, 0.f}; \
                    _Pragma("unroll") for (int j = 0; j < NCH; ++j) _Pragma("unroll") for (int d = 0; d < 4; ++d) { \
                        const f32x2 lo = __builtin_amdgcn_cvt_pk_f32_fp8((int)UU[c][j][d], false), hi = __builtin_amdgcn_cvt_pk_f32_fp8((int)UU[c][j][d], true); \
                        p0 = __builtin_elementwise_fma(xf2[8 * j + 2 * d + 0], lo, p0); p1 = __builtin_elementwise_fma(xf2[8 * j + 2 * d + 1], hi, p1); } \
                    const float dd = row_sum16((p0.x + p0.y) + (p1.x + p1.y)); \
                    if (l16 == c) { tot = dd; ent = EN[c]; } } \
                    if (l16 < EPTU) (void)__hip_atomic_fetch_add((LAS float*)((LAS unsigned char*)ACTt + (ent & 0x1FCu)), rs * tot, __ATOMIC_RELAXED, __HIP_MEMORY_SCOPE_WORKGROUP); } while (0)
                unsigned enA[EPTU], enB[EPTU]; v4u uA[EPTU][NCH], uB[EPTU][NCH];
                { int i0 = 0; asm volatile("" : "+s"(i0)); U_LOAD(enA, uA, i0); }
#pragma unroll 1
                for (int i = 0; i < 128; i += 2 * EPTU) {
                    { int i1 = i + EPTU; asm volatile("" : "+s"(i1)); U_LOAD(enB, uB, i1); }
                    __builtin_amdgcn_sched_barrier(0);
                    U_COMP(enA, uA);
                    __builtin_amdgcn_sched_barrier(0);
                    { int i2 = (i + 2 * EPTU) & 127; asm volatile("" : "+s"(i2)); U_LOAD(enA, uA, i2); }
                    __builtin_amdgcn_sched_barrier(0);
                    U_COMP(enB, uB);
                    __builtin_amdgcn_sched_barrier(0);
                }
#undef U_LOAD
#undef U_COMP
                LDS_WAIT(); __builtin_amdgcn_wave_barrier();
            }
#pragma unroll
            for (int j = 0; j < 8; ++j) { const int ix = j * 16 + l16; const float hh = ACTt[ix];
                ACTt[ix] = 0.5f * hh * (1.f + erff(hh * 0.70710678118654752f)) * SG[tl * 128 + ix] * (1.f / VSCALE); }
            LDS_WAIT(); __builtin_amdgcn_wave_barrier();
        }
        SSTAMP();
#endif
#ifndef DBG_NO_V
        {
            constexpr int NCH = 8 / NPV;
            const unsigned char* V8 = (const unsigned char*)Vb;
#pragma unroll 1
            for (int ps = 0; ps < NPV * REP_P5V; ++ps) {
                const int pp = ps % NPV; const int cofs = pp * (D / NPV) + l16 * 16; const int tofs = pp * (NEXP * 512) + l16 * 16;
                if (PASS_BAR) xcd_barrier(xbar);
                float acc[16 * NCH];
#pragma unroll
                for (int i = 0; i < 16 * NCH; ++i) acc[i] = 0.f;
#define V_LOAD(EN, VV, AA, I0) do { _Pragma("unroll") for (int c = 0; c < EPTV; ++c) { EN[c] = ORDt[(I0) + c]; AA[c] = *(const LAS float*)((const LAS unsigned char*)ACTt + (EN[c] & 0x1FCu)); const unsigned char* vp = V8 + ((EN[c] & ~511u) + (unsigned)tofs); \
                    _Pragma("unroll") for (int j = 0; j < NCH; ++j) VV[c][j] = *(const v4u*)(vp + 256 * j); } } while (0)
#define V_COMP(AA, VV) do { _Pragma("unroll") for (int c = 0; c < EPTV; ++c) { const float a = AA[c]; \
                    _Pragma("unroll") for (int j = 0; j < NCH; ++j) _Pragma("unroll") for (int d = 0; d < 4; ++d) { \
                        const f32x2 lo = __builtin_amdgcn_cvt_pk_f32_fp8((int)VV[c][j][d], false), hi = __builtin_amdgcn_cvt_pk_f32_fp8((int)VV[c][j][d], true); \
                        acc[16 * j + 4 * d + 0] += a * lo.x; acc[16 * j + 4 * d + 1] += a * lo.y; acc[16 * j + 4 * d + 2] += a * hi.x; acc[16 * j + 4 * d + 3] += a * hi.y; } } } while (0)
                unsigned enA[EPTV], enB[EPTV]; float aA[EPTV], aB[EPTV]; v4u vA[EPTV][NCH], vB[EPTV][NCH];
                { int i0 = 0; asm volatile("" : "+s"(i0)); V_LOAD(enA, vA, aA, i0); }
#pragma unroll 1
                for (int i = 0; i < 128; i += 2 * EPTV) {
                    { int i1 = i + EPTV; asm volatile("" : "+s"(i1)); V_LOAD(enB, vB, aB, i1); }
                    __builtin_amdgcn_sched_barrier(0);
                    V_COMP(aA, vA);
                    __builtin_amdgcn_sched_barrier(0);
                    { int i2 = (i + 2 * EPTV) & 127; asm volatile("" : "+s"(i2)); V_LOAD(enA, vA, aA, i2); }
                    __builtin_amdgcn_sched_barrier(0);
                    V_COMP(aB, vB);
                    __builtin_amdgcn_sched_barrier(0);
                }
#undef V_LOAD
#undef V_COMP
                if (ps < NPV) {
                    float* orow = A.out + (size_t)t * D + cofs; const bf16* xrow = x1b + (size_t)t * D + cofs;
#pragma unroll
                    for (int j = 0; j < NCH; ++j)
#pragma unroll
                        for (int d = 0; d < 4; ++d) { f32x4 o;
                            if (RESID_BF16) { const v2u xw = *(const v2u*)(xrow + 256 * j + 4 * d); o.x = bflo(xw.x); o.y = bfhi(xw.x); o.z = bflo(xw.y); o.w = bfhi(xw.y); }
                            else o = *(f32x4*)(orow + 256 * j + 4 * d);
                            o.x += acc[16 * j + 4 * d + 0]; o.y += acc[16 * j + 4 * d + 1]; o.z += acc[16 * j + 4 * d + 2]; o.w += acc[16 * j + 4 * d + 3];
                            *(f32x4*)(orow + 256 * j + 4 * d) = o; }
                }
            }
        }
#endif
    }
    SSTAMP();
    if (PROBE_SUB >= 0 && PROBE_SUB < 5 && blockIdx.x == 0 && threadIdx.x == 0) { const unsigned long long span = sst[PROBE_SUB + 1] - sst[PROBE_SUB], t0s = __builtin_amdgcn_s_memrealtime();
        while (__builtin_amdgcn_s_memrealtime() - t0s < span) __builtin_amdgcn_s_sleep(8); }
    __syncthreads();
}


__global__ void __launch_bounds__(NTHR, 2) mega_fwd(Args args) {
    extern __shared__ __attribute__((aligned(16))) unsigned char lds_raw[];
    LAS unsigned char* lds = (LAS unsigned char*)lds_raw;
    const int tid = threadIdx.x, G = gridDim.x, bx = blockIdx.x;
    const int vcu = (G % 8 == 0) ? (bx % 8) * (G / 8) + bx / 8 : bx;
    unsigned char* ws = args.ws;
    const int lo = args.ph_lo, hi = args.ph_hi;
    volatile LAS unsigned* bst = (volatile LAS unsigned*)(lds + LDS_BYTES - 16);
    if (tid < 4) bst[tid] = 0u;
    __syncthreads();
    XcdBarrier xbar = xcd_barrier_post((unsigned*)(ws + WS_BAR), bst);
#if USE_XCD_BAR
#define SEAM_SYNC() xcd_barrier(xbar)
#else
#define SEAM_SYNC() cg::this_grid().sync()
#endif
#ifndef PH_MASK
#define PH_MASK 63
#endif
#define IN(k) (((PH_MASK >> (k)) & 1) && lo <= (k) && (k) < hi)
#ifndef PROBE_PH
#define PROBE_PH -1
#endif
    unsigned long long tstamp[7]; int nst = 0;
#define STAMP() do { if (PROBE_PH >= 0) { tstamp[nst] = __builtin_amdgcn_s_memrealtime(); } ++nst; } while (0)
    STAMP();
#define TIDP() ({ int _t = threadIdx.x; asm volatile("" : "+v"(_t)); _t; })
#define BOTH(k) (IN(k) && IN((k) + 1))
    if (IN(0)) { for (int rep = 0; rep < REP_P0; ++rep) { p0_prologue(args, lds, bx, TIDP()); __syncthreads(); } if (BOTH(0)) SEAM_SYNC(); STAMP(); }
    if (IN(1)) {
        pg8::Gemm g{(const bf16*)(ws + WS_XB), (const bf16*)(ws + WS_W1T), T, INC, D}; pg8::StaticOrder S; S.init(T, INC, G, bx);
        pg8::EpiProjGlu E{(bf16*)(ws + WS_PROJ), (bf16*)(ws + WS_PROJ) + (size_t)T * 1024, (const float*)(ws + WS_RSTD1), args.b_in};
        for (int rep = 0; rep < REP_P1; ++rep) pg8::gemm_phase<pg8::EpiProjGlu, pg8::StaticOrder, PG8_ALIGN, PG8_SP2>(lds, g, S, E);
        if (N_P1 > 0) p1_table_queue(args, bx, TIDP());
        if (BOTH(1)) SEAM_SYNC(); STAMP();
    }
    if (IN(2)) {
        for (int rep = 0; rep < REP_P2; ++rep) {
#ifndef NO_CONV
        for (int r2 = 0; r2 < REP_CONV; ++r2) for (int u = vcu; u < 256; u += G) conv_unit(args, lds, 32 * u, TIDP());
#endif
#ifndef NO_ATTN
        for (int r2 = 0; r2 < REP_ATTN; ++r2) for (int u = vcu; u < 256; u += G) attn_unit(args, lds, u >> 2, (u >> 1) & 1, u & 1, TIDP());
#endif
        }
        if (BOTH(2)) SEAM_SYNC(); STAMP();
    }
    if (IN(3)) {
        pg8::Gemm g{(const bf16*)(ws + WS_MIXED), (const bf16*)(ws + WS_W2T), T, D, D}; pg8::StaticOrder S; S.init(T, D, G, bx);
        pg8::EpiResid E{(const bf16*)(ws + WS_XB), RESID_BF16 ? nullptr : args.out, (bf16*)(ws + WS_X1B), (float*)(ws + WS_SSQ), D};
        pg8::gemm_phase<pg8::EpiResid, pg8::StaticOrder, PG8_ALIGN, PG8_SP2>(lds, g, S, E);
        if (BOTH(3)) SEAM_SYNC(); STAMP();
    }
    if (IN(4)) {
        pg8::Gemm g{(const bf16*)(ws + WS_X1B), (const bf16*)(ws + WS_W3T), T, D, D}; pg8::StaticOrder S; S.init(T, D, G, bx);
        pg8::EpiScaleBf16<true> E{(bf16*)(ws + WS_QP), D, (const float*)(ws + WS_SSQ), nullptr};
        for (int rep = 0; rep < REP_P4; ++rep) pg8::gemm_phase<pg8::EpiScaleBf16<true>, pg8::StaticOrder, PG8_ALIGN, PG8_SP2>(lds, g, S, E);
        if (BOTH(4)) SEAM_SYNC(); STAMP();
    }
    if (IN(5)) {
        for (int u = vcu; u < T / 32; u += G) peer_tile(args, lds, 32 * u, TIDP(), xbar);
    }
#ifdef END_BAR
    SEAM_SYNC();
#endif
    STAMP();
    if (PROBE_PH >= 0 && PROBE_PH < 6 && bx == 0 && threadIdx.x == 0) {
        const unsigned long long span = tstamp[PROBE_PH + 1] - tstamp[PROBE_PH], t0 = __builtin_amdgcn_s_memrealtime();
        while (__builtin_amdgcn_s_memrealtime() - t0 < span) __builtin_amdgcn_s_sleep(8);
    }
#undef IN
#undef BOTH
}

__global__ void k_rope_naive(const int* __restrict__ pos, float* __restrict__ rope) {
    const int i = blockIdx.x * blockDim.x + threadIdx.x; if (i >= T * 8) return;
    const int t = i >> 3, f = i & 7; const float ang = (float)pos[t] * powf(500000.f, -(float)(2 * f) / 16.f); float sn, cs; sincosf(ang, &sn, &cs);
    rope[t * 16 + f] = cs; rope[t * 16 + 8 + f] = sn;
}

#ifndef MK_MODE
#define MK_MODE 1
#endif
#ifndef MK_COOP
#define MK_COOP 1
#endif
#ifndef NAIVE_MASK
#define NAIVE_MASK 0
#endif
extern "C" void kernel_launch(void* const* d_in, const int* in_sizes, int n_in, void* d_out, int out_size, void* d_ws, size_t ws_size, hipStream_t stream) {
    static int grid = 0;
    if (grid == 0) {
        if (n_in != 18 || in_sizes[0] != T * D || out_size != T * D || ws_size < WS_END) {
            fprintf(stderr, "kernel_launch: unexpected shapes: n_in %d in0 %d out %d ws %zu (need %zu)\n", n_in, n_in > 0 ? in_sizes[0] : -1, out_size, ws_size, (size_t)WS_END); grid = -1; return; }
        int dev = 0, cus = 0, per_cu = 0;
        if (hipGetDevice(&dev) != hipSuccess || hipDeviceGetAttribute(&cus, hipDeviceAttributeMultiprocessorCount, dev) != hipSuccess) { fprintf(stderr, "kernel_launch: device query failed\n"); grid = -1; return; }
        if (hipFuncSetAttribute((const void*)mega_fwd, hipFuncAttributeMaxDynamicSharedMemorySize, LDS_BYTES) != hipSuccess) { fprintf(stderr, "kernel_launch: hipFuncSetAttribute failed\n"); grid = -1; return; }
        if (hipOccupancyMaxActiveBlocksPerMultiprocessor(&per_cu, (const void*)mega_fwd, NTHR, LDS_BYTES) != hipSuccess || per_cu < 1) {
            fprintf(stderr, "kernel_launch: occupancy query says %d blocks per CU: nothing launched\n", per_cu); (void)hipGetLastError(); grid = -1; return; }
        grid = cus * 1;
        (void)per_cu;
    }
    if (grid < 0) return;
    unsigned char* ws = (unsigned char*)d_ws;
    (void)hipMemsetAsync(ws + WS_BAR, 0, WS_SSQ + (size_t)T * 4 - WS_BAR, stream);
    Args a{};
    a.x = (const float*)d_in[0]; a.pos = (const int*)d_in[1]; a.g1 = (const float*)d_in[2]; a.w_in = (const float*)d_in[3]; a.b_in = (const float*)d_in[4];
    a.cw = (const float*)d_in[5]; a.cb = (const float*)d_in[6]; a.lg = (const float*)d_in[7]; a.lb = (const float*)d_in[8]; a.qg = (const float*)d_in[9];
    a.kg = (const float*)d_in[10]; a.sinks = (const float*)d_in[11]; a.w_out = (const float*)d_in[12]; a.g2 = (const float*)d_in[13]; a.wq = (const float*)d_in[14];
    a.skeys = (const float*)d_in[15]; a.pu = (const float*)d_in[16]; a.pv = (const float*)d_in[17];
    a.out = (float*)d_out; a.ws = ws;
#if MK_MODE == 1
    a.ph_lo = 0; a.ph_hi = 6;
#if MK_COOP
    void* kargs[] = {&a};
    hipError_t e = hipLaunchCooperativeKernel((const void*)mega_fwd, dim3(grid), dim3(NTHR), kargs, LDS_BYTES, stream);
    if (e != hipSuccess) fprintf(stderr, "kernel_launch: cooperative launch failed: %s (grid %d)\n", hipGetErrorString(e), grid);
#else
    hipLaunchKernelGGL(mega_fwd, dim3(grid), dim3(NTHR), LDS_BYTES, stream, a);
    const hipError_t e = hipPeekAtLastError();
    if (e != hipSuccess) fprintf(stderr, "kernel_launch: launch failed: %s (grid %d)\n", hipGetErrorString(e), grid);
#endif
#else
    float* ssq = (float*)(ws + WS_SSQ); float* rstd1 = (float*)(ws + WS_RSTD1); float* rope = (float*)(ws + WS_ROPE);
    bf16 *skb = (bf16*)(ws + WS_SKB), *w1t = (bf16*)(ws + WS_W1T), *w2t = (bf16*)(ws + WS_W2T), *w3t = (bf16*)(ws + WS_W3T);
    bf16 *xb = (bf16*)(ws + WS_XB), *proj = (bf16*)(ws + WS_PROJ), *mixed = (bf16*)(ws + WS_MIXED), *x1b = (bf16*)(ws + WS_X1B), *qp = (bf16*)(ws + WS_QP);
    bf16 *ub = (bf16*)(ws + WS_UB), *vb = (bf16*)(ws + WS_VB);
    for (int ph = 0; ph < 6; ++ph) {
        if (!((NAIVE_MASK >> ph) & 1)) { a.ph_lo = ph; a.ph_hi = ph + 1; hipLaunchKernelGGL(mega_fwd, dim3(grid), dim3(NTHR), LDS_BYTES, stream, a); continue; }
        switch (ph) {
        case 0:
            k_prep_x<<<1024, 256, 0, stream>>>(a.x, xb, rstd1);
            k_transpose_w<<<dim3(INC / 32, D / 32), 256, 0, stream>>>(a.w_in, a.g1, w1t, D, INC);
            k_transpose_w<<<dim3(D / 32, D / 32), 256, 0, stream>>>(a.w_out, nullptr, w2t, D, D);
            k_transpose_w<<<dim3(D / 32, D / 32), 256, 0, stream>>>(a.wq, a.g2, w3t, D, D);
            k_convert<<<256, 256, 0, stream>>>(a.skeys, nullptr, skb, (size_t)16 * 128 * 128 / 8, 128);
            k_convert<<<2048, 256, 0, stream>>>(a.pu, a.g2, ub, (size_t)NEXP * D / 8, D);
            k_convert<<<2048, 256, 0, stream>>>(a.pv, nullptr, vb, (size_t)NEXP * D / 8, D);
            k_rope_naive<<<T * 8 / 256, 256, 0, stream>>>(a.pos, rope);
            break;
        case 1: k_gemm_naive<EpiProj><<<dim3(INC / 64, T / 64), 256, 0, stream>>>(xb, w1t, T, INC, D, EpiProj{proj, rstd1, a.b_in}); break;
        case 2: k_conv_naive<<<T, 256, 0, stream>>>(proj, a.cw, a.cb, a.lg, a.lb, mixed);
                k_attn_naive<<<T * NQH / 4, 256, 0, stream>>>(proj, a.pos, a.qg, a.kg, a.sinks, mixed); break;
        case 3: k_gemm_naive<EpiX1><<<dim3(D / 64, T / 64), 256, 0, stream>>>(mixed, w2t, T, D, D, EpiX1{a.x, a.out, x1b});
                k_ssq<<<1024, 256, 0, stream>>>(a.out, ssq); break;
        case 4: k_gemm_naive<EpiQp><<<dim3(D / 64, T / 64), 256, 0, stream>>>(x1b, w3t, T, D, D, EpiQp{qp, ssq}); break;
        case 5: k_peer_naive<<<T / 4, 256, 0, stream>>>(qp, skb, x1b, ssq, ub, vb, a.out); break;
        }
    }
#endif
}
```

```cpp
#include <hip/hip_runtime.h>
#include <hip/hip_cooperative_groups.h>
namespace cg = cooperative_groups;
#include <cstdio>
#include <cstdint>

typedef unsigned short bf16;
typedef unsigned v4u __attribute__((ext_vector_type(4)));
typedef unsigned v2u __attribute__((ext_vector_type(2)));
typedef float f32x4 __attribute__((ext_vector_type(4)));

constexpr int T = 8192, D = 2048, CONVC = 1024, HD = 64, NQH = 16, NKVH = 2, ATT = 1024, KVC = 128;
constexpr int INC = 2 * CONVC + ATT + 2 * KVC;
constexpr int QOFF = 2 * CONVC, KOFF = QOFF + ATT, VOFF = KOFF + KVC;
constexpr int CK = 31, WIN = 128;
constexpr int NKEYS = 128, NEXP = NKEYS * NKEYS, PH = 8, PTOPK = 16;
constexpr float EPS = 1e-6f;

constexpr size_t MiB = 1u << 20;
constexpr size_t WS_CTL = 0, CTL_ZERO_BYTES = 1 * MiB;
constexpr size_t WS_BAR = 16 * 1024;
constexpr size_t WS_SSQ = 64 * 1024;
constexpr size_t WS_RSTD1 = 1 * MiB;
constexpr size_t WS_ROPE = 3 * MiB;
constexpr size_t WS_SKB = 2 * MiB;
constexpr size_t WS_W1T = 4 * MiB;
constexpr size_t WS_W2T = 20 * MiB;
constexpr size_t WS_W3T = 28 * MiB;
constexpr size_t WS_XB = 64 * MiB;
constexpr size_t WS_PROJ = 96 * MiB;
constexpr size_t WS_MIXED = 160 * MiB;
constexpr size_t WS_X1B = 192 * MiB;
constexpr size_t WS_QP = 224 * MiB;
constexpr size_t WS_UB = 256 * MiB;
constexpr size_t WS_VB = 320 * MiB;
constexpr size_t WS_END = 384 * MiB;

__device__ __forceinline__ unsigned f2bf(float f) { unsigned u = __float_as_uint(f); return (u + 0x7fffu + ((u >> 16) & 1u)) >> 16; }
__device__ __forceinline__ unsigned pk2(float lo, float hi) { return f2bf(lo) | (f2bf(hi) << 16); }
__device__ __forceinline__ float bf2f(unsigned b) { return __uint_as_float(b << 16); }
__device__ __forceinline__ float bflo(unsigned w) { return __uint_as_float(w << 16); }
__device__ __forceinline__ float bfhi(unsigned w) { return __uint_as_float(w & 0xffff0000u); }
__device__ __forceinline__ float wave_sum(float v) {
#pragma unroll
    for (int o = 1; o < 64; o <<= 1) v += __shfl_xor(v, o);
    return v;
}
__device__ __forceinline__ float wave_max(float v) {
#pragma unroll
    for (int o = 1; o < 64; o <<= 1) v = fmaxf(v, __shfl_xor(v, o));
    return v;
}
__device__ __forceinline__ int wave_min_i(int v) {
#pragma unroll
    for (int o = 1; o < 64; o <<= 1) { int t = __shfl_xor(v, o); v = t < v ? t : v; }
    return v;
}

__global__ void k_prep_x(const float* __restrict__ x, bf16* __restrict__ xb, float* __restrict__ rstd1) {
    const int lane = threadIdx.x & 63, gw = (blockIdx.x * blockDim.x + threadIdx.x) >> 6, ngw = (gridDim.x * blockDim.x) >> 6;
    for (int row = gw; row < T; row += ngw) {
        const f32x4* xr = (const f32x4*)(x + (size_t)row * D) + lane;
        f32x4 v[8]; float ss = 0.f;
#pragma unroll
        for (int j = 0; j < 8; ++j) { v[j] = xr[64 * j]; ss += v[j].x * v[j].x + v[j].y * v[j].y + v[j].z * v[j].z + v[j].w * v[j].w; }
        ss = wave_sum(ss);
        if (lane == 0) rstd1[row] = rsqrtf(ss * (1.f / D) + EPS);
        v2u* o = (v2u*)(xb + (size_t)row * D) + lane;
#pragma unroll
        for (int j = 0; j < 8; ++j) { v2u w; w.x = pk2(v[j].x, v[j].y); w.y = pk2(v[j].z, v[j].w); o[64 * j] = w; }
    }
}
__global__ void k_transpose_w(const float* __restrict__ W, const float* __restrict__ g, bf16* __restrict__ Wt, int K, int N) {
    __shared__ float tile[32][33];
    const int k0 = blockIdx.y * 32, n0 = blockIdx.x * 32, tx = threadIdx.x & 31, ty = threadIdx.x >> 5;
    for (int i = ty; i < 32; i += 8) { const float gv = g ? g[k0 + i] : 1.f; tile[i][tx] = W[(size_t)(k0 + i) * N + n0 + tx] * gv; }
    __syncthreads();
    for (int i = ty; i < 32; i += 8) Wt[(size_t)(n0 + i) * K + k0 + tx] = (bf16)f2bf(tile[tx][i]);
}
__global__ void k_convert(const float* __restrict__ src, const float* __restrict__ g, bf16* __restrict__ dst, size_t n8, int ncol) {
    for (size_t i = (size_t)blockIdx.x * blockDim.x + threadIdx.x; i < n8; i += (size_t)gridDim.x * blockDim.x) {
        f32x4 a = ((const f32x4*)src)[2 * i], b = ((const f32x4*)src)[2 * i + 1];
        if (g) { const int c = (int)((i * 8) % ncol); const f32x4 ga = *(const f32x4*)(g + c), gb = *(const f32x4*)(g + c + 4); a = a * ga; b = b * gb; }
        v4u w; w.x = pk2(a.x, a.y); w.y = pk2(a.z, a.w); w.z = pk2(b.x, b.y); w.w = pk2(b.z, b.w);
        ((v4u*)dst)[i] = w;
    }
}

struct EpiProj { bf16* proj; const float* rstd1; const float* bias;
    __device__ void operator()(int r, int c, float v) const { proj[(size_t)r * INC + c] = (bf16)f2bf(rstd1[r] * v + bias[c]); } };
struct EpiX1 { const float* x; float* out; bf16* x1b;
    __device__ void operator()(int r, int c, float v) const { const float x1 = x[(size_t)r * D + c] + v; out[(size_t)r * D + c] = x1; x1b[(size_t)r * D + c] = (bf16)f2bf(x1); } };
struct EpiQp { bf16* qp; const float* ssq;
    __device__ void operator()(int r, int c, float v) const { qp[(size_t)r * D + c] = (bf16)f2bf(rsqrtf(ssq[r] * (1.f / D) + EPS) * v); } };
template <class Epi>
__global__ void __launch_bounds__(256) k_gemm_naive(const bf16* __restrict__ A, const bf16* __restrict__ Bt, int M, int N, int K, Epi E) {
    __shared__ float As[32][65], Bs[32][65];
    const int tx = threadIdx.x & 15, ty = threadIdx.x >> 4, m0 = blockIdx.y * 64, n0 = blockIdx.x * 64;
    float acc[4][4] = {};
    for (int k0 = 0; k0 < K; k0 += 32) {
        for (int i = threadIdx.x; i < 64 * 32; i += 256) { const int r = i >> 5, k = i & 31;
            As[k][r] = bf2f(A[(size_t)(m0 + r) * K + k0 + k]); Bs[k][r] = bf2f(Bt[(size_t)(n0 + r) * K + k0 + k]); }
        __syncthreads();
#pragma unroll 8
        for (int k = 0; k < 32; ++k) {
            float a[4], b[4];
#pragma unroll
            for (int i = 0; i < 4; ++i) { a[i] = As[k][ty * 4 + i]; b[i] = Bs[k][tx * 4 + i]; }
#pragma unroll
            for (int i = 0; i < 4; ++i)
#pragma unroll
                for (int j = 0; j < 4; ++j) acc[i][j] += a[i] * b[j];
        }
        __syncthreads();
    }
#pragma unroll
    for (int i = 0; i < 4; ++i)
#pragma unroll
        for (int j = 0; j < 4; ++j) E(m0 + ty * 4 + i, n0 + tx * 4 + j, acc[i][j]);
}

__global__ void __launch_bounds__(256) k_conv_naive(const bf16* __restrict__ proj, const float* __restrict__ cw, const float* __restrict__ cb,
                                                     const float* __restrict__ lg, const float* __restrict__ lb, bf16* __restrict__ mixed) {
    __shared__ float red[2][4];
    const int t = blockIdx.x, c0 = threadIdx.x * 4, lane = threadIdx.x & 63, wv = threadIdx.x >> 6;
    float acc[4];
#pragma unroll
    for (int i = 0; i < 4; ++i) acc[i] = cb[c0 + i];
    for (int j = 0; j < CK; ++j) {
        const int tt = t + j - (CK - 1);
        if (tt < 0) continue;
        const v2u a = *(const v2u*)(proj + (size_t)tt * INC + c0), gt = *(const v2u*)(proj + (size_t)tt * INC + CONVC + c0);
        const float av[4] = {bflo(a.x), bfhi(a.x), bflo(a.y), bfhi(a.y)}, gv[4] = {bflo(gt.x), bfhi(gt.x), bflo(gt.y), bfhi(gt.y)};
#pragma unroll
        for (int i = 0; i < 4; ++i) { const float h = av[i] / (1.f + __expf(-gv[i])); acc[i] += h * cw[j * CONVC + c0 + i]; }
    }
    float s = acc[0] + acc[1] + acc[2] + acc[3];
    s = wave_sum(s); if (lane == 0) red[0][wv] = s; __syncthreads();
    const float mu = (red[0][0] + red[0][1] + red[0][2] + red[0][3]) * (1.f / CONVC);
    float q = 0.f;
#pragma unroll
    for (int i = 0; i < 4; ++i) { const float d = acc[i] - mu; q += d * d; }
    q = wave_sum(q); if (lane == 0) red[1][wv] = q; __syncthreads();
    const float rstd = rsqrtf((red[1][0] + red[1][1] + red[1][2] + red[1][3]) * (1.f / CONVC) + EPS);
    float o[4];
#pragma unroll
    for (int i = 0; i < 4; ++i) { const float y = (acc[i] - mu) * rstd * lg[c0 + i] + lb[c0 + i]; o[i] = y / (1.f + __expf(-y)); }
    v2u w; w.x = pk2(o[0], o[1]); w.y = pk2(o[2], o[3]);
    *(v2u*)(mixed + (size_t)t * D + c0) = w;
}

__global__ void __launch_bounds__(256) k_attn_naive(const bf16* __restrict__ proj, const int* __restrict__ pos, const float* __restrict__ qg, const float* __restrict__ kg,
                                                     const float* __restrict__ sinks, bf16* __restrict__ mixed) {
    __shared__ float qs[4][64];
    const int lane = threadIdx.x & 63, wv = threadIdx.x >> 6, gw = blockIdx.x * 4 + wv;
    const int t = gw >> 4, hq = gw & 15, kvh = hq >> 3;
    {
        float q = bf2f(proj[(size_t)t * INC + QOFF + hq * HD + lane]);
        const float ss = wave_sum(q * q);
        q = q * rsqrtf(ss * (1.f / HD) + EPS) * qg[lane];
        const float pv = __shfl(q, lane < 8 ? lane + 8 : (lane < 16 ? lane - 8 : lane));
        if (lane < 16) { const int i = lane & 7; const float ang = (float)pos[t] * powf(500000.f, -(float)(2 * i) / 16.f); float sn, cs; sincosf(ang, &sn, &cs);
            q = lane < 8 ? q * cs - pv * sn : q * cs + pv * sn; }
        qs[wv][lane] = q;
    }
    __syncthreads();
    float sc[2];
#pragma unroll
    for (int h = 0; h < 2; ++h) {
        const int kp = t - lane - 64 * h;
        float s = -1e30f;
        if (kp >= 0) {
            const bf16* kr = proj + (size_t)kp * INC + KOFF + kvh * HD;
            float kv[64]; float ss = 0.f;
#pragma unroll
            for (int d = 0; d < 64; ++d) { kv[d] = bf2f(kr[d]); ss += kv[d] * kv[d]; }
            const float r = rsqrtf(ss * (1.f / HD) + EPS);
#pragma unroll
            for (int d = 0; d < 64; ++d) kv[d] = kv[d] * r * kg[d];
            const float p = (float)pos[kp];
#pragma unroll
            for (int i = 0; i < 8; ++i) { const float ang = p * powf(500000.f, -(float)(2 * i) / 16.f); float sn, cs; sincosf(ang, &sn, &cs);
                const float r1 = kv[i], r2 = kv[i + 8]; kv[i] = r1 * cs - r2 * sn; kv[i + 8] = r2 * cs + r1 * sn; }
            float dot = 0.f;
#pragma unroll
            for (int d = 0; d < 64; ++d) dot += kv[d] * qs[wv][d];
            s = dot * 0.125f;
        }
        sc[h] = s;
    }
    const float sink = sinks[hq];
    const float m = fmaxf(wave_max(fmaxf(sc[0], sc[1])), sink);
    const float p0 = (t - lane >= 0) ? __expf(sc[0] - m) : 0.f, p1 = (t - lane - 64 >= 0) ? __expf(sc[1] - m) : 0.f;
    const float denom = wave_sum(p0 + p1) + __expf(sink - m);
    float acc = 0.f;
    for (int j = 0; j < WIN; ++j) {
        const float pj = __shfl(j < 64 ? p0 : p1, j & 63);
        const int kp = t - j;
        if (kp >= 0) acc += pj * bf2f(proj[(size_t)kp * INC + VOFF + kvh * HD + lane]);
    }
    mixed[(size_t)t * D + CONVC + hq * HD + lane] = (bf16)f2bf(acc / denom);
}

__global__ void k_ssq(const float* __restrict__ x1, float* __restrict__ ssq) {
    const int lane = threadIdx.x & 63, gw = (blockIdx.x * blockDim.x + threadIdx.x) >> 6, ngw = (gridDim.x * blockDim.x) >> 6;
    for (int row = gw; row < T; row += ngw) {
        const f32x4* xr = (const f32x4*)(x1 + (size_t)row * D) + lane; float ss = 0.f;
#pragma unroll
        for (int j = 0; j < 8; ++j) { const f32x4 v = xr[64 * j]; ss += v.x * v.x + v.y * v.y + v.z * v.z + v.w * v.w; }
        ss = wave_sum(ss); if (lane == 0) ssq[row] = ss;
    }
}

__global__ void __launch_bounds__(256) k_peer_naive(const bf16* __restrict__ qp, const bf16* __restrict__ skb, const bf16* __restrict__ x1b, const float* __restrict__ ssq,
                                                     const bf16* __restrict__ Ub, const bf16* __restrict__ Vb, float* __restrict__ out) {
    __shared__ float q_s[4][256];
    __shared__ float tkv[4][2][16];
    __shared__ int tki[4][2][16];
    __shared__ int sel_e[4][128];
    __shared__ float sel_g[4][128];
    __shared__ float act[4][128];
    const int lane = threadIdx.x & 63, wv = threadIdx.x >> 6, t = blockIdx.x * 4 + wv;
    const float rstd2 = rsqrtf(ssq[t] * (1.f / D) + EPS);
    for (int h = 0; h < PH; ++h) {
        for (int i = lane; i < 256; i += 64) q_s[wv][i] = bf2f(qp[(size_t)t * D + h * 256 + i]);
        __builtin_amdgcn_s_waitcnt(0); __builtin_amdgcn_wave_barrier();
        for (int p = 0; p < 2; ++p) {
            float v0 = 0.f, v1 = 0.f;
            const bf16* k0 = skb + ((size_t)(h * 2 + p) * NKEYS + lane) * 128, * k1 = k0 + 64 * 128;
            for (int c8 = 0; c8 < 16; ++c8) {
                const v4u a = ((const v4u*)k0)[c8], b = ((const v4u*)k1)[c8]; const float* qv = &q_s[wv][p * 128 + c8 * 8];
                v0 += qv[0] * bflo(a.x) + qv[1] * bfhi(a.x) + qv[2] * bflo(a.y) + qv[3] * bfhi(a.y) + qv[4] * bflo(a.z) + qv[5] * bfhi(a.z) + qv[6] * bflo(a.w) + qv[7] * bfhi(a.w);
                v1 += qv[0] * bflo(b.x) + qv[1] * bfhi(b.x) + qv[2] * bflo(b.y) + qv[3] * bfhi(b.y) + qv[4] * bflo(b.z) + qv[5] * bfhi(b.z) + qv[6] * bflo(b.w) + qv[7] * bfhi(b.w);
            }
            float tv = 0.f; int ti = 0;
            for (int r = 0; r < PTOPK; ++r) {
                const float M = wave_max(fmaxf(v0, v1));
                const int cn = (v0 == M) ? lane : ((v1 == M) ? lane + 64 : 9999);
                const int nm = wave_min_i(cn);
                if (lane == r) { tv = M; ti = nm; }
                if (nm == lane) v0 = -3.0e38f;
                if (nm == lane + 64) v1 = -3.0e38f;
            }
            if (lane < 16) { tkv[wv][p][lane] = tv; tki[wv][p][lane] = ti; }
        }
        __builtin_amdgcn_s_waitcnt(0); __builtin_amdgcn_wave_barrier();
        float cs[4];
#pragma unroll
        for (int i = 0; i < 4; ++i) cs[i] = tkv[wv][0][lane >> 2] + tkv[wv][1][(lane & 3) * 4 + i];
        float sv = 0.f; int sf = 0;
        for (int r = 0; r < PTOPK; ++r) {
            const float M = wave_max(fmaxf(fmaxf(cs[0], cs[1]), fmaxf(cs[2], cs[3])));
            int cn = 9999;
#pragma unroll
            for (int i = 3; i >= 0; --i) if (cs[i] == M) cn = (lane >> 2) * 16 + (lane & 3) * 4 + i;
            const int nm = wave_min_i(cn);
            if (lane == r) { sv = M; sf = nm; }
#pragma unroll
            for (int i = 0; i < 4; ++i) if (nm == (lane >> 2) * 16 + (lane & 3) * 4 + i) cs[i] = -3.0e38f;
        }
        const float smax = __shfl(sv, 0);
        const float ge = lane < 16 ? __expf(sv - smax) : 0.f;
        const float gs = wave_sum(ge);
        if (lane < 16) { sel_e[wv][h * 16 + lane] = tki[wv][0][sf >> 4] * NKEYS + tki[wv][1][sf & 15]; sel_g[wv][h * 16 + lane] = ge / gs; }
        __builtin_amdgcn_s_waitcnt(0); __builtin_amdgcn_wave_barrier();
    }
    {
        const v4u* xr = (const v4u*)(x1b + (size_t)t * D) + lane;
        float xv[32];
#pragma unroll
        for (int j = 0; j < 4; ++j) { const v4u w = xr[64 * j]; xv[8 * j + 0] = bflo(w.x); xv[8 * j + 1] = bfhi(w.x); xv[8 * j + 2] = bflo(w.y); xv[8 * j + 3] = bfhi(w.y);
            xv[8 * j + 4] = bflo(w.z); xv[8 * j + 5] = bfhi(w.z); xv[8 * j + 6] = bflo(w.w); xv[8 * j + 7] = bfhi(w.w); }
        for (int k = 0; k < 128; ++k) {
            const v4u* ur = (const v4u*)(Ub + (size_t)sel_e[wv][k] * D) + lane; float dot = 0.f;
#pragma unroll
            for (int j = 0; j < 4; ++j) { const v4u w = ur[64 * j];
                dot += xv[8 * j + 0] * bflo(w.x) + xv[8 * j + 1] * bfhi(w.x) + xv[8 * j + 2] * bflo(w.y) + xv[8 * j + 3] * bfhi(w.y)
                     + xv[8 * j + 4] * bflo(w.z) + xv[8 * j + 5] * bfhi(w.z) + xv[8 * j + 6] * bflo(w.w) + xv[8 * j + 7] * bfhi(w.w); }
            dot = wave_sum(dot);
            const float hh = rstd2 * dot;
            if (lane == 0) act[wv][k] = 0.5f * hh * (1.f + erff(hh * 0.70710678118654752f)) * sel_g[wv][k];
        }
    }
    __builtin_amdgcn_s_waitcnt(0); __builtin_amdgcn_wave_barrier();
    {
        float acc[32];
#pragma unroll
        for (int i = 0; i < 32; ++i) acc[i] = 0.f;
        for (int k = 0; k < 128; ++k) {
            const v4u* vr = (const v4u*)(Vb + (size_t)sel_e[wv][k] * D) + lane; const float a = act[wv][k];
#pragma unroll
            for (int j = 0; j < 4; ++j) { const v4u w = vr[64 * j];
                acc[8 * j + 0] += a * bflo(w.x); acc[8 * j + 1] += a * bfhi(w.x); acc[8 * j + 2] += a * bflo(w.y); acc[8 * j + 3] += a * bfhi(w.y);
                acc[8 * j + 4] += a * bflo(w.z); acc[8 * j + 5] += a * bfhi(w.z); acc[8 * j + 6] += a * bflo(w.w); acc[8 * j + 7] += a * bfhi(w.w); }
        }
        f32x4* orow = (f32x4*)(out + (size_t)t * D);
#pragma unroll
        for (int j = 0; j < 4; ++j) {
            f32x4 a = orow[128 * j + 2 * lane], b = orow[128 * j + 2 * lane + 1];
            a.x += acc[8 * j + 0]; a.y += acc[8 * j + 1]; a.z += acc[8 * j + 2]; a.w += acc[8 * j + 3];
            b.x += acc[8 * j + 4]; b.y += acc[8 * j + 5]; b.z += acc[8 * j + 6]; b.w += acc[8 * j + 7];
            orow[128 * j + 2 * lane] = a; orow[128 * j + 2 * lane + 1] = b;
        }
    }
}


namespace pg8 {
#define PG8_LAS __attribute__((address_space(3)))
typedef unsigned short bf16_t;
typedef short bf16x8 __attribute__((ext_vector_type(8)));
typedef float f32x4 __attribute__((ext_vector_type(4)));
typedef unsigned u32x4 __attribute__((ext_vector_type(4)));
constexpr int BM = 256, BK = 64, HALF = 128, HTB = HALF * BK * 2  , STAGE_BYTES = 8 * HTB, NXCD = 8, WGM = 8;

__host__ __device__ __forceinline__ int lds_byte(int r, int c) { const int st = (r >> 4) * 2 + (c >> 5), rr = r & 15, cc = c & 31, ob = rr * 64 + cc * 2; return st * 1024 + (ob ^ (((ob >> 9) & 1) << 5)); }
__host__ __device__ __forceinline__ void stage_rc(int b, int& R, int& C) { const int st = b / 1024, sb = b % 1024, swz = sb ^ (((sb >> 9) & 1) << 5); R = (st >> 1) * 16 + swz / 64; C = (st & 1) * 32 + (swz % 64) / 2; }
__host__ __device__ __forceinline__ int perm32(int rho) { const int n = rho >> 4, i = rho & 15; return 8 * (i >> 2) + 4 * n + (i & 3); }

struct Unit { int pm, pn; };
struct Gemm { const bf16_t* A; const bf16_t* Bt; int M, N, K; };

struct StaticOrder {
    int nM, nN, nwg, G, c;
    __host__ __device__ void init(int M, int N, int G_, int c_) { nM = M / BM; nN = N / BM; nwg = nM * nN; G = G_; c = c_; }
    __host__ __device__ bool next(int i, Unit& u) const {
        const long L = (long)i * G + c; if (L >= nwg) return false;
        int wgid = (int)L; { const int q = nwg / NXCD, r = nwg % NXCD, xcd = wgid % NXCD, off = wgid / NXCD; wgid = (xcd < r ? xcd * (q + 1) : r * (q + 1) + (xcd - r) * q) + off; }
        const int nig = WGM * nN, gid = wgid / nig, fm = gid * WGM, gsz = (nM - fm) < WGM ? (nM - fm) : WGM;
        u.pm = fm + ((wgid % nig) % gsz); u.pn = (wgid % nig) / gsz; return true;
    }
    __device__ __forceinline__ void a_ready(const Unit&) const {}
    __device__ __forceinline__ void done(const Unit&) const {}
};
#ifndef EPI_WT
#define EPI_WT 0
#endif

__device__ __forceinline__ unsigned cvt_pk_bf16(float lo, float hi) { unsigned r; asm volatile("v_cvt_pk_bf16_f32 %0, %1, %2" : "=v"(r) : "v"(lo), "v"(hi)); return r; }

__device__ __forceinline__ void st16_wt(void* p, const u32x4 v) {
#if EPI_WT
    asm volatile("global_store_dwordx4 %0, %1, off sc1\n\ts_nop 1" :: "v"(p), "v"(v) : "memory");
#else
    *(u32x4*)p = v;
#endif
}
template <bool RSQ> struct EpiScaleBf16 {
    static constexpr bool PERM = true, AFTER_DRAIN = false;
    bf16_t* O; int ldc; const float* sv; const float* bias;
    __device__ __forceinline__ void operator()(const f32x4 (&acc)[2][2][4][2], const Unit& u, int wr, int wc, int fr, int fq) const {
        const int row0 = u.pm * BM + wr * 64 + fr, col0 = u.pn * BM + wc * 32 + 8 * fq;
        f32x4 bv[2][2];
#pragma unroll
        for (int bj = 0; bj < 2; ++bj)
#pragma unroll
            for (int n = 0; n < 2; ++n) bv[bj][n] = bias ? *(const f32x4*)(bias + col0 + bj * HALF + 4 * n) : (f32x4){0.f, 0.f, 0.f, 0.f};
#pragma unroll
        for (int ai = 0; ai < 2; ++ai)
#pragma unroll
            for (int m = 0; m < 4; ++m) { const int r = row0 + ai * HALF + m * 16; float s = sv[r]; if (RSQ) s = rsqrtf(s * (1.0f / 2048.0f) + 1e-6f);
                bf16_t* rowp = O + (size_t)r * ldc + col0;
#pragma unroll
                for (int bj = 0; bj < 2; ++bj) { const f32x4 v0 = acc[ai][bj][m][0] * s + bv[bj][0], v1 = acc[ai][bj][m][1] * s + bv[bj][1];
                    u32x4 w; w.x = cvt_pk_bf16(v0[0], v0[1]); w.y = cvt_pk_bf16(v0[2], v0[3]); w.z = cvt_pk_bf16(v1[0], v1[1]); w.w = cvt_pk_bf16(v1[2], v1[3]);
                    st16_wt(rowp + bj * HALF, w); } }
    }
};
struct EpiResid {
    static constexpr bool PERM = true, AFTER_DRAIN = false;
    const bf16_t* XB; float* out; bf16_t* x1b; float* ssq; int ldc;
    __device__ __forceinline__ void operator()(const f32x4 (&acc)[2][2][4][2], const Unit& u, int wr, int wc, int fr, int fq) const {
        const int row0 = u.pm * BM + wr * 64 + fr, col0 = u.pn * BM + wc * 32 + 8 * fq;
#pragma unroll
        for (int ai = 0; ai < 2; ++ai)
#pragma unroll
            for (int m = 0; m < 4; ++m) { const int r = row0 + ai * HALF + m * 16; const size_t off = (size_t)r * ldc + col0; float q = 0.f;
#pragma unroll
                for (int bj = 0; bj < 2; ++bj) {
                    const u32x4 xw = *(const u32x4*)(XB + off + bj * HALF);
                    const f32x4 v0 = (f32x4){__uint_as_float(xw.x << 16), __uint_as_float(xw.x & 0xffff0000u), __uint_as_float(xw.y << 16), __uint_as_float(xw.y & 0xffff0000u)} + acc[ai][bj][m][0],
                                v1 = (f32x4){__uint_as_float(xw.z << 16), __uint_as_float(xw.z & 0xffff0000u), __uint_as_float(xw.w << 16), __uint_as_float(xw.w & 0xffff0000u)} + acc[ai][bj][m][1];
                    if (out) { *(f32x4*)(out + off + bj * HALF) = v0; *(f32x4*)(out + off + bj * HALF + 4) = v1; }
                    u32x4 w; w.x = cvt_pk_bf16(v0[0], v0[1]); w.y = cvt_pk_bf16(v0[2], v0[3]); w.z = cvt_pk_bf16(v1[0], v1[1]); w.w = cvt_pk_bf16(v1[2], v1[3]);
                    st16_wt(x1b + off + bj * HALF, w);
                    q += (v0[0] * v0[0] + v0[1] * v0[1]) + (v0[2] * v0[2] + v0[3] * v0[3]) + (v1[0] * v1[0] + v1[1] * v1[1]) + (v1[2] * v1[2] + v1[3] * v1[3]); }
                q += __shfl_xor(q, 16); q += __shfl_xor(q, 32);
                if (fq == 0) atomicAdd(ssq + r, q);
                asm volatile("" ::: "memory"); }
    }
};

struct EpiProjGlu {
    static constexpr bool PERM = true, AFTER_DRAIN = false;
    bf16_t* hg; bf16_t* qkv; const float* rstd; const float* bias;
    __device__ __forceinline__ void operator()(const f32x4 (&acc)[2][2][4][2], const Unit& u, int wr, int wc, int fr, int fq) const {
        const int row0 = u.pm * BM + wr * 64 + fr, cl = wc * 32 + 8 * fq;
        if (u.pn < 8) {
            f32x4 ba[2], bg[2];
#pragma unroll
            for (int n = 0; n < 2; ++n) { ba[n] = *(const f32x4*)(bias + 128 * u.pn + cl + 4 * n); bg[n] = *(const f32x4*)(bias + 1024 + 128 * u.pn + cl + 4 * n); }
#pragma unroll
            for (int ai = 0; ai < 2; ++ai)
#pragma unroll
                for (int m = 0; m < 4; ++m) { const int r = row0 + ai * HALF + m * 16; const float s = rstd[r]; float h[8];
#pragma unroll
                    for (int n = 0; n < 2; ++n) { const f32x4 a = acc[ai][0][m][n] * s + ba[n], g = acc[ai][1][m][n] * s + bg[n];
#pragma unroll
                        for (int j = 0; j < 4; ++j) h[4 * n + j] = a[j] / (1.0f + __expf(-g[j])); }
                    u32x4 w; w.x = cvt_pk_bf16(h[0], h[1]); w.y = cvt_pk_bf16(h[2], h[3]); w.z = cvt_pk_bf16(h[4], h[5]); w.w = cvt_pk_bf16(h[6], h[7]);
                    *(u32x4*)(hg + (size_t)r * 1024 + 128 * u.pn + cl) = w; }
        } else {
            const int c0 = 256 * (u.pn - 8) + cl;
            f32x4 bv[2][2];
#pragma unroll
            for (int bj = 0; bj < 2; ++bj)
#pragma unroll
                for (int n = 0; n < 2; ++n) bv[bj][n] = *(const f32x4*)(bias + 2048 + c0 + bj * HALF + 4 * n);
#pragma unroll
            for (int ai = 0; ai < 2; ++ai)
#pragma unroll
                for (int m = 0; m < 4; ++m) { const int r = row0 + ai * HALF + m * 16; const float s = rstd[r]; bf16_t* rowp = qkv + (size_t)r * 1280 + c0;
#pragma unroll
                    for (int bj = 0; bj < 2; ++bj) { const f32x4 v0 = acc[ai][bj][m][0] * s + bv[bj][0], v1 = acc[ai][bj][m][1] * s + bv[bj][1];
                        u32x4 w; w.x = cvt_pk_bf16(v0[0], v0[1]); w.y = cvt_pk_bf16(v0[2], v0[3]); w.z = cvt_pk_bf16(v1[0], v1[1]); w.w = cvt_pk_bf16(v1[2], v1[3]);
                        *(u32x4*)(rowp + bj * HALF) = w; } }
        }
    }
};
template <class Epi, class Sched, bool ALIGN_EPI = false, bool SP2 = false>
__device__ __forceinline__ void gemm_phase(PG8_LAS unsigned char* lds, const Gemm g, const Sched& S, const Epi& E) {
    const int tid = threadIdx.x, wid = __builtin_amdgcn_readfirstlane(tid >> 6), lane = tid & 63, wr = wid >> 2, wc = wid & 3, fr = lane & 15, fq = lane >> 4;
    const int K = g.K, nt = K / BK;
    unsigned voffA[2], voffB[2];
#pragma unroll
    for (int i = 0; i < 2; ++i) { int R, C; stage_rc(tid * 16 + i * 8192, R, C); const int Rb = Epi::PERM ? ((R & ~31) + perm32(R & 31)) : R;
        voffA[i] = (unsigned)(R * K + C) * 2u; voffB[i] = (unsigned)(Rb * K + C) * 2u; }
    const size_t kstep = (size_t)(BK * 2);
    const size_t hstep = (size_t)HALF * K * 2;
    const size_t tstep = 2 * hstep;
    const unsigned ldsw = (unsigned)wid * 1024u;
    const int aoff = lds_byte(wr * 64 + fr, fq * 8), boff = lds_byte(wc * 32 + fr, fq * 8);
#define PG8_SA(b, h) (((b) * 2 + (h)) * HTB)
#define PG8_SB(b, h) ((4 + (b) * 2 + (h)) * HTB)
#define PG8_STAGE(bufoff, gbase, voff) do { _Pragma("unroll") for (int _i = 0; _i < 2; ++_i) \
        __builtin_amdgcn_global_load_lds((const unsigned*)((const char*)(gbase) + (voff)[_i]), (PG8_LAS unsigned*)(lds + (bufoff) + ldsw + _i * 8192), 16, 0, 0); } while (0)
#define PG8_LDA(dst, b, h) do { _Pragma("unroll") for (int m = 0; m < 4; ++m) _Pragma("unroll") for (int k = 0; k < 2; ++k) dst[m][k] = *(const PG8_LAS bf16x8*)(lds + PG8_SA(b, h) + aoff + m * 2048 + k * 1024); } while (0)
#define PG8_LDB(dst, b, h) do { _Pragma("unroll") for (int n = 0; n < 2; ++n) _Pragma("unroll") for (int k = 0; k < 2; ++k) dst[n][k] = *(const PG8_LAS bf16x8*)(lds + PG8_SB(b, h) + boff + n * 2048 + k * 1024); } while (0)
#define PG8_MMA(ai, bj, At, Bt) do { __builtin_amdgcn_s_setprio(1); _Pragma("unroll") for (int m = 0; m < 4; ++m) _Pragma("unroll") for (int n = 0; n < 2; ++n) _Pragma("unroll") for (int k = 0; k < 2; ++k) \
        acc[ai][bj][m][n] = __builtin_amdgcn_mfma_f32_16x16x32_bf16(Bt[n][k], At[m][k], acc[ai][bj][m][n], 0, 0, 0); __builtin_amdgcn_s_setprio(0); } while (0)
#define PG8_WAIT_V(n) asm volatile("s_waitcnt vmcnt(" #n ")" ::: "memory")
#define PG8_WAIT_L(n) asm volatile("s_waitcnt lgkmcnt(" #n ")" ::: "memory")
#define PG8_BAR __builtin_amdgcn_s_barrier()
#define PG8_SCHED __builtin_amdgcn_sched_barrier(0)
    Unit cur, nxt; int ui = 0;
    if (!S.next(0, cur)) return;
    f32x4 acc[2][2][4][2];
#pragma unroll
    for (int a = 0; a < 2; ++a)
#pragma unroll
        for (int b = 0; b < 2; ++b)
#pragma unroll
            for (int m = 0; m < 4; ++m)
#pragma unroll
                for (int n = 0; n < 2; ++n) acc[a][b][m][n] = (f32x4){0.f, 0.f, 0.f, 0.f};
    bf16x8 At[4][2], B0[2][2], B1[2][2];
    const char* cA = (const char*)g.A + (size_t)cur.pm * tstep; const char* cB = (const char*)g.Bt + (size_t)cur.pn * tstep;
    S.a_ready(cur);
    if constexpr (SP2) {
        PG8_STAGE(PG8_SB(0, 0), cB, voffB); PG8_STAGE(PG8_SB(0, 1), cB + hstep, voffB); PG8_STAGE(PG8_SA(0, 0), cA, voffA); PG8_STAGE(PG8_SA(0, 1), cA + hstep, voffA);
        if (wr == 1) PG8_BAR;
        PG8_WAIT_V(2); PG8_BAR;
        PG8_STAGE(PG8_SB(1, 0), cB + kstep, voffB); PG8_STAGE(PG8_SA(1, 0), cA + kstep, voffA); PG8_STAGE(PG8_SB(1, 1), cB + hstep + kstep, voffB);
        PG8_WAIT_V(6); PG8_BAR;
    } else {
        PG8_STAGE(PG8_SB(0, 0), cB, voffB); PG8_STAGE(PG8_SA(0, 0), cA, voffA); PG8_STAGE(PG8_SB(0, 1), cB + hstep, voffB); PG8_STAGE(PG8_SA(0, 1), cA + hstep, voffA);
        if (wr == 1) PG8_BAR;
        PG8_WAIT_V(4); PG8_BAR;
        PG8_STAGE(PG8_SB(1, 0), cB + kstep, voffB); PG8_STAGE(PG8_SA(1, 0), cA + kstep, voffA); PG8_STAGE(PG8_SB(1, 1), cB + hstep + kstep, voffB);
        PG8_WAIT_V(6); PG8_BAR;
    }
    for (;;) {
        const bool has_next = S.next(ui + 1, nxt);
        const char* nA = has_next ? (const char*)g.A + (size_t)nxt.pm * tstep : cA; const char* nB = has_next ? (const char*)g.Bt + (size_t)nxt.pn * tstep : cB;
        for (int t = 0; t < nt; t += 2) {
            const bool last = (t == nt - 2);
            const char* a1 = cA + (size_t)(t + 1) * kstep;
            const char* a2 = last ? nA : cA + (size_t)(t + 2) * kstep; const char* b2 = last ? nB : cB + (size_t)(t + 2) * kstep;
            const char* a3 = a2 + kstep; const char* b3 = b2 + kstep;
            if (last && has_next) S.a_ready(nxt);
            if constexpr (SP2) {
            PG8_LDB(B0, 0, 0); PG8_LDB(B1, 0, 1); PG8_SCHED; PG8_LDA(At, 0, 0); PG8_STAGE(PG8_SA(1, 1), a1 + hstep, voffA);
            PG8_WAIT_V(8); PG8_WAIT_L(0); PG8_BAR; PG8_MMA(0, 0, At, B0); PG8_MMA(0, 1, At, B1); PG8_BAR; PG8_SCHED;
            PG8_LDA(At, 0, 1); PG8_STAGE(PG8_SB(0, 0), b2, voffB); PG8_STAGE(PG8_SB(0, 1), b2 + hstep, voffB); PG8_STAGE(PG8_SA(0, 0), a2, voffA);
            PG8_WAIT_V(8); PG8_WAIT_L(0); PG8_BAR; PG8_MMA(1, 0, At, B0); PG8_MMA(1, 1, At, B1); PG8_BAR; PG8_SCHED;
            PG8_LDB(B0, 1, 0); PG8_LDB(B1, 1, 1); PG8_SCHED; PG8_LDA(At, 1, 0); PG8_STAGE(PG8_SA(0, 1), a2 + hstep, voffA);
            PG8_WAIT_V(8); PG8_WAIT_L(0); PG8_BAR; PG8_MMA(0, 0, At, B0); PG8_MMA(0, 1, At, B1); PG8_BAR; PG8_SCHED;
            PG8_LDA(At, 1, 1); PG8_STAGE(PG8_SB(1, 0), b3, voffB); PG8_STAGE(PG8_SB(1, 1), b3 + hstep, voffB); PG8_STAGE(PG8_SA(1, 0), a3, voffA);
            PG8_WAIT_V(8); PG8_WAIT_L(0); PG8_BAR; PG8_MMA(1, 0, At, B0); PG8_MMA(1, 1, At, B1); PG8_BAR; PG8_SCHED;
            } else {
            PG8_LDB(B0, 0, 0); PG8_SCHED; PG8_LDA(At, 0, 0); PG8_STAGE(PG8_SA(1, 1), a1 + hstep, voffA);
            PG8_WAIT_L(8); PG8_BAR; PG8_WAIT_L(0); PG8_MMA(0, 0, At, B0); PG8_BAR; PG8_SCHED;
            PG8_LDB(B1, 0, 1); PG8_STAGE(PG8_SB(0, 0), b2, voffB);
            PG8_BAR; PG8_WAIT_L(0); PG8_MMA(0, 1, At, B1); PG8_BAR;
            PG8_LDA(At, 0, 1); PG8_STAGE(PG8_SA(0, 0), a2, voffA);
            PG8_BAR; PG8_WAIT_L(0); PG8_MMA(1, 0, At, B0); PG8_BAR; PG8_SCHED;
            PG8_STAGE(PG8_SB(0, 1), b2 + hstep, voffB);
            PG8_WAIT_V(6); PG8_BAR; PG8_MMA(1, 1, At, B1); PG8_BAR;
            PG8_LDB(B0, 1, 0); PG8_SCHED; PG8_LDA(At, 1, 0); PG8_STAGE(PG8_SA(0, 1), a2 + hstep, voffA);
            PG8_WAIT_L(8); PG8_BAR; PG8_WAIT_L(0); PG8_MMA(0, 0, At, B0); PG8_BAR; PG8_SCHED;
            PG8_LDB(B1, 1, 1); PG8_STAGE(PG8_SB(1, 0), b3, voffB);
            PG8_BAR; PG8_WAIT_L(0); PG8_MMA(0, 1, At, B1); PG8_BAR;
            PG8_LDA(At, 1, 1); PG8_STAGE(PG8_SA(1, 0), a3, voffA);
            PG8_BAR; PG8_WAIT_L(0); PG8_MMA(1, 0, At, B0); PG8_BAR; PG8_SCHED;
            PG8_STAGE(PG8_SB(1, 1), b3 + hstep, voffB);
            PG8_WAIT_V(6); PG8_BAR; PG8_MMA(1, 1, At, B1); PG8_BAR;
            }
        }
        if constexpr (ALIGN_EPI) { if (wr == 0) PG8_BAR; }
        if constexpr (!Epi::AFTER_DRAIN) { E(acc, cur, wr, wc, fr, fq); S.done(cur); }
        if (!has_next) break;
#pragma unroll
        for (int a = 0; a < 2; ++a)
#pragma unroll
            for (int b = 0; b < 2; ++b)
#pragma unroll
                for (int m = 0; m < 4; ++m)
#pragma unroll
                    for (int n = 0; n < 2; ++n) acc[a][b][m][n] = (f32x4){0.f, 0.f, 0.f, 0.f};
        cur = nxt; cA = nA; cB = nB; ++ui;
        if constexpr (ALIGN_EPI) { if (wr == 1) PG8_BAR; }
    }
    PG8_WAIT_V(0);
    if constexpr (!ALIGN_EPI) { if (wr == 0) PG8_BAR; }
    PG8_BAR;
    if constexpr (Epi::AFTER_DRAIN) { E.fused(acc, cur, wr, wc, fr, fq, lds, wid, lane); S.done(cur); }
#undef PG8_SA
#undef PG8_SB
#undef PG8_STAGE
#undef PG8_LDA
#undef PG8_LDB
#undef PG8_MMA
#undef PG8_WAIT_V
#undef PG8_WAIT_L
#undef PG8_BAR
#undef PG8_SCHED
}
}

#ifndef REP_P0
#define REP_P0 1
#endif
#ifndef REP_P1
#define REP_P1 1
#endif
#ifndef REP_P2
#define REP_P2 1
#endif
#ifndef REP_CONV
#define REP_CONV 1
#endif
#ifndef REP_ATTN
#define REP_ATTN 1
#endif
#ifndef REP_P4
#define REP_P4 1
#endif
#ifndef REP_P5A
#define REP_P5A 1
#endif
#ifndef REP_P5U
#define REP_P5U 1
#endif
#ifndef REP_P5V
#define REP_P5V 1
#endif
#ifndef PG8_SP2
#define PG8_SP2 true
#endif
#ifndef PG8_ALIGN
#define PG8_ALIGN true
#endif

#ifndef RESID_BF16
#define RESID_BF16 1
#endif
#ifndef TAB_R0
#define TAB_R0 4096
#endif
constexpr float VSCALE = 128.f;
constexpr float USCALE = 2048.f;
constexpr int NWAVES = 8, NTHR = 512;
constexpr int LDS_BYTES = 160 * 1024;
#define LAS __attribute__((address_space(3)))
typedef short bf16x8 __attribute__((ext_vector_type(8)));
typedef float f32x16 __attribute__((ext_vector_type(16)));
typedef float f32x2 __attribute__((ext_vector_type(2)));
#define LDS_WAIT() asm volatile("s_waitcnt lgkmcnt(0)" ::: "memory")

struct Args {
    const float* x; const int* pos; const float* g1; const float* w_in; const float* b_in; const float* cw; const float* cb; const float* lg; const float* lb;
    const float* qg; const float* kg; const float* sinks; const float* w_out; const float* g2; const float* wq; const float* skeys; const float* pu; const float* pv;
    float* out; unsigned char* ws; int ph_lo, ph_hi;
};

__device__ __forceinline__ int w1_row(int n) { return n < 1024 ? 256 * (n >> 7) + (n & 127) : n < 2048 ? 256 * ((n - 1024) >> 7) + 128 + (n & 127) : n; }
template <bool GLU_PERM = false>
__device__ __forceinline__ void p0_transpose_item(const float* W, const float* g, int K, int N, bf16* WT, LAS float* scr, int item, int lane) {
    const int nblk = N / 32, kb = item / nblk, nb = item % nblk, k0 = 64 * kb, n0 = 32 * nb;
    f32x4 wv[8];
#pragma unroll
    for (int i = 0; i < 8; ++i) wv[i] = __builtin_nontemporal_load((const f32x4*)(W + (size_t)(k0 + 8 * i + (lane >> 3)) * N + n0 + 4 * (lane & 7)));
#pragma unroll
    for (int i = 0; i < 8; ++i) { const int kk = 8 * i + (lane >> 3); const float gv = g ? g[k0 + kk] : 1.f; LAS float* s = scr + kk * 33 + 4 * (lane & 7);
        s[0] = wv[i].x * gv; s[1] = wv[i].y * gv; s[2] = wv[i].z * gv; s[3] = wv[i].w * gv; }
    LDS_WAIT(); asm volatile("" ::: "memory");
    const int c = lane & 7;
#pragma unroll
    for (int j = 0; j < 4; ++j) { const int n = (lane >> 3) + 8 * j; const LAS float* s = scr + (8 * c) * 33 + n;
        v4u o; o.x = pk2(s[0 * 33], s[1 * 33]); o.y = pk2(s[2 * 33], s[3 * 33]); o.z = pk2(s[4 * 33], s[5 * 33]); o.w = pk2(s[6 * 33], s[7 * 33]);
        *(v4u*)(WT + (size_t)(GLU_PERM ? w1_row(n0 + n) : n0 + n) * K + k0 + 8 * c) = o; }
    LDS_WAIT(); asm volatile("" ::: "memory");
}
__device__ __forceinline__ void p0_convert(const float* src, const float* g, bf16* dst, size_t n8, int ncol, size_t gtid, size_t nthr) {
    for (size_t i = gtid; i < n8; i += nthr) {
        f32x4 a = ((const f32x4*)src)[2 * i], b = ((const f32x4*)src)[2 * i + 1];
        if (g) { const int c = (int)((i * 8) % ncol); const f32x4 ga = *(const f32x4*)(g + c), gb = *(const f32x4*)(g + c + 4); a = a * ga; b = b * gb; }
        v4u w; w.x = pk2(a.x, a.y); w.y = pk2(a.z, a.w); w.z = pk2(b.x, b.y); w.w = pk2(b.z, b.w);
        ((v4u*)dst)[i] = w;
    }
}
__device__ __forceinline__ void p0_convert_fp8g(const float* src, const float* g, unsigned char* dst, size_t n16, float scale, size_t gtid, size_t nthr) {
    for (size_t i0 = gtid; i0 < n16; i0 += 4 * nthr) {
        f32x4 a[4][4];
#pragma unroll
        for (int u = 0; u < 4; ++u) { const size_t i = i0 + u * nthr; if (i < n16) {
#pragma unroll
            for (int q = 0; q < 4; ++q) a[u][q] = ((const f32x4*)src)[4 * i + q]; } }
#pragma unroll
        for (int u = 0; u < 4; ++u) { const size_t i = i0 + u * nthr; if (i < n16) {
            v4u w; const int c0 = (int)((i * 16) % D);
#pragma unroll
            for (int q = 0; q < 4; ++q) { f32x4 v = a[u][q] * scale; if (g) v = v * *(const f32x4*)(g + c0 + 4 * q);
                int d = __builtin_amdgcn_cvt_pk_fp8_f32(v.x, v.y, 0, false); d = __builtin_amdgcn_cvt_pk_fp8_f32(v.z, v.w, d, true); w[q] = (unsigned)d; }
            ((v4u*)dst)[i] = w; } }
    }
}
__device__ __forceinline__ void p0_convert_fp8(const float* src, unsigned char* dst, size_t n16, float scale, size_t gtid, size_t nthr) { p0_convert_fp8g(src, nullptr, dst, n16, scale, gtid, nthr); }
constexpr size_t WS_Q0 = 32 * 1024, WS_Q1 = 40 * 1024;
__device__ __forceinline__ int q_pull(unsigned* q, int lane) {
    unsigned v = 0u; if (lane == 0) v = __hip_atomic_fetch_add(q, 1u, __ATOMIC_RELAXED, __HIP_MEMORY_SCOPE_AGENT);
    return __builtin_amdgcn_readfirstlane((int)v);
}
__device__ __forceinline__ void tab_load(const float* src, int row, int lane, f32x4 (&a)[4][4]) {
    const size_t ib = (size_t)row * (D / 16);
#pragma unroll
    for (int u = 0; u < 4; ++u)
#pragma unroll
        for (int q = 0; q < 4; ++q) a[u][q] = __builtin_nontemporal_load((const f32x4*)src + 4 * (ib + u * 64 + lane) + q);
}
__device__ __forceinline__ void tab_store(const float* g, unsigned char* dst, int row, float scale, int lane, const f32x4 (&a)[4][4]) {
    const size_t ib = (size_t)row * (D / 16);
#pragma unroll
    for (int u = 0; u < 4; ++u) { const size_t i = ib + u * 64 + lane; const int c0 = (int)((i * 16) % D); v4u w;
#pragma unroll
        for (int q = 0; q < 4; ++q) { f32x4 v = a[u][q] * scale; if (g) v = v * *(const f32x4*)(g + c0 + 4 * q);
            int d = __builtin_amdgcn_cvt_pk_fp8_f32(v.x, v.y, 0, false); d = __builtin_amdgcn_cvt_pk_fp8_f32(v.z, v.w, d, true); w[q] = (unsigned)d; }
        ((v4u*)dst)[i] = w; }
}
__device__ __forceinline__ void p0_table_rows2(const float* src, const float* g, unsigned char* dst, int row, float scale, int lane) {
    f32x4 a[4][4]; tab_load(src, row, lane, a); tab_store(g, dst, row, scale, lane, a);
}
constexpr int C_X = T / 2, C_W1 = (D / 64) * (INC / 32) / 4, C_W2 = (D / 64) * (D / 32) / 4, C_ROPE = T * 8 / 1024, C_SK = 16 * 128 * 128 / 8 / 512, C_TAB = TAB_R0 / 2;
constexpr int B_W1 = C_X, B_W2 = B_W1 + C_W1, B_W3 = B_W2 + C_W2, B_ROPE = B_W3 + C_W2, B_SK = B_ROPE + C_ROPE, B_TU = B_SK + C_SK, N_P0 = B_TU + C_TAB;
__device__ __forceinline__ void p0_chunk(const Args& A, LAS float* scr, int c, int lane) {
    unsigned char* ws = A.ws;
    if (c < B_W1) {
        bf16* xb = (bf16*)(ws + WS_XB); float* rstd1 = (float*)(ws + WS_RSTD1);
        const int row = 2 * c, row2 = row + 1;
        const f32x4* xr = (const f32x4*)(A.x + (size_t)row * D) + lane; const f32x4* xr2 = (const f32x4*)(A.x + (size_t)row2 * D) + lane;
        f32x4 v[8], w[8]; float ss = 0.f, ss2 = 0.f;
#pragma unroll
        for (int j = 0; j < 8; ++j) { v[j] = __builtin_nontemporal_load(xr + 64 * j); w[j] = __builtin_nontemporal_load(xr2 + 64 * j); }
#pragma unroll
        for (int j = 0; j < 8; ++j) { ss += v[j].x * v[j].x + v[j].y * v[j].y + v[j].z * v[j].z + v[j].w * v[j].w; ss2 += w[j].x * w[j].x + w[j].y * w[j].y + w[j].z * w[j].z + w[j].w * w[j].w; }
        ss = wave_sum(ss); ss2 = wave_sum(ss2);
        if (lane == 0) { rstd1[row] = rsqrtf(ss * (1.f / D) + EPS); rstd1[row2] = rsqrtf(ss2 * (1.f / D) + EPS); }
        v2u* o = (v2u*)(xb + (size_t)row * D) + lane; v2u* o2 = (v2u*)(xb + (size_t)row2 * D) + lane;
#pragma unroll
        for (int j = 0; j < 8; ++j) { v2u q; q.x = pk2(v[j].x, v[j].y); q.y = pk2(v[j].z, v[j].w); o[64 * j] = q; v2u r; r.x = pk2(w[j].x, w[j].y); r.y = pk2(w[j].z, w[j].w); o2[64 * j] = r; }
    } else if (c < B_W2) {
        for (int i = 0; i < 4; ++i) p0_transpose_item<true>(A.w_in, A.g1, D, INC, (bf16*)(ws + WS_W1T), scr, 4 * (c - B_W1) + i, lane);
    } else if (c < B_W3) {
        for (int i = 0; i < 4; ++i) p0_transpose_item(A.w_out, nullptr, D, D, (bf16*)(ws + WS_W2T), scr, 4 * (c - B_W2) + i, lane);
    } else if (c < B_ROPE) {
        for (int i = 0; i < 4; ++i) p0_transpose_item(A.wq, A.g2, D, D, (bf16*)(ws + WS_W3T), scr, 4 * (c - B_W3) + i, lane);
    } else if (c < B_SK) {
        float* rope = (float*)(ws + WS_ROPE);
        for (int j = 0; j < 16; ++j) { const int i = (c - B_ROPE) * 1024 + j * 64 + lane, t = i >> 3, f = i & 7;
            const float ang = (float)A.pos[t] * powf(500000.f, -(float)(2 * f) / 16.f); float sn, cs; sincosf(ang, &sn, &cs);
            rope[t * 16 + f] = cs; rope[t * 16 + 8 + f] = sn; }
    } else if (c < B_TU) {
        p0_convert(A.skeys, nullptr, (bf16*)(ws + WS_SKB), (size_t)(c - B_SK + 1) * 512, 128, (size_t)(c - B_SK) * 512 + lane, 64);
    } else {
        p0_table_rows2(A.pu, A.g2, ws + WS_UB, 2 * (c - B_TU), USCALE, lane);
    }
}
__device__ __forceinline__ void p0_prologue(const Args& A, LAS unsigned char* lds, int bx, int tid) {
    const int lane = tid & 63, wave = tid >> 6, shard = bx & 7;
    LAS float* scr = (LAS float*)(lds + wave * 16384);
    unsigned* q = (unsigned*)(A.ws + WS_Q0) + 64 * shard;
    int nxt = q_pull(q, lane);
    for (;;) { const int c = 8 * nxt + shard; if (c >= N_P0) break; nxt = q_pull(q, lane); p0_chunk(A, scr, c, lane); }
}
constexpr int N_P1 = (NEXP - TAB_R0) / 2;
__device__ __forceinline__ void p1_table_queue(const Args& A, int bx, int tid) {
    const int lane = tid & 63, shard = bx & 7;
    unsigned* q = (unsigned*)(A.ws + WS_Q1) + 64 * shard;
    int nxt = q_pull(q, lane);
    for (;;) { const int c = 8 * nxt + shard; if (c >= N_P1) break; nxt = q_pull(q, lane);
        p0_table_rows2(A.pu, A.g2, A.ws + WS_UB, TAB_R0 + 2 * c, USCALE, lane); }
}

__device__ __forceinline__ void conv_unit(const Args& A, LAS unsigned char* lds, int t0, int tid) {
    const bf16* proj = (const bf16*)(A.ws + WS_PROJ); bf16* mixed = (bf16*)(A.ws + WS_MIXED);
    const int lane = tid & 63, wave = tid >> 6;
    LAS bf16* H = (LAS bf16*)lds;
#pragma unroll 1
    for (int b = 0; b < 2; ++b) {
        v4u hv[8];
#pragma unroll
        for (int q = 0; q < 8; ++q) { const int it = tid + NTHR * (8 * b + q); const int row = it >> 7, ch = (it & 127) * 8, tt = t0 - 30 + row;
            hv[q] = (v4u){0u, 0u, 0u, 0u};
            if (it < 62 * 128 && tt >= 0) hv[q] = *(const v4u*)(proj + (size_t)tt * 1024 + ch); }
#pragma unroll
        for (int q = 0; q < 8; ++q) { const int it = tid + NTHR * (8 * b + q); const int row = it >> 7, ch = (it & 127) * 8;
            if (it < 62 * 128) *(LAS v4u*)(H + row * 1024 + ch) = hv[q]; }
    }
    __syncthreads();
    LAS float* Cf = (LAS float*)(lds + 62 * 1024 * 2);
    float w0[CK], w1[CK];
#pragma unroll
    for (int j = 0; j < CK; ++j) { const f32x2 wv = *(const f32x2*)(A.cw + j * CONVC + 2 * tid); w0[j] = wv.x; w1[j] = wv.y; }
    const f32x2 bv = *(const f32x2*)(A.cb + 2 * tid);
    f32x4 lgv[4], lbv[4];
#pragma unroll
    for (int j = 0; j < 4; ++j) { lgv[j] = *(const f32x4*)(A.lg + 4 * lane + 256 * j); lbv[j] = *(const f32x4*)(A.lb + 4 * lane + 256 * j); }
#pragma unroll 1
    for (int c = 0; c < 4; ++c) {
        float a0[8], a1[8];
#pragma unroll
        for (int tt = 0; tt < 8; ++tt) { a0[tt] = bv.x; a1[tt] = bv.y; }
        const LAS bf16* Hc = H + (8 * c) * 1024 + 2 * tid;
#pragma unroll
        for (int i = 0; i < 38; ++i) {
            const unsigned hw = *(const LAS unsigned*)(Hc + i * 1024); const float h0 = bflo(hw), h1 = bfhi(hw);
#pragma unroll
            for (int tt = 0; tt < 8; ++tt) { const int j = i - tt; if (j >= 0 && j < CK) { a0[tt] += h0 * w0[j]; a1[tt] += h1 * w1[j]; } }
        }
#pragma unroll
        for (int tt = 0; tt < 8; ++tt) *(LAS f32x2*)(Cf + tt * 1024 + 2 * tid) = (f32x2){a0[tt], a1[tt]};
        __syncthreads();
        {
            const int tt = wave;
            f32x4 v[4]; float s = 0.f;
#pragma unroll
            for (int j = 0; j < 4; ++j) { v[j] = *(const LAS f32x4*)(Cf + tt * 1024 + 4 * lane + 256 * j); s += (v[j].x + v[j].y) + (v[j].z + v[j].w); }
            const float mu = wave_sum(s) * (1.f / CONVC); float s2 = 0.f;
#pragma unroll
            for (int j = 0; j < 4; ++j) { v[j] = v[j] - mu; s2 += (v[j].x * v[j].x + v[j].y * v[j].y) + (v[j].z * v[j].z + v[j].w * v[j].w); }
            const float rstd = rsqrtf(wave_sum(s2) * (1.f / CONVC) + EPS);
#pragma unroll
            for (int j = 0; j < 4; ++j) {
                const int ch = 4 * lane + 256 * j; const f32x4 gg = lgv[j], bb = lbv[j];
                f32x4 y = v[j] * rstd * gg + bb;
                y.x = y.x / (1.f + __expf(-y.x)); y.y = y.y / (1.f + __expf(-y.y)); y.z = y.z / (1.f + __expf(-y.z)); y.w = y.w / (1.f + __expf(-y.w));
                v2u w; w.x = pk2(y.x, y.y); w.y = pk2(y.z, y.w);
                *(v2u*)(mixed + (size_t)(t0 + 8 * c + tt) * D + ch) = w;
            }
        }
        __syncthreads();
    }
}

__device__ __forceinline__ void attn_unit(const Args& A, LAS unsigned char* lds, int qb, int kvh, int gh, int tid) {
    const bf16* proj = (const bf16*)(A.ws + WS_PROJ) + (size_t)T * 1024; bf16* mixed = (bf16*)(A.ws + WS_MIXED); const float* rope = (const float*)(A.ws + WS_ROPE);
    constexpr int KST = 72, VST = 260, QP = 1280, QO = 0, KO = 1024, VO = 1152;
    LAS bf16* Kn = (LAS bf16*)lds;
    LAS bf16* Vt = (LAS bf16*)(lds + 256 * KST * 2);
    const int lane = tid & 63, wave = tid >> 6;
    const int kbase = (qb - 1) * 128;
    v4u qraw[2][4];
#pragma unroll
    for (int si = 0; si < 2; ++si)
#pragma unroll
        for (int ks = 0; ks < 4; ++ks)
            qraw[si][ks] = *(const v4u*)(proj + (size_t)(qb * 128 + 32 * ((wave & 1) * 2 + si) + (lane & 31)) * QP + QO + (kvh * 8 + gh * 4 + (wave >> 1)) * HD + 16 * ks + 8 * (lane >> 5));
    {
        const int key = tid >> 1, half = tid & 1, kp = kbase + key;
        float v[32]; unsigned vw[16];
        if (kp >= 0) {
            const v4u* kr = (const v4u*)(proj + (size_t)kp * QP + KO + kvh * HD + 32 * half);
            const v4u* vr = (const v4u*)(proj + (size_t)kp * QP + VO + kvh * HD + 32 * half);
#pragma unroll
            for (int j = 0; j < 4; ++j) { const v4u w = kr[j]; v[8 * j + 0] = bflo(w.x); v[8 * j + 1] = bfhi(w.x); v[8 * j + 2] = bflo(w.y); v[8 * j + 3] = bfhi(w.y);
                v[8 * j + 4] = bflo(w.z); v[8 * j + 5] = bfhi(w.z); v[8 * j + 6] = bflo(w.w); v[8 * j + 7] = bfhi(w.w);
                const v4u u = vr[j]; vw[4 * j + 0] = u.x; vw[4 * j + 1] = u.y; vw[4 * j + 2] = u.z; vw[4 * j + 3] = u.w; }
        } else {
#pragma unroll
            for (int i = 0; i < 32; ++i) v[i] = 0.f;
#pragma unroll
            for (int i = 0; i < 16; ++i) vw[i] = 0u;
        }
        float ss = 0.f;
#pragma unroll
        for (int i = 0; i < 32; ++i) ss += v[i] * v[i];
        ss += __shfl_xor(ss, 1);
        const float r = rsqrtf(ss * (1.f / HD) + EPS);
#pragma unroll
        for (int i = 0; i < 32; ++i) v[i] = v[i] * r * A.kg[32 * half + i];
        if (half == 0 && kp >= 0) {
#pragma unroll
            for (int i = 0; i < 8; ++i) { const float cs = rope[kp * 16 + i], sn = rope[kp * 16 + 8 + i]; const float r1 = v[i], r2 = v[i + 8]; v[i] = r1 * cs - r2 * sn; v[i + 8] = r2 * cs + r1 * sn; }
        }
#pragma unroll
        for (int j = 0; j < 4; ++j) { v4u w; w.x = pk2(v[8 * j + 0], v[8 * j + 1]); w.y = pk2(v[8 * j + 2], v[8 * j + 3]); w.z = pk2(v[8 * j + 4], v[8 * j + 5]); w.w = pk2(v[8 * j + 6], v[8 * j + 7]);
            *(LAS v4u*)(Kn + key * KST + 32 * half + 8 * j) = w; }
#pragma unroll
        for (int i = 0; i < 16; ++i) { Vt[(32 * half + 2 * i) * VST + key] = (bf16)(vw[i] & 0xffffu); Vt[(32 * half + 2 * i + 1) * VST + key] = (bf16)(vw[i] >> 16); }
    }
    __syncthreads();
    const int hq = kvh * 8 + gh * 4 + (wave >> 1);
    const float sink = A.sinks[hq];
    const int h = lane >> 5, lq = lane & 31;
#pragma unroll 1
    for (int si = 0; si < 2; ++si) {
        const int s = (wave & 1) * 2 + si;
        const int qtok = qb * 128 + 32 * s + lq;
        bf16x8 qf[4];
        {
            float qv[4][8]; float ss = 0.f;
#pragma unroll
            for (int ks = 0; ks < 4; ++ks) { const v4u w = si == 0 ? qraw[0][ks] : qraw[1][ks];
                qv[ks][0] = bflo(w.x); qv[ks][1] = bfhi(w.x); qv[ks][2] = bflo(w.y); qv[ks][3] = bfhi(w.y); qv[ks][4] = bflo(w.z); qv[ks][5] = bfhi(w.z); qv[ks][6] = bflo(w.w); qv[ks][7] = bfhi(w.w);
#pragma unroll
                for (int j = 0; j < 8; ++j) ss += qv[ks][j] * qv[ks][j]; }
            ss += __shfl_xor(ss, 32);
            const float r = rsqrtf(ss * (1.f / HD) + EPS) * 0.125f;
#pragma unroll
            for (int ks = 0; ks < 4; ++ks)
#pragma unroll
                for (int j = 0; j < 8; ++j) qv[ks][j] = qv[ks][j] * r * A.qg[16 * ks + 8 * h + j];
#pragma unroll
            for (int j = 0; j < 8; ++j) { const float pv = __shfl_xor(qv[0][j], 32); const float cs = rope[qtok * 16 + j], sn = rope[qtok * 16 + 8 + j];
                qv[0][j] = h == 0 ? qv[0][j] * cs - pv * sn : qv[0][j] * cs + pv * sn; }
#pragma unroll
            for (int ks = 0; ks < 4; ++ks) { v4u w; w.x = pk2(qv[ks][0], qv[ks][1]); w.y = pk2(qv[ks][2], qv[ks][3]); w.z = pk2(qv[ks][4], qv[ks][5]); w.w = pk2(qv[ks][6], qv[ks][7]);
                qf[ks] = __builtin_bit_cast(bf16x8, w); }
        }
        f32x16 S[5];
#pragma unroll
        for (int k5 = 0; k5 < 5; ++k5) {
            f32x16 c;
#pragma unroll
            for (int i = 0; i < 16; ++i) c[i] = 0.f;
#pragma unroll
            for (int ks = 0; ks < 4; ++ks) { const bf16x8 a = *(const LAS bf16x8*)(Kn + (32 * (s + k5) + lq) * KST + 16 * ks + 8 * h);
                c = __builtin_amdgcn_mfma_f32_32x32x16_bf16(a, qf[ks], c, 0, 0, 0); }
            S[k5] = c;
        }
        float m = sink;
#pragma unroll
        for (int k5 = 0; k5 < 5; ++k5)
#pragma unroll
            for (int i = 0; i < 16; ++i) {
                const int keyb = 32 * (s + k5) + (i & 3) + 8 * (i >> 2) + 4 * h, diff = 128 + 32 * s + lq - keyb;
                const bool valid = diff >= 0 && diff < WIN && (qb > 0 || keyb >= 128);
                const float sv = valid ? S[k5][i] : -1e30f; S[k5][i] = sv; m = fmaxf(m, sv);
            }
        m = fmaxf(m, __shfl_xor(m, 32));
        float l = 0.f;
#pragma unroll
        for (int k5 = 0; k5 < 5; ++k5)
#pragma unroll
            for (int i = 0; i < 16; ++i) { const float p = __expf(S[k5][i] - m); S[k5][i] = p; l += p; }
        l += __shfl_xor(l, 32);
        l += __expf(sink - m);
        f32x16 O0, O1;
#pragma unroll
        for (int i = 0; i < 16; ++i) { O0[i] = 0.f; O1[i] = 0.f; }
#pragma unroll
        for (int k5 = 0; k5 < 5; ++k5)
#pragma unroll
            for (int s2 = 0; s2 < 2; ++s2) {
                v4u pw; pw.x = pk2(S[k5][8 * s2 + 0], S[k5][8 * s2 + 1]); pw.y = pk2(S[k5][8 * s2 + 2], S[k5][8 * s2 + 3]);
                pw.z = pk2(S[k5][8 * s2 + 4], S[k5][8 * s2 + 5]); pw.w = pk2(S[k5][8 * s2 + 6], S[k5][8 * s2 + 7]);
                const bf16x8 pf = __builtin_bit_cast(bf16x8, pw);
                const int kk = 32 * (s + k5) + 16 * s2 + 4 * h;
                { const v2u lo = *(const LAS v2u*)(Vt + lq * VST + kk), hi = *(const LAS v2u*)(Vt + lq * VST + kk + 8);
                  v4u aw; aw.x = lo.x; aw.y = lo.y; aw.z = hi.x; aw.w = hi.y;
                  O0 = __builtin_amdgcn_mfma_f32_32x32x16_bf16(__builtin_bit_cast(bf16x8, aw), pf, O0, 0, 0, 0); }
                { const v2u lo = *(const LAS v2u*)(Vt + (32 + lq) * VST + kk), hi = *(const LAS v2u*)(Vt + (32 + lq) * VST + kk + 8);
                  v4u aw; aw.x = lo.x; aw.y = lo.y; aw.z = hi.x; aw.w = hi.y;
                  O1 = __builtin_amdgcn_mfma_f32_32x32x16_bf16(__builtin_bit_cast(bf16x8, aw), pf, O1, 0, 0, 0); }
            }
        const float inv = 1.f / l;
        bf16* orow = mixed + (size_t)qtok * D + CONVC + hq * HD;
#pragma unroll
        for (int g = 0; g < 4; ++g) {
            v2u w0; w0.x = pk2(O0[4 * g + 0] * inv, O0[4 * g + 1] * inv); w0.y = pk2(O0[4 * g + 2] * inv, O0[4 * g + 3] * inv);
            *(v2u*)(orow + 8 * g + 4 * h) = w0;
            v2u w1; w1.x = pk2(O1[4 * g + 0] * inv, O1[4 * g + 1] * inv); w1.y = pk2(O1[4 * g + 2] * inv, O1[4 * g + 3] * inv);
            *(v2u*)(orow + 32 + 8 * g + 4 * h) = w1;
        }
    }
    __syncthreads();
}

typedef __attribute__((address_space(1))) unsigned gu32;
#define XB_TMO      128
#define XB_XCNT(j)  (256  + 64 * (j))
#define XB_XSUB(j)  (1280 + 64 * (j))
#define XB_XGEN(j)  (2304 + 64 * (j))
#define XB_TOP      3328
#define XB_TOPGEN   3392
#define XCD_BAR_WORDS 3456
#define XB_SPIN_CAP (1u << 18)
__device__ __forceinline__ unsigned xb_ld(unsigned* p)              { return __hip_atomic_load(p, __ATOMIC_RELAXED, __HIP_MEMORY_SCOPE_AGENT); }
__device__ __forceinline__ unsigned xb_add(unsigned* p, unsigned v) { return __hip_atomic_fetch_add(p, v, __ATOMIC_RELAXED, __HIP_MEMORY_SCOPE_AGENT); }
__device__ __forceinline__ unsigned xb_xcc_id() { return (unsigned)__builtin_amdgcn_s_getreg((3 << 11) | 20) & 0xFu; }
#define XB_SPIN(cond, bar) do { unsigned _sp = 0; while (cond) { __builtin_amdgcn_s_sleep(1); \
    if ((++_sp & 255u) == 0u) { if (xb_ld(&(bar)[XB_TMO])) break; if (_sp > XB_SPIN_CAP) { atomicAdd(&(bar)[XB_TMO], 1u); break; } } } } while (0)
struct XcdBarrier { unsigned* bar; unsigned x; volatile LAS unsigned* st; };
__device__ __forceinline__ XcdBarrier xcd_barrier_post(unsigned* bar, volatile LAS unsigned* st) {
    XcdBarrier b; b.bar = bar; b.x = xb_xcc_id(); b.st = st;
    if (threadIdx.x == 0) (void)xb_add(&bar[XB_XCNT(b.x)], 1u);
    return b;
}
__device__ __forceinline__ void xcd_barrier_complete(unsigned* bar, unsigned x, unsigned& nloc, unsigned& nx) {
    const unsigned G = gridDim.x * gridDim.y * gridDim.z;
    unsigned sum, cnt, mine, sp = 0u;
    for (;;) {
        sum = 0u; cnt = 0u; mine = 0u;
#pragma unroll
        for (unsigned j = 0; j < 16; ++j) { const unsigned c = xb_ld(&bar[XB_XCNT(j)]); sum += c; cnt += (c > 0u) ? 1u : 0u; mine = (j == x) ? c : mine; }
        if (sum == G) break;
        __builtin_amdgcn_s_sleep(1);
        if ((++sp & 255u) == 0u) { if (xb_ld(&bar[XB_TMO])) break; if (sp > XB_SPIN_CAP) { atomicAdd(&bar[XB_TMO], 1u); break; } }
    }
    nloc = mine > 0u ? mine : 1u; nx = cnt > 0u ? cnt : 1u;
}
__device__ __forceinline__ void xcd_barrier(const XcdBarrier& b) {
    asm volatile("s_waitcnt vmcnt(0)" ::: "memory");
    __syncthreads();
    if (threadIdx.x == 0) {
        unsigned* bar = b.bar;
        __builtin_amdgcn_s_waitcnt(0);
        unsigned nloc = b.st[0], nx = b.st[1];
        if (nloc == 0u) { xcd_barrier_complete(bar, b.x, nloc, nx); b.st[0] = nloc; b.st[1] = nx; }
        const unsigned old = xb_add(&bar[XB_XSUB(b.x)], 1u);
        const unsigned gen = old / nloc;
        if (old + 1u == (gen + 1u) * nloc) {
            __builtin_amdgcn_fence(__ATOMIC_RELEASE, "agent");
            asm volatile("s_waitcnt vmcnt(0)" ::: "memory");
            const unsigned og = xb_add(&bar[XB_TOP], 1u);
            const unsigned tg = og / nx;
            if (og + 1u == (tg + 1u) * nx) xb_add(&bar[XB_TOPGEN], 1u);
            else XB_SPIN(xb_ld(&bar[XB_TOPGEN]) == tg, bar);
            __builtin_amdgcn_fence(__ATOMIC_ACQUIRE, "agent");
            xb_add(&bar[XB_XGEN(b.x)], 1u);
            asm volatile("s_waitcnt vmcnt(0)" ::: "memory");
        } else {
            XB_SPIN(xb_ld(&bar[XB_XGEN(b.x)]) == gen, bar);
            __builtin_amdgcn_fence(__ATOMIC_ACQUIRE, "agent");
            asm volatile("s_waitcnt vmcnt(0)" ::: "memory");
        }
    }
    __syncthreads();
}
#ifndef USE_XCD_BAR
#define USE_XCD_BAR 1
#endif


__device__ __forceinline__ unsigned mono_key(float f) { const unsigned u = __float_as_uint(f); return u ^ ((unsigned)((int)u >> 31) | 0x80000000u); }
__device__ __forceinline__ float mono_val(unsigned k) { const unsigned u = (k & 0x80000000u) ? (k ^ 0x80000000u) : ~k; return __uint_as_float(u); }
__host__ __device__ constexpr int cand_a(int c) { return c < 16 ? 0 : c < 24 ? 1 : c < 29 ? 2 : c < 33 ? 3 : c < 36 ? 4 : c < 38 ? 5 : c < 40 ? 6 : c < 42 ? 7 : c - 34; }
__host__ __device__ constexpr int cand_b(int c) { return c < 16 ? c : c < 24 ? c - 16 : c < 29 ? c - 24 : c < 33 ? c - 29 : c < 36 ? c - 33 : c < 38 ? c - 36 : c < 40 ? c - 38 : c < 42 ? c - 40 : 0; }

typedef __bf16 bf16x2 __attribute__((ext_vector_type(2)));
__device__ __forceinline__ float dot2bf(unsigned w, unsigned x, float acc) { return __builtin_amdgcn_fdot2_f32_bf16(__builtin_bit_cast(bf16x2, w), __builtin_bit_cast(bf16x2, x), acc, false); }
template <int JC> __device__ __forceinline__ float dotn(const unsigned (&x)[4 * JC], const v4u (&u)[JC]) {
    float a0 = 0.f, a1 = 0.f, a2 = 0.f, a3 = 0.f;
#pragma unroll
    for (int j = 0; j < JC; ++j) { a0 = dot2bf(u[j].x, x[4 * j + 0], a0); a1 = dot2bf(u[j].y, x[4 * j + 1], a1); a2 = dot2bf(u[j].z, x[4 * j + 2], a2); a3 = dot2bf(u[j].w, x[4 * j + 3], a3); }
    return (a0 + a1) + (a2 + a3);
}
template <int JC> __device__ __forceinline__ void fman(float (&acc)[8 * JC], float a, const v4u (&v)[JC]) {
#pragma unroll
    for (int j = 0; j < JC; ++j) { const v4u w = v[j];
        acc[8 * j + 0] += a * bflo(w.x); acc[8 * j + 1] += a * bfhi(w.x); acc[8 * j + 2] += a * bflo(w.y); acc[8 * j + 3] += a * bfhi(w.y);
        acc[8 * j + 4] += a * bflo(w.z); acc[8 * j + 5] += a * bfhi(w.z); acc[8 * j + 6] += a * bflo(w.w); acc[8 * j + 7] += a * bfhi(w.w); }
}
__device__ __forceinline__ float row_sum16(float v) {
    v += __builtin_bit_cast(float, __builtin_amdgcn_update_dpp(0, __builtin_bit_cast(int, v), 0x128, 0xF, 0xF, true));
    v += __builtin_bit_cast(float, __builtin_amdgcn_update_dpp(0, __builtin_bit_cast(int, v), 0x124, 0xF, 0xF, true));
    v += __builtin_bit_cast(float, __builtin_amdgcn_update_dpp(0, __builtin_bit_cast(int, v), 0x122, 0xF, 0xF, true));
    v += __builtin_bit_cast(float, __builtin_amdgcn_update_dpp(0, __builtin_bit_cast(int, v), 0x121, 0xF, 0xF, true));
    return v;
}
#ifndef EPTU
#define EPTU 4
#endif
#ifndef EPTV
#define EPTV 2
#endif
#ifndef NPU
#define NPU 4
#endif
#ifndef NPV
#define NPV 4
#endif

#ifndef PASS_BAR
#define PASS_BAR 0
#endif
__device__ __forceinline__ void peer_tile(const Args& A, LAS unsigned char* lds, int t0, int tid, const XcdBarrier& xbar, int cbase, int cstr) {
    const bf16* qp = (const bf16*)(A.ws + WS_QP); const bf16* skb = (const bf16*)(A.ws + WS_SKB); const bf16* x1b = (const bf16*)(A.ws + WS_X1B);
    const bf16* Ub = (const bf16*)(A.ws + WS_UB); const bf16* Vb = (const bf16*)(A.ws + WS_VB); const float* ssq = (const float*)(A.ws + WS_SSQ);
    LAS unsigned* TK = (LAS unsigned*)lds;
    LAS int* SE = (LAS int*)(lds + 32768);
    LAS float* SG = (LAS float*)(lds + 49152);
    LAS float* ACT = (LAS float*)(lds + 65536);
    const int lane = tid & 63, wave = tid >> 6, h = lane >> 5, lq = lane & 31;
#ifndef PROBE_SUB
#define PROBE_SUB -1
#endif
    unsigned long long sst[6]; int nss = 0;
#define SSTAMP() do { if (PROBE_SUB >= 0) { __syncthreads(); sst[nss] = __builtin_amdgcn_s_memrealtime(); } ++nss; } while (0)
    SSTAMP();
#ifndef DBG_NO_S1
#pragma unroll 1
    for (int repA = 0; repA < REP_P5A; ++repA) {
#pragma unroll 1
    for (int hp2 = 0; hp2 < 2; ++hp2) {
        const int hp = 2 * wave + hp2;
        LAS bf16* KT = (LAS bf16*)(lds + 32768) + wave * (32 * 136);
        const int srow = lane >> 4, scol = (lane & 15) * 8;
        v4u gq[8];
#pragma unroll
        for (int i = 0; i < 8; ++i) gq[i] = *(const v4u*)(qp + (size_t)(t0 + 4 * i + srow) * D + hp * 128 + scol);
#pragma unroll
        for (int i = 0; i < 8; ++i) *(LAS v4u*)(KT + (4 * i + srow) * 136 + scol) = gq[i];
        bf16x8 qf[8];
#pragma unroll
        for (int ks = 0; ks < 8; ++ks) qf[ks] = *(const LAS bf16x8*)(KT + lq * 136 + 16 * ks + 8 * h);
        unsigned key[64];
        v4u gk[8];
#pragma unroll
        for (int i = 0; i < 8; ++i) gk[i] = *(const v4u*)(skb + (size_t)(hp * 128 + 4 * i + srow) * 128 + scol);
#pragma unroll
        for (int nt = 0; nt < 4; ++nt) {
            LDS_WAIT();
#pragma unroll
            for (int i = 0; i < 8; ++i) *(LAS v4u*)(KT + (4 * i + srow) * 136 + scol) = gk[i];
            if (nt < 3) {
#pragma unroll
                for (int i = 0; i < 8; ++i) gk[i] = *(const v4u*)(skb + (size_t)(hp * 128 + 32 * (nt + 1) + 4 * i + srow) * 128 + scol);
            }
            f32x16 c;
#pragma unroll
            for (int i = 0; i < 16; ++i) c[i] = 0.f;
#pragma unroll
            for (int ks = 0; ks < 8; ++ks) { const bf16x8 a = *(const LAS bf16x8*)(KT + lq * 136 + 16 * ks + 8 * h);
                c = __builtin_amdgcn_mfma_f32_32x32x16_bf16(a, qf[ks], c, 0, 0, 0); }
#pragma unroll
            for (int i = 0; i < 16; ++i) { const int n = 32 * nt + (i & 3) + 8 * (i >> 2) + 4 * h; key[16 * nt + i] = (mono_key(c[i]) & ~127u) | (unsigned)(127 - n); }
        }
#ifndef REP_RND
#define REP_RND 1
#endif
#pragma unroll 1
        for (int rr = 0; rr < REP_RND; ++rr) {
        unsigned cprev = 0xFFFFFFFFu;
#pragma unroll 1
        for (int r = 0; r < PTOPK; ++r) {
            unsigned m = cprev - key[0];
#pragma unroll
            for (int i = 1; i < 64; ++i) { const unsigned d = cprev - key[i]; m = m < d ? m : d; }
            const unsigned pm = (unsigned)__shfl_xor((int)m, 32);
            m = m < pm ? m : pm;
            const unsigned M = cprev - m;
            if (h == 0) TK[((lq * 16) + hp) * 16 + r] = M;
            cprev = M - 1u;
        }
        }
    }
    __syncthreads();
    SSTAMP();
    if (lane < 32) {
        const int p = wave * 32 + lane, t = p >> 3, hd = p & 7;
        const LAS unsigned* K1 = TK + (t * 16 + 2 * hd) * 16; const LAS unsigned* K2 = K1 + 16;
        const float v20 = mono_val(K2[0] & ~127u);
        unsigned ik[16], fl[16];
#pragma unroll
        for (int a = 0; a < 16; ++a) ik[a] = (mono_key(mono_val(K1[a] & ~127u) + v20) & ~255u) | (unsigned)(255 - a * 16);
#pragma unroll
        for (int r = 0; r < 16; ++r) {
            unsigned M = ik[0];
#pragma unroll
            for (int a = 1; a < 16; ++a) M = M > ik[a] ? M : ik[a];
            const unsigned flat = 255u - (M & 255u); fl[r] = flat;
            const unsigned as = flat >> 4, pn = (flat & 15u) + 1u, pc = pn < 16u ? pn : 15u;
            const float sn = mono_val(K1[as] & ~127u) + mono_val(K2[pc] & ~127u);
            const unsigned nk = pn < 16u ? ((mono_key(sn) & ~255u) | (255u - (as * 16u + pn))) : 0u;
#pragma unroll
            for (int a = 0; a < 16; ++a) ik[a] = (as == (unsigned)a) ? nk : ik[a];
        }
        float sv[16]; int ev[16];
#pragma unroll
        for (int r = 0; r < 16; ++r) { const unsigned k1 = K1[fl[r] >> 4], k2 = K2[fl[r] & 15u];
            sv[r] = mono_val(k1 & ~127u) + mono_val(k2 & ~127u); ev[r] = (int)(127u - (k1 & 127u)) * NKEYS + (int)(127u - (k2 & 127u)); }
        const float smax = sv[0]; float gs = 0.f;
#pragma unroll
        for (int r = 0; r < 16; ++r) { sv[r] = __expf(sv[r] - smax); gs += sv[r]; }
        const float ginv = 1.f / gs;
#pragma unroll
        for (int r = 0; r < 16; ++r) { SE[t * 128 + hd * 16 + r] = ev[r]; SG[t * 128 + hd * 16 + r] = sv[r] * ginv; }
    }
    __syncthreads();
    }
#endif
    SSTAMP();
    {
        const int g = lane >> 4, l16 = lane & 15, tl = wave * 4 + g, t = t0 + tl;
        LAS unsigned* ORD = (LAS unsigned*)(lds + 81920);
        const LAS int* SEt = SE + tl * 128; LAS float* ACTt = ACT + tl * 128;
        {
            unsigned key[8]; int rank[8];
#pragma unroll
            for (int j = 0; j < 8; ++j) { key[j] = (((unsigned)SEt[j * 16 + l16] & (unsigned)(NEXP - 1)) << 7) | (unsigned)(j * 16 + l16); rank[j] = 0; }
#pragma unroll 4
            for (int m = 0; m < 128; ++m) { const unsigned km = (((unsigned)SEt[m] & (unsigned)(NEXP - 1)) << 7) | (unsigned)m;
#pragma unroll
                for (int j = 0; j < 8; ++j) rank[j] += km < key[j] ? 1 : 0; }
#pragma unroll
            for (int j = 0; j < 8; ++j) { ORD[tl * 128 + rank[j]] = key[j] << 2; ACTt[j * 16 + l16] = 0.f; }
            LDS_WAIT(); __builtin_amdgcn_wave_barrier();
        }
        const LAS unsigned* ORDt = ORD + tl * 128;
        SSTAMP();
#ifndef DBG_NO_U
        {
            constexpr int NCH = 8 / NPU;
            const unsigned char* U8 = (const unsigned char*)Ub;
            const float rs = rsqrtf(ssq[t] * (1.f / D) + EPS) * (1.f / USCALE);
#pragma unroll 1
            for (int ps = 0; ps < NPU; ++ps) {
                const int pp = ps % NPU; const int cofs = pp * (D / NPU) + l16 * 16;
                if (PASS_BAR) xcd_barrier(xbar);
                f32x4 vch[4][4]; const int vid = ps * cstr + cbase + wave; const bool vdo = cbase >= 0 && vid < NEXP / 2;
                if (vdo) tab_load(A.pv, 2 * vid, lane, vch);
                f32x2 xf2[8 * NCH];
                { const bf16* xr = x1b + (size_t)t * D + cofs;
#pragma unroll
                  for (int j = 0; j < NCH; ++j)
#pragma unroll
                    for (int hh = 0; hh < 2; ++hh) { const v4u w = *(const v4u*)(xr + 256 * j + 8 * hh);
                        xf2[8 * j + 4 * hh + 0] = (f32x2){bflo(w.x), bfhi(w.x)}; xf2[8 * j + 4 * hh + 1] = (f32x2){bflo(w.y), bfhi(w.y)};
                        xf2[8 * j + 4 * hh + 2] = (f32x2){bflo(w.z), bfhi(w.z)}; xf2[8 * j + 4 * hh + 3] = (f32x2){bflo(w.w), bfhi(w.w)}; } }
#define U_LOAD(EN, UU, I0) do { _Pragma("unroll") for (int c = 0; c < EPTU; ++c) { EN[c] = ORDt[(I0) + c]; const unsigned char* up = U8 + (((EN[c] & ~511u) << 2) + (unsigned)cofs); \
                    _Pragma("unroll") for (int j = 0; j < NCH; ++j) UU[c][j] = *(const v4u*)(up + 256 * j); } } while (0)
#define U_COMP(EN, UU) do { float tot = 0.f; unsigned ent = 0u; _Pragma("unroll") for (int c = 0; c < EPTU; ++c) { f32x2 p0 = {0.f, 0.f}, p1 = {0.f, 0.f}; \
                    _Pragma("unroll") for (int j = 0; j < NCH; ++j) _Pragma("unroll") for (int d = 0; d < 4; ++d) { \
                        const f32x2 lo = __builtin_amdgcn_cvt_pk_f32_fp8((int)UU[c][j][d], false), hi = __builtin_amdgcn_cvt_pk_f32_fp8((int)UU[c][j][d], true); \
                        p0 = __builtin_elementwise_fma(xf2[8 * j + 2 * d + 0], lo, p0); p1 = __builtin_elementwise_fma(xf2[8 * j + 2 * d + 1], hi, p1); } \
                    const float dd = row_sum16((p0.x + p0.y) + (p1.x + p1.y)); \
                    if (l16 == c) { tot = dd; ent = EN[c]; } } \
                    if (l16 < EPTU) (void)__hip_atomic_fetch_add((LAS float*)((LAS unsigned char*)ACTt + (ent & 0x1FCu)), rs * tot, __ATOMIC_RELAXED, __HIP_MEMORY_SCOPE_WORKGROUP); } while (0)
                unsigned enA[EPTU], enB[EPTU]; v4u uA[EPTU][NCH], uB[EPTU][NCH];
                { int i0 = 0; asm volatile("" : "+s"(i0)); U_LOAD(enA, uA, i0); }
#pragma unroll 1
                for (int i = 0; i < 128; i += 2 * EPTU) {
                    { int i1 = i + EPTU; asm volatile("" : "+s"(i1)); U_LOAD(enB, uB, i1); }
                    __builtin_amdgcn_sched_barrier(0);
                    U_COMP(enA, uA);
                    __builtin_amdgcn_sched_barrier(0);
                    { int i2 = (i + 2 * EPTU) & 127; asm volatile("" : "+s"(i2)); U_LOAD(enA, uA, i2); }
                    __builtin_amdgcn_sched_barrier(0);
                    U_COMP(enB, uB);
                    __builtin_amdgcn_sched_barrier(0);
                }
#undef U_LOAD
#undef U_COMP
                LDS_WAIT(); __builtin_amdgcn_wave_barrier();
                if (vdo) tab_store(nullptr, A.ws + WS_VB, 2 * vid, VSCALE, lane, vch);
                if (cbase >= 0) for (int v2 = vid + NPU * cstr; v2 < NEXP / 2; v2 += NPU * cstr) p0_table_rows2(A.pv, nullptr, A.ws + WS_VB, 2 * v2, VSCALE, lane);
            }
#pragma unroll
            for (int j = 0; j < 8; ++j) { const int ix = j * 16 + l16; const float hh = ACTt[ix];
                ACTt[ix] = 0.5f * hh * (1.f + erff(hh * 0.70710678118654752f)) * SG[tl * 128 + ix] * (1.f / VSCALE); }
            LDS_WAIT(); __builtin_amdgcn_wave_barrier();
        }
        SSTAMP();
#endif
        if (cbase >= 0) xcd_barrier(xbar);
#ifndef DBG_NO_V
        {
            constexpr int NCH = 8 / NPV;
            const unsigned char* V8 = (const unsigned char*)Vb;
#pragma unroll 1
            for (int ps = 0; ps < NPV * REP_P5V; ++ps) {
                const int pp = ps % NPV; const int cofs = pp * (D / NPV) + l16 * 16;
                if (PASS_BAR) xcd_barrier(xbar);
                float acc[16 * NCH];
#pragma unroll
                for (int i = 0; i < 16 * NCH; ++i) acc[i] = 0.f;
#define V_LOAD(EN, VV, AA, I0) do { _Pragma("unroll") for (int c = 0; c < EPTV; ++c) { EN[c] = ORDt[(I0) + c]; AA[c] = *(const LAS float*)((const LAS unsigned char*)ACTt + (EN[c] & 0x1FCu)); const unsigned char* vp = V8 + (((EN[c] & ~511u) << 2) + (unsigned)cofs); \
                    _Pragma("unroll") for (int j = 0; j < NCH; ++j) VV[c][j] = *(const v4u*)(vp + 256 * j); } } while (0)
#define V_COMP(AA, VV) do { _Pragma("unroll") for (int c = 0; c < EPTV; ++c) { const float a = AA[c]; \
                    _Pragma("unroll") for (int j = 0; j < NCH; ++j) _Pragma("unroll") for (int d = 0; d < 4; ++d) { \
                        const f32x2 lo = __builtin_amdgcn_cvt_pk_f32_fp8((int)VV[c][j][d], false), hi = __builtin_amdgcn_cvt_pk_f32_fp8((int)VV[c][j][d], true); \
                        acc[16 * j + 4 * d + 0] += a * lo.x; acc[16 * j + 4 * d + 1] += a * lo.y; acc[16 * j + 4 * d + 2] += a * hi.x; acc[16 * j + 4 * d + 3] += a * hi.y; } } } while (0)
                unsigned enA[EPTV], enB[EPTV]; float aA[EPTV], aB[EPTV]; v4u vA[EPTV][NCH], vB[EPTV][NCH];
                { int i0 = 0; asm volatile("" : "+s"(i0)); V_LOAD(enA, vA, aA, i0); }
#pragma unroll 1
                for (int i = 0; i < 128; i += 2 * EPTV) {
                    { int i1 = i + EPTV; asm volatile("" : "+s"(i1)); V_LOAD(enB, vB, aB, i1); }
                    __builtin_amdgcn_sched_barrier(0);
                    V_COMP(aA, vA);
                    __builtin_amdgcn_sched_barrier(0);
                    { int i2 = (i + 2 * EPTV) & 127; asm volatile("" : "+s"(i2)); V_LOAD(enA, vA, aA, i2); }
                    __builtin_amdgcn_sched_barrier(0);
                    V_COMP(aB, vB);
                    __builtin_amdgcn_sched_barrier(0);
                }
#undef V_LOAD
#undef V_COMP
                if (ps < NPV) {
                    float* orow = A.out + (size_t)t * D + cofs; const bf16* xrow = x1b + (size_t)t * D + cofs;
#pragma unroll
                    for (int j = 0; j < NCH; ++j)
#pragma unroll
                        for (int d = 0; d < 4; ++d) { f32x4 o;
                            if (RESID_BF16) { const v2u xw = *(const v2u*)(xrow + 256 * j + 4 * d); o.x = bflo(xw.x); o.y = bfhi(xw.x); o.z = bflo(xw.y); o.w = bfhi(xw.y); }
                            else o = *(f32x4*)(orow + 256 * j + 4 * d);
                            o.x += acc[16 * j + 4 * d + 0]; o.y += acc[16 * j + 4 * d + 1]; o.z += acc[16 * j + 4 * d + 2]; o.w += acc[16 * j + 4 * d + 3];
                            *(f32x4*)(orow + 256 * j + 4 * d) = o; }
                }
            }
        }
#endif
    }
    SSTAMP();
    if (PROBE_SUB >= 0 && PROBE_SUB < 5 && blockIdx.x == 0 && threadIdx.x == 0) { const unsigned long long span = sst[PROBE_SUB + 1] - sst[PROBE_SUB], t0s = __builtin_amdgcn_s_memrealtime();
        while (__builtin_amdgcn_s_memrealtime() - t0s < span) __builtin_amdgcn_s_sleep(8); }
    __syncthreads();
}


__global__ void __launch_bounds__(NTHR, 2) mega_fwd(Args args) {
    extern __shared__ __attribute__((aligned(16))) unsigned char lds_raw[];
    LAS unsigned char* lds = (LAS unsigned char*)lds_raw;
    const int tid = threadIdx.x, G = gridDim.x, bx = blockIdx.x;
    const int vcu = (G % 8 == 0) ? (bx % 8) * (G / 8) + bx / 8 : bx;
    unsigned char* ws = args.ws;
    const int lo = args.ph_lo, hi = args.ph_hi;
    volatile LAS unsigned* bst = (volatile LAS unsigned*)(lds + LDS_BYTES - 16);
    if (tid < 4) bst[tid] = 0u;
    __syncthreads();
    XcdBarrier xbar = xcd_barrier_post((unsigned*)(ws + WS_BAR), bst);
#if USE_XCD_BAR
#define SEAM_SYNC() xcd_barrier(xbar)
#else
#define SEAM_SYNC() cg::this_grid().sync()
#endif
#ifndef PH_MASK
#define PH_MASK 63
#endif
#define IN(k) (((PH_MASK >> (k)) & 1) && lo <= (k) && (k) < hi)
#ifndef PROBE_PH
#define PROBE_PH -1
#endif
    unsigned long long tstamp[7]; int nst = 0;
#define STAMP() do { if (PROBE_PH >= 0) { tstamp[nst] = __builtin_amdgcn_s_memrealtime(); } ++nst; } while (0)
    STAMP();
#define TIDP() ({ int _t = threadIdx.x; asm volatile("" : "+v"(_t)); _t; })
#define BOTH(k) (IN(k) && IN((k) + 1))
    if (IN(0)) { for (int rep = 0; rep < REP_P0; ++rep) { p0_prologue(args, lds, bx, TIDP()); __syncthreads(); } if (BOTH(0)) SEAM_SYNC(); STAMP(); }
    if (IN(1)) {
        pg8::Gemm g{(const bf16*)(ws + WS_XB), (const bf16*)(ws + WS_W1T), T, INC, D}; pg8::StaticOrder S; S.init(T, INC, G, bx);
        pg8::EpiProjGlu E{(bf16*)(ws + WS_PROJ), (bf16*)(ws + WS_PROJ) + (size_t)T * 1024, (const float*)(ws + WS_RSTD1), args.b_in};
        for (int rep = 0; rep < REP_P1; ++rep) pg8::gemm_phase<pg8::EpiProjGlu, pg8::StaticOrder, PG8_ALIGN, PG8_SP2>(lds, g, S, E);
        if (N_P1 > 0) p1_table_queue(args, bx, TIDP());
        if (BOTH(1)) SEAM_SYNC(); STAMP();
    }
    if (IN(2)) {
        for (int rep = 0; rep < REP_P2; ++rep) {
#ifndef NO_CONV
        for (int r2 = 0; r2 < REP_CONV; ++r2) for (int u = vcu; u < 256; u += G) conv_unit(args, lds, 32 * u, TIDP());
#endif
#ifndef NO_ATTN
        for (int r2 = 0; r2 < REP_ATTN; ++r2) for (int u = vcu; u < 256; u += G) attn_unit(args, lds, u >> 2, (u >> 1) & 1, u & 1, TIDP());
#endif
        }
        if (BOTH(2)) SEAM_SYNC(); STAMP();
    }
    if (IN(3)) {
        pg8::Gemm g{(const bf16*)(ws + WS_MIXED), (const bf16*)(ws + WS_W2T), T, D, D}; pg8::StaticOrder S; S.init(T, D, G, bx);
        pg8::EpiResid E{(const bf16*)(ws + WS_XB), RESID_BF16 ? nullptr : args.out, (bf16*)(ws + WS_X1B), (float*)(ws + WS_SSQ), D};
        pg8::gemm_phase<pg8::EpiResid, pg8::StaticOrder, PG8_ALIGN, PG8_SP2>(lds, g, S, E);
        if (BOTH(3)) SEAM_SYNC(); STAMP();
    }
    if (IN(4)) {
        pg8::Gemm g{(const bf16*)(ws + WS_X1B), (const bf16*)(ws + WS_W3T), T, D, D}; pg8::StaticOrder S; S.init(T, D, G, bx);
        pg8::EpiScaleBf16<true> E{(bf16*)(ws + WS_QP), D, (const float*)(ws + WS_SSQ), nullptr};
        for (int rep = 0; rep < REP_P4; ++rep) pg8::gemm_phase<pg8::EpiScaleBf16<true>, pg8::StaticOrder, PG8_ALIGN, PG8_SP2>(lds, g, S, E);
        if (BOTH(4)) SEAM_SYNC(); STAMP();
    }
    if (IN(5)) {
        const bool inl = (G == T / 32);
        if (!inl) { const int t5 = TIDP(); for (int v2 = bx * 8 + (t5 >> 6); v2 < NEXP / 2; v2 += G * 8) p0_table_rows2(args.pv, nullptr, ws + WS_VB, 2 * v2, VSCALE, t5 & 63); SEAM_SYNC(); }
        for (int u = vcu; u < T / 32; u += G) peer_tile(args, lds, 32 * u, TIDP(), xbar, inl ? bx * 8 : -1, G * 8);
    }
#ifdef END_BAR
    SEAM_SYNC();
#endif
    STAMP();
    if (PROBE_PH >= 0 && PROBE_PH < 6 && bx == 0 && threadIdx.x == 0) {
        const unsigned long long span = tstamp[PROBE_PH + 1] - tstamp[PROBE_PH], t0 = __builtin_amdgcn_s_memrealtime();
        while (__builtin_amdgcn_s_memrealtime() - t0 < span) __builtin_amdgcn_s_sleep(8);
    }
#undef IN
#undef BOTH
}

__global__ void k_rope_naive(const int* __restrict__ pos, float* __restrict__ rope) {
    const int i = blockIdx.x * blockDim.x + threadIdx.x; if (i >= T * 8) return;
    const int t = i >> 3, f = i & 7; const float ang = (float)pos[t] * powf(500000.f, -(float)(2 * f) / 16.f); float sn, cs; sincosf(ang, &sn, &cs);
    rope[t * 16 + f] = cs; rope[t * 16 + 8 + f] = sn;
}

#ifndef MK_MODE
#define MK_MODE 1
#endif
#ifndef MK_COOP
#define MK_COOP 1
#endif
#ifndef NAIVE_MASK
#define NAIVE_MASK 0
#endif
extern "C" void kernel_launch(void* const* d_in, const int* in_sizes, int n_in, void* d_out, int out_size, void* d_ws, size_t ws_size, hipStream_t stream) {
    static int grid = 0;
    if (grid == 0) {
        if (n_in != 18 || in_sizes[0] != T * D || out_size != T * D || ws_size < WS_END) {
            fprintf(stderr, "kernel_launch: unexpected shapes: n_in %d in0 %d out %d ws %zu (need %zu)\n", n_in, n_in > 0 ? in_sizes[0] : -1, out_size, ws_size, (size_t)WS_END); grid = -1; return; }
        int dev = 0, cus = 0, per_cu = 0;
        if (hipGetDevice(&dev) != hipSuccess || hipDeviceGetAttribute(&cus, hipDeviceAttributeMultiprocessorCount, dev) != hipSuccess) { fprintf(stderr, "kernel_launch: device query failed\n"); grid = -1; return; }
        if (hipFuncSetAttribute((const void*)mega_fwd, hipFuncAttributeMaxDynamicSharedMemorySize, LDS_BYTES) != hipSuccess) { fprintf(stderr, "kernel_launch: hipFuncSetAttribute failed\n"); grid = -1; return; }
        if (hipOccupancyMaxActiveBlocksPerMultiprocessor(&per_cu, (const void*)mega_fwd, NTHR, LDS_BYTES) != hipSuccess || per_cu < 1) {
            fprintf(stderr, "kernel_launch: occupancy query says %d blocks per CU: nothing launched\n", per_cu); (void)hipGetLastError(); grid = -1; return; }
        grid = cus * 1;
        (void)per_cu;
    }
    if (grid < 0) return;
    unsigned char* ws = (unsigned char*)d_ws;
    (void)hipMemsetAsync(ws + WS_BAR, 0, WS_SSQ + (size_t)T * 4 - WS_BAR, stream);
    Args a{};
    a.x = (const float*)d_in[0]; a.pos = (const int*)d_in[1]; a.g1 = (const float*)d_in[2]; a.w_in = (const float*)d_in[3]; a.b_in = (const float*)d_in[4];
    a.cw = (const float*)d_in[5]; a.cb = (const float*)d_in[6]; a.lg = (const float*)d_in[7]; a.lb = (const float*)d_in[8]; a.qg = (const float*)d_in[9];
    a.kg = (const float*)d_in[10]; a.sinks = (const float*)d_in[11]; a.w_out = (const float*)d_in[12]; a.g2 = (const float*)d_in[13]; a.wq = (const float*)d_in[14];
    a.skeys = (const float*)d_in[15]; a.pu = (const float*)d_in[16]; a.pv = (const float*)d_in[17];
    a.out = (float*)d_out; a.ws = ws;
#if MK_MODE == 1
    a.ph_lo = 0; a.ph_hi = 6;
#if MK_COOP
    void* kargs[] = {&a};
    hipError_t e = hipLaunchCooperativeKernel((const void*)mega_fwd, dim3(grid), dim3(NTHR), kargs, LDS_BYTES, stream);
    if (e != hipSuccess) fprintf(stderr, "kernel_launch: cooperative launch failed: %s (grid %d)\n", hipGetErrorString(e), grid);
#else
    hipLaunchKernelGGL(mega_fwd, dim3(grid), dim3(NTHR), LDS_BYTES, stream, a);
    const hipError_t e = hipPeekAtLastError();
    if (e != hipSuccess) fprintf(stderr, "kernel_launch: launch failed: %s (grid %d)\n", hipGetErrorString(e), grid);
#endif
#else
    float* ssq = (float*)(ws + WS_SSQ); float* rstd1 = (float*)(ws + WS_RSTD1); float* rope = (float*)(ws + WS_ROPE);
    bf16 *skb = (bf16*)(ws + WS_SKB), *w1t = (bf16*)(ws + WS_W1T), *w2t = (bf16*)(ws + WS_W2T), *w3t = (bf16*)(ws + WS_W3T);
    bf16 *xb = (bf16*)(ws + WS_XB), *proj = (bf16*)(ws + WS_PROJ), *mixed = (bf16*)(ws + WS_MIXED), *x1b = (bf16*)(ws + WS_X1B), *qp = (bf16*)(ws + WS_QP);
    bf16 *ub = (bf16*)(ws + WS_UB), *vb = (bf16*)(ws + WS_VB);
    for (int ph = 0; ph < 6; ++ph) {
        if (!((NAIVE_MASK >> ph) & 1)) { a.ph_lo = ph; a.ph_hi = ph + 1; hipLaunchKernelGGL(mega_fwd, dim3(grid), dim3(NTHR), LDS_BYTES, stream, a); continue; }
        switch (ph) {
        case 0:
            k_prep_x<<<1024, 256, 0, stream>>>(a.x, xb, rstd1);
            k_transpose_w<<<dim3(INC / 32, D / 32), 256, 0, stream>>>(a.w_in, a.g1, w1t, D, INC);
            k_transpose_w<<<dim3(D / 32, D / 32), 256, 0, stream>>>(a.w_out, nullptr, w2t, D, D);
            k_transpose_w<<<dim3(D / 32, D / 32), 256, 0, stream>>>(a.wq, a.g2, w3t, D, D);
            k_convert<<<256, 256, 0, stream>>>(a.skeys, nullptr, skb, (size_t)16 * 128 * 128 / 8, 128);
            k_convert<<<2048, 256, 0, stream>>>(a.pu, a.g2, ub, (size_t)NEXP * D / 8, D);
            k_convert<<<2048, 256, 0, stream>>>(a.pv, nullptr, vb, (size_t)NEXP * D / 8, D);
            k_rope_naive<<<T * 8 / 256, 256, 0, stream>>>(a.pos, rope);
            break;
        case 1: k_gemm_naive<EpiProj><<<dim3(INC / 64, T / 64), 256, 0, stream>>>(xb, w1t, T, INC, D, EpiProj{proj, rstd1, a.b_in}); break;
        case 2: k_conv_naive<<<T, 256, 0, stream>>>(proj, a.cw, a.cb, a.lg, a.lb, mixed);
                k_attn_naive<<<T * NQH / 4, 256, 0, stream>>>(proj, a.pos, a.qg, a.kg, a.sinks, mixed); break;
        case 3: k_gemm_naive<EpiX1><<<dim3(D / 64, T / 64), 256, 0, stream>>>(mixed, w2t, T, D, D, EpiX1{a.x, a.out, x1b});
                k_ssq<<<1024, 256, 0, stream>>>(a.out, ssq); break;
        case 4: k_gemm_naive<EpiQp><<<dim3(D / 64, T / 64), 256, 0, stream>>>(x1b, w3t, T, D, D, EpiQp{qp, ssq}); break;
        case 5: k_peer_naive<<<T / 4, 256, 0, stream>>>(qp, skb, x1b, ssq, ub, vb, a.out); break;
        }
    }
#endif
}
```
